# Optimizing an MI355X kernel written in HIP

```python
import math
import jax
import jax.numpy as jnp
from jax import lax
import numpy as np

D_MODEL = 1024
BATCH = 16
SEQ = 4096
DEPTH = 4

CTX_LEN = 256
GRID_W = 64
NORM_EPS = 1e-6

N_HEADS = 8
N_KV_HEADS = 2
HEAD_DIM = 128
GROUP = N_HEADS // N_KV_HEADS
ROPE_HALF = HEAD_DIM // 2
ROPE_PAIRS_AXIS = HEAD_DIM // 4
ROPE_THETA = 10000.0
ATTN_SCALE = HEAD_DIM ** -0.5
Q_BLOCK = 128
Q_WIDTH = N_HEADS * HEAD_DIM
KV_WIDTH = N_KV_HEADS * HEAD_DIM

HY_WIDTH = D_MODEL // 2
HY_SHORT = 3
HY_BANDS = 16
HY_EMB = 1 + 2 * HY_BANDS
HY_FILTER_HIDDEN = 64
HY_FAST_DECAY_PCT = 0.3
HY_SLOW_DECAY_PCT = 1.5
HY_DECAY_TARGET = 1e-2

LRU_WIDTH = D_MODEL // 2
LRU_BLOCKS = 8
LRU_BLOCK = LRU_WIDTH // LRU_BLOCKS
LRU_CONV = 4
LRU_PAD_LEFT = 2
LRU_PAD_RIGHT = 1
LRU_C = 8.0

N_BRANCH = 3
N_EXPERTS = 16
EXPERT_FF = D_MODEL
EC_CAPACITY = 2

IN_NAMES = ('q', 'k', 'v', 'hy', 'rx', 'rg', 'gate')
IN_WIDTHS = (Q_WIDTH, KV_WIDTH, KV_WIDTH, 3 * HY_WIDTH, LRU_WIDTH, LRU_WIDTH, N_BRANCH * D_MODEL)
IN_TOTAL = Q_WIDTH + 2 * KV_WIDTH + 3 * HY_WIDTH + 2 * LRU_WIDTH + N_BRANCH * D_MODEL

kernel_name = 'hybrid_gqa_hyena_rglru_ecmoe_dit'


def in_columns():
    cols, start = {}, 0
    for name, width in zip(IN_NAMES, IN_WIDTHS):
        cols[name] = (start, start + width)
        start += width
    return cols


def rms_norm(x, g):
    xf = x.astype(jnp.float32)
    y = xf * lax.rsqrt(jnp.mean(xf * xf, axis=-1, keepdims=True) + NORM_EPS)
    return (y * g.astype(jnp.float32)).astype(x.dtype)


def modulate(x, g, shift, scale):
    return rms_norm(x, g) * (1 + scale) + shift


def short_conv(u, w, b, left, right):
    n = u.shape[1]
    up = jnp.pad(u, ((0, 0), (left, right), (0, 0)))
    out = b
    for j in range(w.shape[0]):
        out = out + up[:, j:j + n] * w[j]
    return out


def axial_rope(rows):
    row = jnp.repeat(jnp.arange(rows, dtype=jnp.float32), GRID_W)
    col = jnp.tile(jnp.arange(GRID_W, dtype=jnp.float32), rows)
    inv = jnp.power(ROPE_THETA, -jnp.arange(ROPE_PAIRS_AXIS, dtype=jnp.float32) / ROPE_PAIRS_AXIS)
    ang = jnp.concatenate([row[:, None] * inv, col[:, None] * inv], axis=-1)
    return jnp.cos(ang), jnp.sin(ang)


def apply_rope(x, cos, sin):
    xf = x.astype(jnp.float32)
    x1, x2 = xf[..., :ROPE_HALF], xf[..., ROPE_HALF:]
    cs = cos[None, :, None, :]
    sn = sin[None, :, None, :]
    return jnp.concatenate([x1 * cs - x2 * sn, x2 * cs + x1 * sn], axis=-1).astype(x.dtype)


def attend(qg, keys, vals):
    s = jnp.einsum('bqhgd,bkhd->bhgqk', qg, keys, preferred_element_type=jnp.float32) * ATTN_SCALE
    p = jax.nn.softmax(s, axis=-1).astype(vals.dtype)
    return jnp.einsum('bhgqk,bkhd->bqhgd', p, vals)


def latent_attention(q, k, v, k_ctx, v_ctx):
    bsz, s = q.shape[0], q.shape[1]
    keys = jnp.concatenate([k, k_ctx], axis=1)
    vals = jnp.concatenate([v, v_ctx], axis=1)
    n_blk = s // Q_BLOCK
    qb = q.reshape(bsz, n_blk, Q_BLOCK, N_KV_HEADS, GROUP, HEAD_DIM).swapaxes(0, 1)
    out = lax.map(lambda qblk: attend(qblk, keys, vals), qb)
    return out.swapaxes(0, 1).reshape(bsz, s, Q_WIDTH)


def hyena_filters(n, p):
    f32 = jnp.float32
    t = jnp.linspace(0.0, 1.0, n, dtype=f32)[:, None]
    w = (2.0 * math.pi / n) * jnp.arange(n, dtype=f32)[:, None]
    f = jnp.linspace(1e-4, HY_BANDS - 1, HY_BANDS, dtype=f32)[None, :]
    feats = jnp.concatenate([t, jnp.cos(f * w), -jnp.sin(f * w)], axis=-1)
    freq = p['hy_freq'].astype(f32)
    hid = jnp.sin(freq[0] * (feats @ p['hy_fw1'].astype(f32) + p['hy_fb1'].astype(f32)))
    hid = jnp.sin(freq[1] * (hid @ p['hy_fw2'].astype(f32) + p['hy_fb2'].astype(f32)))
    filt = hid @ p['hy_fw3'].astype(f32)
    max_decay = math.log(HY_DECAY_TARGET) / HY_FAST_DECAY_PCT
    min_decay = math.log(HY_DECAY_TARGET) / HY_SLOW_DECAY_PCT
    deltas = jnp.linspace(min_decay, max_decay, HY_WIDTH, dtype=f32)
    decay = jnp.exp(-t * jnp.abs(deltas)[None, :])
    h_fwd = filt[:, :HY_WIDTH] * decay
    h_bwd = filt[:, HY_WIDTH:] * decay
    return jnp.concatenate([h_fwd[:1] + h_bwd[:1], h_fwd[1:], jnp.zeros((1, HY_WIDTH), f32), h_bwd[:0:-1]], axis=0)


def bidir_long_conv(u, k2, bias):
    n = u.shape[1]
    uf = jnp.fft.rfft(u.astype(jnp.float32), n=2 * n, axis=1)
    kf = jnp.fft.rfft(k2, n=2 * n, axis=0)
    y = jnp.fft.irfft(uf * kf[None], n=2 * n, axis=1)[:, :n]
    return (y + u.astype(jnp.float32) * bias.astype(jnp.float32)).astype(u.dtype)


def hyena_branch(hy, p):
    n = hy.shape[1]
    u = short_conv(hy, p['hy_conv_w'], p['hy_conv_b'], 1, 1)
    x0, x1, v = jnp.split(u, 3, axis=-1)
    k2 = hyena_filters(n, p)
    return x0 * bidir_long_conv(v * x1, k2, p['hy_bias'])


def block_diag(x, w):
    bsz, n, _ = x.shape
    xb = x.reshape(bsz, n, LRU_BLOCKS, LRU_BLOCK)
    return jnp.einsum('blnk,nkj->blnj', xb, w).reshape(bsz, n, LRU_WIDTH)


def rglru_coeffs(xc, wa, ba, wx, bx, lam):
    f32 = jnp.float32
    r = jax.nn.sigmoid((block_diag(xc, wa) + ba).astype(f32))
    i = jax.nn.sigmoid((block_diag(xc, wx) + bx).astype(f32))
    log_a = -LRU_C * r * jax.nn.softplus(-lam.astype(f32))
    a = jnp.exp(log_a)
    b = jnp.sqrt(-jnp.expm1(2.0 * log_a)) * i * xc.astype(f32)
    return a, b


def linear_scan(a, b, reverse):
    def combine(lhs, rhs):
        return (lhs[0] * rhs[0], rhs[0] * lhs[1] + rhs[1])
    _, h = lax.associative_scan(combine, (a, b), reverse=reverse, axis=1)
    return h


def lru_scan_dir(xc, p, d, h0):
    a, b = rglru_coeffs(xc, p['lru_wa'][d], p['lru_ba'][d], p['lru_wx'][d], p['lru_bx'][d], p['lru_lambda'][d])
    if h0 is not None:
        t0 = 0 if d == 0 else -1
        b = b.at[:, t0].add(a[:, t0] * h0)
    return linear_scan(a, b, reverse=(d == 1))


def merge_branches(gate_logits, attn_o, hy_o, lru_o, p):
    g = jax.nn.sigmoid(gate_logits.astype(jnp.float32)).astype(attn_o.dtype)
    ga, gh, gl = jnp.split(g, N_BRANCH, axis=-1)
    y = ga * (attn_o @ p['w_attn_out']) + gh * (hy_o @ p['w_hy_out']) + gl * (lru_o @ p['w_lru_out'])
    return y @ p['w_out']


def ec_moe(u, p):
    bsz, n, d = u.shape
    cap = max(1, EC_CAPACITY * n // N_EXPERTS)
    aff = jax.nn.softmax((u @ p['router_w']).astype(jnp.float32), axis=-1)
    g, idx = lax.top_k(jnp.swapaxes(aff, 1, 2), cap)
    xs = jax.vmap(lambda ub, ib: ub[ib])(u, idx)
    hid = jax.nn.silu(jnp.einsum('becd,edf->becf', xs, p['exp_w1'])) * jnp.einsum('becd,edf->becf', xs, p['exp_w3'])
    ys = jnp.einsum('becf,efd->becd', hid, p['exp_w2']) * g[..., None].astype(u.dtype)
    return jax.vmap(lambda yb, ib: jnp.zeros((n, d), yb.dtype).at[ib.reshape(-1)].add(yb.reshape(-1, d)))(ys, idx)


def setup_inputs(seed: int = 0) -> dict:
    key = jax.random.key(seed)
    ks = iter(jax.random.split(key, 40))
    f32 = jnp.float32

    def nrm(shape, scale):
        return jax.random.normal(next(ks), shape, f32) * scale

    def gain(shape):
        return 1.0 + 0.02 * jax.random.normal(next(ks), shape, f32)

    x = nrm((BATCH, SEQ, D_MODEL), 1.0)
    c = nrm((BATCH, D_MODEL), 1.0)
    ctx = nrm((BATCH, CTX_LEN, D_MODEL), 1.0)
    c_ctx = nrm((D_MODEL,), 1.0)
    mod_w = nrm((DEPTH, D_MODEL, 6 * D_MODEL), 0.5 * D_MODEL ** -0.5)
    mod_b = nrm((DEPTH, 6 * D_MODEL), 0.02)
    norm1_g = gain((DEPTH, D_MODEL))
    norm2_g = gain((DEPTH, D_MODEL))
    w_in = nrm((DEPTH, D_MODEL, IN_TOTAL), D_MODEL ** -0.5)
    q_norm_g = gain((DEPTH, HEAD_DIM))
    k_norm_g = gain((DEPTH, HEAD_DIM))
    hy_conv_w = nrm((DEPTH, HY_SHORT, 3 * HY_WIDTH), HY_SHORT ** -0.5)
    hy_conv_b = nrm((DEPTH, 3 * HY_WIDTH), 0.02)
    hy_fw1 = nrm((DEPTH, HY_EMB, HY_FILTER_HIDDEN), HY_EMB ** -0.5)
    hy_fb1 = nrm((DEPTH, HY_FILTER_HIDDEN), 0.02)
    hy_fw2 = nrm((DEPTH, HY_FILTER_HIDDEN, HY_FILTER_HIDDEN), HY_FILTER_HIDDEN ** -0.5)
    hy_fb2 = nrm((DEPTH, HY_FILTER_HIDDEN), 0.02)
    hy_fw3 = nrm((DEPTH, HY_FILTER_HIDDEN, 2 * HY_WIDTH), 0.02)
    hy_freq = gain((DEPTH, 2, HY_FILTER_HIDDEN))
    hy_bias = nrm((DEPTH, HY_WIDTH), 0.1)
    lru_conv_w = nrm((DEPTH, LRU_CONV, LRU_WIDTH), LRU_CONV ** -0.5)
    lru_conv_b = nrm((DEPTH, LRU_WIDTH), 0.02)
    lru_wa = nrm((DEPTH, 2, LRU_BLOCKS, LRU_BLOCK, LRU_BLOCK), LRU_BLOCK ** -0.5)
    lru_ba = nrm((DEPTH, 2, LRU_WIDTH), 0.02)
    lru_wx = nrm((DEPTH, 2, LRU_BLOCKS, LRU_BLOCK, LRU_BLOCK), LRU_BLOCK ** -0.5)
    lru_bx = nrm((DEPTH, 2, LRU_WIDTH), 0.02)
    a_c = jax.random.uniform(next(ks), (DEPTH, 2, LRU_WIDTH), f32, 0.9, 0.999)
    a_base = a_c ** (1.0 / LRU_C)
    lru_lambda = jnp.log(a_base) - jnp.log1p(-a_base)
    w_attn_out = nrm((DEPTH, Q_WIDTH, D_MODEL), Q_WIDTH ** -0.5)
    w_hy_out = nrm((DEPTH, HY_WIDTH, D_MODEL), HY_WIDTH ** -0.5)
    w_lru_out = nrm((DEPTH, LRU_WIDTH, D_MODEL), LRU_WIDTH ** -0.5)
    w_out = nrm((DEPTH, D_MODEL, D_MODEL), D_MODEL ** -0.5)
    router_w = nrm((DEPTH, D_MODEL, N_EXPERTS), D_MODEL ** -0.5)
    exp_w1 = nrm((DEPTH, N_EXPERTS, D_MODEL, EXPERT_FF), D_MODEL ** -0.5)
    exp_w3 = nrm((DEPTH, N_EXPERTS, D_MODEL, EXPERT_FF), D_MODEL ** -0.5)
    exp_w2 = nrm((DEPTH, N_EXPERTS, EXPERT_FF, D_MODEL), EXPERT_FF ** -0.5)
    final_norm_g = gain((D_MODEL,))
    return {'x': x, 'c': c, 'ctx': ctx, 'c_ctx': c_ctx, 'mod_w': mod_w, 'mod_b': mod_b,
            'norm1_g': norm1_g, 'norm2_g': norm2_g, 'w_in': w_in, 'q_norm_g': q_norm_g, 'k_norm_g': k_norm_g,
            'hy_conv_w': hy_conv_w, 'hy_conv_b': hy_conv_b, 'hy_fw1': hy_fw1, 'hy_fb1': hy_fb1,
            'hy_fw2': hy_fw2, 'hy_fb2': hy_fb2, 'hy_fw3': hy_fw3, 'hy_freq': hy_freq, 'hy_bias': hy_bias,
            'lru_conv_w': lru_conv_w, 'lru_conv_b': lru_conv_b, 'lru_wa': lru_wa, 'lru_ba': lru_ba,
            'lru_wx': lru_wx, 'lru_bx': lru_bx, 'lru_lambda': lru_lambda,
            'w_attn_out': w_attn_out, 'w_hy_out': w_hy_out, 'w_lru_out': w_lru_out, 'w_out': w_out,
            'router_w': router_w, 'exp_w1': exp_w1, 'exp_w3': exp_w3, 'exp_w2': exp_w2,
            'final_norm_g': final_norm_g}


def reference(x, c, ctx, c_ctx, mod_w, mod_b, norm1_g, norm2_g, w_in, q_norm_g, k_norm_g,
              hy_conv_w, hy_conv_b, hy_fw1, hy_fb1, hy_fw2, hy_fb2, hy_fw3, hy_freq, hy_bias,
              lru_conv_w, lru_conv_b, lru_wa, lru_ba, lru_wx, lru_bx, lru_lambda,
              w_attn_out, w_hy_out, w_lru_out, w_out, router_w, exp_w1, exp_w3, exp_w2, final_norm_g):
    bsz, n_lat, _ = x.shape
    n_ctx = ctx.shape[1]
    ROWS = n_lat // GRID_W
    cos, sin = axial_rope(ROWS)
    cols = in_columns()
    silu_c = jax.nn.silu(c)
    silu_cc = jax.nn.silu(c_ctx)
    h, hc = x, ctx
    for l in range(DEPTH):
        last = l == DEPTH - 1
        p = {'hy_conv_w': hy_conv_w[l], 'hy_conv_b': hy_conv_b[l], 'hy_fw1': hy_fw1[l], 'hy_fb1': hy_fb1[l],
             'hy_fw2': hy_fw2[l], 'hy_fb2': hy_fb2[l], 'hy_fw3': hy_fw3[l], 'hy_freq': hy_freq[l],
             'hy_bias': hy_bias[l], 'lru_wa': lru_wa[l], 'lru_ba': lru_ba[l], 'lru_wx': lru_wx[l],
             'lru_bx': lru_bx[l], 'lru_lambda': lru_lambda[l], 'w_attn_out': w_attn_out[l],
             'w_hy_out': w_hy_out[l], 'w_lru_out': w_lru_out[l], 'w_out': w_out[l], 'router_w': router_w[l],
             'exp_w1': exp_w1[l], 'exp_w3': exp_w3[l], 'exp_w2': exp_w2[l]}
        mod = (silu_c @ mod_w[l] + mod_b[l])[:, None, :]
        sh1, sc1, g1, sh2, sc2, g2 = jnp.split(mod, 6, axis=-1)
        mod_c = silu_cc @ mod_w[l] + mod_b[l]
        csh1, csc1, cg1, csh2, csc2, cg2 = jnp.split(mod_c, 6, axis=-1)

        u = modulate(h, norm1_g[l], sh1, sc1)
        uc = modulate(hc, norm1_g[l], csh1, csc1)
        z = u @ w_in[l]
        zs = {name: z[..., a:b] for name, (a, b) in cols.items()}
        if last:
            w_l = w_in[l]
            zcs = {name: uc @ w_l[:, a:b] for name, (a, b) in cols.items() if name in ('k', 'v', 'rx')}
        else:
            zc = uc @ w_in[l]
            zcs = {name: zc[..., a:b] for name, (a, b) in cols.items()}

        k_c = rms_norm(zcs['k'].reshape(bsz, n_ctx, N_KV_HEADS, HEAD_DIM), k_norm_g[l])
        v_c = zcs['v'].reshape(bsz, n_ctx, N_KV_HEADS, HEAD_DIM)
        xc_c = short_conv(zcs['rx'], lru_conv_w[l], lru_conv_b[l], LRU_PAD_LEFT, LRU_PAD_RIGHT)
        hc_f = lru_scan_dir(xc_c, p, 0, None)
        hc_b = lru_scan_dir(xc_c, p, 1, None)

        q = apply_rope(rms_norm(zs['q'].reshape(bsz, n_lat, N_HEADS, HEAD_DIM), q_norm_g[l]), cos, sin)
        k = apply_rope(rms_norm(zs['k'].reshape(bsz, n_lat, N_KV_HEADS, HEAD_DIM), k_norm_g[l]), cos, sin)
        v = zs['v'].reshape(bsz, n_lat, N_KV_HEADS, HEAD_DIM)
        attn = latent_attention(q, k, v, k_c, v_c)
        hy = hyena_branch(zs['hy'], p)
        xc = short_conv(zs['rx'], lru_conv_w[l], lru_conv_b[l], LRU_PAD_LEFT, LRU_PAD_RIGHT)
        h_f = lru_scan_dir(xc, p, 0, hc_f[:, -1])
        h_b = lru_scan_dir(xc, p, 1, hc_b[:, 0])
        lru = (h_f + h_b).astype(h.dtype) * jax.nn.gelu(zs['rg'])
        h = h + g1 * merge_branches(zs['gate'], attn, hy, lru, p)

        if not last:
            qc = rms_norm(zcs['q'].reshape(bsz, n_ctx, N_HEADS, HEAD_DIM), q_norm_g[l])
            attn_c = attend(qc.reshape(bsz, n_ctx, N_KV_HEADS, GROUP, HEAD_DIM), k_c, v_c).reshape(bsz, n_ctx, Q_WIDTH)
            hy_c = hyena_branch(zcs['hy'], p)
            lru_c = (hc_f + hc_b).astype(hc.dtype) * jax.nn.gelu(zcs['rg'])
            hc = hc + cg1 * merge_branches(zcs['gate'], attn_c, hy_c, lru_c, p)

        u2 = modulate(h, norm2_g[l], sh2, sc2)
        h = h + g2 * ec_moe(u2, p)
        if not last:
            uc2 = modulate(hc, norm2_g[l], csh2, csc2)
            hc = hc + cg2 * ec_moe(uc2, p)
    return rms_norm(h, final_norm_g)
```

```cpp
#include <hip/hip_runtime.h>
#include <cstdio>
#include <cstdint>

#define GAS __attribute__((address_space(1)))
#define LAS __attribute__((address_space(3)))
typedef unsigned short bf16_t;
typedef short bf16x8 __attribute__((ext_vector_type(8)));
typedef short s16x4 __attribute__((ext_vector_type(4)));
typedef float f32x16 __attribute__((ext_vector_type(16)));
typedef float f32x4 __attribute__((ext_vector_type(4)));
typedef float f32x2 __attribute__((ext_vector_type(2)));
typedef unsigned u32x4 __attribute__((ext_vector_type(4)));
typedef unsigned u32x2 __attribute__((ext_vector_type(2)));

#ifndef MK_ONE_LAUNCH
#define MK_ONE_LAUNCH 1
#endif

constexpr int NB = 16, SEQ = 4096, DM = 1024, DEPTH = 4, CTX = 256, TOK = SEQ + CTX;
constexpr int NCH = 1, BC = NB / NCH, RC = BC * TOK, PANELS = RC / 256;
constexpr int IN_TOTAL = 7168, GRIDW = 64;
constexpr int NE = 16, CAP_L = 512, CAP_C = 32, XPB = CAP_L + CAP_C, XROWS = BC * XPB;
constexpr float NORM_EPS = 1e-6f;
static_assert(RC % 256 == 0 && XROWS % 256 == 0 && TOK % 256 == 0, "panel alignment");

enum { I_X = 0, I_C, I_CTX, I_CCTX, I_MODW, I_MODB, I_N1G, I_N2G, I_WIN, I_QNG, I_KNG, I_HYCW, I_HYCB, I_FW1, I_FB1, I_FW2, I_FB2, I_FW3, I_FREQ, I_HYBIAS,
       I_LCW, I_LCB, I_LWA, I_LBA, I_LWX, I_LBX, I_LLAM, I_WAO, I_WHO, I_WLO, I_WOUT, I_ROUT, I_EW1, I_EW3, I_EW2, I_FNG, N_IN };
static_assert(N_IN == 36, "36 inputs");

constexpr size_t MiB = (size_t)1 << 20;
constexpr size_t WS_CTL = 0, CTL_ZERO_BYTES = 1 * MiB;
constexpr size_t WS_HC = 1 * MiB;
constexpr size_t WS_MOD = 17 * MiB;
constexpr size_t WS_FRL = 19 * MiB;
constexpr size_t WS_FRC = 35 * MiB;
constexpr size_t WS_ROPE = 30 * MiB;
constexpr size_t WS_WIN = 36 * MiB;
constexpr size_t WS_SWIN = 44 * MiB;
constexpr size_t WS_WINB = 88 * MiB;
constexpr size_t CH_HRES = 952 * MiB;
constexpr size_t CH_UB = 952 * MiB;
constexpr size_t WS_SUN = 35 * MiB + 640 * 1024;
constexpr size_t WS_WA = 50 * MiB, WS_WH = 52 * MiB, WS_WL = 53 * MiB, WS_WO = 54 * MiB;
constexpr size_t WS_W13 = 56 * MiB;
constexpr size_t WS_SW13 = 96 * MiB;
constexpr size_t WS_W2 = 120 * MiB;
constexpr size_t WS_CH = 152 * MiB;
constexpr size_t CH_U = 0, CH_Q = 136 * MiB, CH_K = 272 * MiB, CH_V = 306 * MiB, CH_HY = 340 * MiB, CH_RG = 544 * MiB, CH_X0 = 612 * MiB, CH_P = 680 * MiB, CH_XC = 748 * MiB,
                 CH_RX = 816 * MiB, CH_HYO = 884 * MiB, CH_END = 952 * MiB, CH_GATE = 272 * MiB;
constexpr size_t CH_YSUM = 680 * MiB;
constexpr size_t CH_DLT = 272 * MiB;
constexpr size_t CH_HL = CH_RX;
constexpr size_t CH_HF = CH_HY, CH_HB = CH_HY + 68 * MiB, CH_YT = CH_HY + 136 * MiB, CH_LRUO = CH_RX, CH_Y = CH_U;
constexpr size_t CH_U2 = 0, CH_AFF = 136 * MiB, CH_SU = 140 * MiB + MiB / 2, CH_ROWSRC = 141 * MiB, CH_GATEV = 141 * MiB + 3 * MiB / 4, CH_XSCL = 142 * MiB + MiB / 2, CH_INV = 143 * MiB + MiB / 4, CH_HID = 148 * MiB, CH_YS = 420 * MiB;
constexpr size_t WS_END = WS_CH + CH_END + 136 * MiB;
static_assert((size_t)RC * 1024 * 2 == 136 * MiB && (size_t)NE * XROWS * 1024 * 2 == 272 * MiB && CH_YS + 272 * MiB <= CH_END && CH_GATE + 408 * MiB <= CH_RG + 136 * MiB, "buffer sizes");
constexpr int CW_BAR = 4096;
constexpr size_t WS_TAB = WS_MOD + 2 * MiB - 4096;

constexpr int RING_BYTES = 131072, LDSCTL_OFF = 146432, LDS_BYTES = 147456;

__device__ __forceinline__ float bf2f(bf16_t v) { return __uint_as_float(((unsigned)v) << 16); }
__device__ __forceinline__ float bflo(unsigned w) { return __uint_as_float(w << 16); }
__device__ __forceinline__ float bfhi(unsigned w) { return __uint_as_float(w & 0xffff0000u); }
__device__ __forceinline__ unsigned cvt_pk_bf16(float lo, float hi) { unsigned r; asm volatile("v_cvt_pk_bf16_f32 %0, %1, %2" : "=v"(r) : "v"(lo), "v"(hi)); return r; }
__device__ __forceinline__ unsigned cvt_pk_bf16_nv(float lo, float hi) { unsigned r; asm("v_cvt_pk_bf16_f32 %0, %1, %2" : "=v"(r) : "v"(lo), "v"(hi)); return r; }
__device__ __forceinline__ bf16_t f2bf(float f) { return (bf16_t)(cvt_pk_bf16_nv(f, 0.f) & 0xffffu); }
__device__ __forceinline__ float sigmoid_f(float x) { return __builtin_amdgcn_rcpf(1.f + __builtin_amdgcn_exp2f(-1.4426950408889634f * x)); }
__device__ __forceinline__ float silu_f(float x) { return x * sigmoid_f(x); }
__device__ __forceinline__ float gelu_tanh_f(float x) { return x * sigmoid_f(1.5957691216057308f * (x + 0.044715f * x * x * x)); }
__device__ __forceinline__ void sincos_rr(float x, float& s, float& c) {
    const float k = rintf(x * 0.15915494309189535f);
    float r = fmaf(-k, 6.2831854820251465f, x); r = fmaf(-k, -1.7484556000744083e-07f, r);
    s = __sinf(r); c = __cosf(r);
}
template <int CTRL> __device__ __forceinline__ float dpp_f(float v) { return __int_as_float(__builtin_amdgcn_update_dpp(0, __float_as_int(v), CTRL, 0xF, 0xF, true)); }
__device__ __forceinline__ float row16_sum(float v) {
    v += dpp_f<0xB1>(v); v += dpp_f<0x4E>(v); v += dpp_f<0x141>(v); v += dpp_f<0x140>(v); return v;
}
template <int CTRL> __device__ __forceinline__ int dpp_i(int v) { return __builtin_amdgcn_update_dpp(0, v, CTRL, 0xF, 0xF, true); }
__device__ __forceinline__ float row16_sum_i(int v) { v += dpp_i<0xB1>(v); v += dpp_i<0x4E>(v); v += dpp_i<0x141>(v); v += dpp_i<0x140>(v); return __int_as_float(v); }
__device__ __forceinline__ float row16_xor8(float v) { return dpp_f<0x128>(v); }
__device__ __forceinline__ float wave_sum(float v) { v = row16_sum(v); v += __shfl_xor(v, 16); v += __shfl_xor(v, 32); return v; }
#define LDS_WAIT() asm volatile("s_waitcnt lgkmcnt(0)" ::: "memory")
#define VM_WAIT() asm volatile("s_waitcnt vmcnt(0)" ::: "memory")
#define XB_TMO      128
#define XB_XCNT(j)  (256  + 64 * (j))
#define XB_XSUB(j)  (1280 + 64 * (j))
#define XB_XGEN(j)  (2304 + 64 * (j))
#define XB_TOP      3328
#define XB_TOPGEN   3392
#define XCD_BAR_WORDS 3456
#define XB_SPIN_CAP (1u << 18)

__device__ __forceinline__ unsigned xb_ld(unsigned* p)              { return __hip_atomic_load(p, __ATOMIC_RELAXED, __HIP_MEMORY_SCOPE_AGENT); }
__device__ __forceinline__ unsigned xb_add(unsigned* p, unsigned v) { return __hip_atomic_fetch_add(p, v, __ATOMIC_RELAXED, __HIP_MEMORY_SCOPE_AGENT); }
__device__ __forceinline__ unsigned xb_xcc_id() { return (unsigned)__builtin_amdgcn_s_getreg((3 << 11) | 20) & 0xFu; }
#define XB_SPIN(cond, bar) do { unsigned _sp = 0; while (cond) { __builtin_amdgcn_s_sleep(1); \
    if ((++_sp & 255u) == 0u) { if (xb_ld(&(bar)[XB_TMO])) break; if (_sp > XB_SPIN_CAP) { atomicAdd(&(bar)[XB_TMO], 1u); break; } } } } while (0)

struct XcdBarrier {
    unsigned* bar; unsigned x;
    volatile LAS unsigned* st;
};

__device__ __forceinline__ XcdBarrier xcd_barrier_post(unsigned* bar, volatile LAS unsigned* st) {
    XcdBarrier b; b.bar = bar; b.x = xb_xcc_id(); b.st = st;
    if (threadIdx.x == 0) (void)xb_add(&bar[XB_XCNT(b.x)], 1u);
    return b;
}
__device__ __forceinline__ void xcd_barrier_complete(unsigned* bar, unsigned x, unsigned& nloc, unsigned& nx) {
    const unsigned G = gridDim.x * gridDim.y * gridDim.z;
    unsigned sum, cnt, mine, sp = 0u;
    for (;;) {
        sum = 0u; cnt = 0u; mine = 0u;
#pragma unroll
        for (unsigned j = 0; j < 16; ++j) { const unsigned c = xb_ld(&bar[XB_XCNT(j)]); sum += c; cnt += (c > 0u) ? 1u : 0u; mine = (j == x) ? c : mine; }
        if (sum == G) break;
        __builtin_amdgcn_s_sleep(1);
        if ((++sp & 255u) == 0u) { if (xb_ld(&bar[XB_TMO])) break; if (sp > XB_SPIN_CAP) { atomicAdd(&bar[XB_TMO], 1u); break; } }
    }
    nloc = mine > 0u ? mine : 1u; nx = cnt > 0u ? cnt : 1u;
}

__device__ __forceinline__ void xcd_barrier(const XcdBarrier& b) {
    asm volatile("s_waitcnt vmcnt(0)" ::: "memory");
    __syncthreads();
    if (threadIdx.x == 0) {
        unsigned* bar = b.bar;
        __builtin_amdgcn_s_waitcnt(0);
        unsigned nloc = b.st[0], nx = b.st[1];
        if (nloc == 0u) { xcd_barrier_complete(bar, b.x, nloc, nx); b.st[0] = nloc; b.st[1] = nx; }
        const unsigned old = xb_add(&bar[XB_XSUB(b.x)], 1u);
        const unsigned gen = old / nloc;
        if (old + 1u == (gen + 1u) * nloc) {
            __builtin_amdgcn_fence(__ATOMIC_RELEASE, "agent");
            asm volatile("s_waitcnt vmcnt(0)" ::: "memory");
            const unsigned og = xb_add(&bar[XB_TOP], 1u);
            const unsigned tg = og / nx;
            if (og + 1u == (tg + 1u) * nx) xb_add(&bar[XB_TOPGEN], 1u);
            else XB_SPIN(xb_ld(&bar[XB_TOPGEN]) == tg, bar);
            __builtin_amdgcn_fence(__ATOMIC_ACQUIRE, "agent");
            xb_add(&bar[XB_XGEN(b.x)], 1u);
            asm volatile("s_waitcnt vmcnt(0)" ::: "memory");
        } else {
            XB_SPIN(xb_ld(&bar[XB_XGEN(b.x)]) == gen, bar);
            __builtin_amdgcn_fence(__ATOMIC_ACQUIRE, "agent");
            asm volatile("s_waitcnt vmcnt(0)" ::: "memory");
        }
    }
    __syncthreads();
}
namespace pg8 {
#define PG8_LAS __attribute__((address_space(3)))
constexpr int BM = 256, BK = 64, HALF = 128, HTB = HALF * BK * 2  , STAGE_BYTES = 8 * HTB, NXCD = 8, WGM = 8;
__host__ __device__ __forceinline__ int lds_byte(int r, int c) { const int st = (r >> 4) * 2 + (c >> 5), rr = r & 15, cc = c & 31, ob = rr * 64 + cc * 2; return st * 1024 + (ob ^ (((ob >> 9) & 1) << 5)); }
__host__ __device__ __forceinline__ void stage_rc(int b, int& R, int& C) { const int st = b / 1024, sb = b % 1024, swz = sb ^ (((sb >> 9) & 1) << 5); R = (st >> 1) * 16 + swz / 64; C = (st & 1) * 32 + (swz % 64) / 2; }
__host__ __device__ __forceinline__ int perm32(int rho) { const int n = rho >> 4, i = rho & 15; return 8 * (i >> 2) + 4 * n + (i & 3); }
struct Unit { int pm, pn; };
struct StaticOrder {
    int nM, nN, nwg, G, c;
    __host__ __device__ void init(int nM_, int nN_, int G_, int c_) { nM = nM_; nN = nN_; nwg = nM * nN; G = G_; c = c_; }
    __host__ __device__ bool next(int i, Unit& u) const {
        const long L = (long)i * G + c; if (L >= nwg) return false;
        int wgid = (int)L; { const int q = nwg / NXCD, r = nwg % NXCD, xcd = wgid % NXCD, off = wgid / NXCD; wgid = (xcd < r ? xcd * (q + 1) : r * (q + 1) + (xcd - r) * q) + off; }
        const int nig = WGM * nN, gid = wgid / nig, fm = gid * WGM, gsz = (nM - fm) < WGM ? (nM - fm) : WGM;
        u.pm = fm + ((wgid % nig) % gsz); u.pn = (wgid % nig) / gsz; return true;
    }
    __device__ __forceinline__ void a_ready(const Unit&) const {}
    __device__ __forceinline__ void done(const Unit&) const {}
};
struct MappedOrder : StaticOrder {
    int mode;
    __host__ __device__ bool next(int i, Unit& u) const {
        if (!StaticOrder::next(i, u)) return false;
        if (mode == 1) u.pm = 17 * (u.pm >> 4) + 1 + (u.pm & 15); else if (mode == 2) u.pm = 34 * (u.pm >> 5) + (u.pm & 31);
        return true; }
};
typedef int i32x4 __attribute__((ext_vector_type(4)));
template <bool I8> struct AccSel { typedef f32x4 type; };
template <> struct AccSel<true> { typedef i32x4 type; };
template <class GemmT, class Epi, class Sched, bool ALIGN_EPI = true, bool SP2 = true>
__device__ __forceinline__ void gemm_phase(PG8_LAS unsigned char* lds, const GemmT g, const Sched& S, const Epi& E, int tid_in) {
    int tid_ = tid_in; asm volatile("" : "+v"(tid_));
    const int tid = tid_, wid = __builtin_amdgcn_readfirstlane(tid >> 6), lane = tid & 63, wr = wid >> 2, wc = wid & 3, fr = lane & 15, fq = lane >> 4;
    constexpr int ESZ = GemmT::ESZ;
    constexpr bool I8 = (ESZ == 1);
    constexpr bool GATHER = GemmT::GATHER;
    constexpr int NSEG = GemmT::NSEG;
    const int K = g.K, nt1 = K * ESZ / (BK * 2), nt = NSEG * nt1;
    static_assert(!GATHER || SP2, "the gathered-A form is written for the SP2 loop only");
    unsigned voffB[2], gA[2][2], gAn[2][2]; int sR[2], sC[2];
#pragma unroll
    for (int i = 0; i < 2; ++i) { int R, C; stage_rc(tid * 16 + i * 8192, R, C); const int Rb = Epi::PERM ? ((R & ~31) + perm32(R & 31)) : R; sR[i] = R; sC[i] = C;
        voffB[i] = (unsigned)(Rb * K * ESZ + C * 2); gA[0][i] = gA[1][i] = gAn[0][i] = gAn[1][i] = (unsigned)(R * K * ESZ + C * 2); }
    const size_t kstep = (size_t)(BK * 2);
    const size_t hstep = (size_t)HALF * K * ESZ;
    const size_t hA = GATHER ? (size_t)0 : hstep;
    const size_t tstep = 2 * hstep;
    long dA = 0, dB = 0; if constexpr (NSEG == 2) { dA = g.seg_delta_a() - (long)nt1 * (long)kstep; dB = g.seg_delta_b() - (long)nt1 * (long)kstep; }
    const unsigned ldsw = (unsigned)wid * 1024u;
    const int aoff = lds_byte(wr * 64 + fr, fq * 8), boff = lds_byte(wc * 32 + fr, fq * 8);
#define PG8_SA(b, h) (((b) * 2 + (h)) * HTB)
#define PG8_SB(b, h) ((4 + (b) * 2 + (h)) * HTB)
#define PG8_STAGE(bufoff, gbase, voff) do { _Pragma("unroll") for (int _i = 0; _i < 2; ++_i) \
        __builtin_amdgcn_global_load_lds((const unsigned*)((const char*)(gbase) + (voff)[_i]), (PG8_LAS unsigned*)(lds + (bufoff) + ldsw + _i * 8192), 16, 0, 0); } while (0)
#define PG8_LDA(dst, b, h) do { _Pragma("unroll") for (int m = 0; m < 4; ++m) _Pragma("unroll") for (int k = 0; k < 2; ++k) dst[m][k] = *(const PG8_LAS bf16x8*)(lds + PG8_SA(b, h) + aoff + m * 2048 + k * 1024); } while (0)
#define PG8_LDB(dst, b, h) do { _Pragma("unroll") for (int n = 0; n < 2; ++n) _Pragma("unroll") for (int k = 0; k < 2; ++k) dst[n][k] = *(const PG8_LAS bf16x8*)(lds + PG8_SB(b, h) + boff + n * 2048 + k * 1024); } while (0)
#define PG8_MMA(ai, bj, At, Bt) do { __builtin_amdgcn_s_setprio(1); _Pragma("unroll") for (int m = 0; m < 4; ++m) _Pragma("unroll") for (int n = 0; n < 2; ++n) _Pragma("unroll") for (int k = 0; k < 2; ++k) { \
        if constexpr (I8) acc[ai][bj][m][n] = __builtin_amdgcn_mfma_i32_16x16x64_i8(__builtin_bit_cast(i32x4, Bt[n][k]), __builtin_bit_cast(i32x4, At[m][k]), acc[ai][bj][m][n], 0, 0, 0); \
        else acc[ai][bj][m][n] = __builtin_amdgcn_mfma_f32_16x16x32_bf16(Bt[n][k], At[m][k], acc[ai][bj][m][n], 0, 0, 0); } __builtin_amdgcn_s_setprio(0); } while (0)
#define PG8_WAIT_V(n) asm volatile("s_waitcnt vmcnt(" #n ")" ::: "memory")
#define PG8_WAIT_L(n) asm volatile("s_waitcnt lgkmcnt(" #n ")" ::: "memory")
#define PG8_BAR __builtin_amdgcn_s_barrier()
#define PG8_SCHED __builtin_amdgcn_sched_barrier(0)
    Unit cur, nxt; int ui = 0;
    if (!S.next(0, cur)) return;
    typedef typename AccSel<I8>::type acc_t;
    acc_t acc[2][2][4][2];
#pragma unroll
    for (int a = 0; a < 2; ++a)
#pragma unroll
        for (int b = 0; b < 2; ++b)
#pragma unroll
            for (int m = 0; m < 4; ++m)
#pragma unroll
                for (int n = 0; n < 2; ++n) acc[a][b][m][n] = (acc_t){0, 0, 0, 0};
    bf16x8 At[4][2], B0[2][2], B1[2][2];
    const char* cA = g.a_tile(cur); const char* cB = g.b_tile(cur);
    S.a_ready(cur);
    if constexpr (GATHER) {
            { int r4[2][2];
#pragma unroll
        for (int h = 0; h < 2; ++h)
#pragma unroll
            for (int i = 0; i < 2; ++i) r4[h][i] = g.a_row(cur, h * HALF + sR[i]);
        asm volatile("" ::: "memory");
#pragma unroll
        for (int h = 0; h < 2; ++h)
#pragma unroll
            for (int i = 0; i < 2; ++i) gA[h][i] = (unsigned)(r4[h][i] * K * ESZ + sC[i] * 2); }
        PG8_WAIT_V(0); }
    if constexpr (SP2) {
        PG8_STAGE(PG8_SB(0, 0), cB, voffB); PG8_STAGE(PG8_SB(0, 1), cB + hstep, voffB); PG8_STAGE(PG8_SA(0, 0), cA, gA[0]); PG8_STAGE(PG8_SA(0, 1), cA + hA, gA[1]);
        if (wr == 1) PG8_BAR;
        PG8_WAIT_V(2); PG8_BAR;
        PG8_STAGE(PG8_SB(1, 0), cB + kstep, voffB); PG8_STAGE(PG8_SA(1, 0), cA + kstep, gA[0]); PG8_STAGE(PG8_SB(1, 1), cB + hstep + kstep, voffB);
        PG8_WAIT_V(6); PG8_BAR;
    } else {
        PG8_STAGE(PG8_SB(0, 0), cB, voffB); PG8_STAGE(PG8_SA(0, 0), cA, gA[0]); PG8_STAGE(PG8_SB(0, 1), cB + hstep, voffB); PG8_STAGE(PG8_SA(0, 1), cA + hstep, gA[0]);
        if (wr == 1) PG8_BAR;
        PG8_WAIT_V(4); PG8_BAR;
        PG8_STAGE(PG8_SB(1, 0), cB + kstep, voffB); PG8_STAGE(PG8_SA(1, 0), cA + kstep, gA[0]); PG8_STAGE(PG8_SB(1, 1), cB + hstep + kstep, voffB);
        PG8_WAIT_V(6); PG8_BAR;
    }
    for (;;) {
        const bool has_next = S.next(ui + 1, nxt);
        const char* nA = has_next ? g.a_tile(nxt) : cA; const char* nB = has_next ? g.b_tile(nxt) : cB;
        if constexpr (GATHER) {
                { int r4[2][2];
#pragma unroll
            for (int h = 0; h < 2; ++h)
#pragma unroll
                for (int i = 0; i < 2; ++i) r4[h][i] = has_next ? g.a_row(nxt, h * HALF + sR[i]) : 0;
            asm volatile("" ::: "memory");
#pragma unroll
            for (int h = 0; h < 2; ++h)
#pragma unroll
                for (int i = 0; i < 2; ++i) gAn[h][i] = has_next ? (unsigned)(r4[h][i] * K * ESZ + sC[i] * 2) : gA[h][i]; }
            PG8_WAIT_V(0); }
#pragma unroll 1
        for (int sg = 0; sg < (NSEG == 2 ? 3 : 1); ++sg) {
        const int tb = NSEG == 2 ? (sg == 0 ? 0 : sg == 1 ? nt1 : nt1 + nt1 / 2) : 0, te = NSEG == 2 ? (sg == 0 ? nt1 : sg == 1 ? nt1 + nt1 / 2 : nt) : nt;
#pragma unroll 1
        for (int t = tb; t < te; t += 2) {
            const bool last = (t == nt - 2);
            const long sAc = (NSEG == 2 && t >= nt1) ? dA : 0, sAn = (NSEG == 2 && t + 2 >= nt1) ? dA : 0, sBn = (NSEG == 2 && t + 2 >= nt1) ? dB : 0;
            const char* a1 = cA + sAc + (size_t)(t + 1) * kstep;
            const char* a2 = last ? nA : cA + sAn + (size_t)(t + 2) * kstep; const char* b2 = last ? nB : cB + sBn + (size_t)(t + 2) * kstep;
            const char* a3 = a2 + kstep; const char* b3 = b2 + kstep;
            if (last && has_next) S.a_ready(nxt);
            unsigned g2[2][2];
#pragma unroll
            for (int h = 0; h < 2; ++h)
#pragma unroll
                for (int i = 0; i < 2; ++i) g2[h][i] = (GATHER && last) ? gAn[h][i] : gA[h][i];
            if constexpr (SP2) {
            PG8_LDB(B0, 0, 0); PG8_LDB(B1, 0, 1); PG8_SCHED; PG8_LDA(At, 0, 0); PG8_STAGE(PG8_SA(1, 1), a1 + hA, gA[1]);
            PG8_WAIT_V(8); PG8_WAIT_L(0); PG8_BAR; PG8_MMA(0, 0, At, B0); PG8_MMA(0, 1, At, B1); PG8_BAR; PG8_SCHED;
            PG8_LDA(At, 0, 1); PG8_STAGE(PG8_SB(0, 0), b2, voffB); PG8_STAGE(PG8_SB(0, 1), b2 + hstep, voffB); PG8_STAGE(PG8_SA(0, 0), a2, g2[0]);
            PG8_WAIT_V(8); PG8_WAIT_L(0); PG8_BAR; PG8_MMA(1, 0, At, B0); PG8_MMA(1, 1, At, B1); PG8_BAR; PG8_SCHED;
            PG8_LDB(B0, 1, 0); PG8_LDB(B1, 1, 1); PG8_SCHED; PG8_LDA(At, 1, 0); PG8_STAGE(PG8_SA(0, 1), a2 + hA, g2[1]);
            PG8_WAIT_V(8); PG8_WAIT_L(0); PG8_BAR; PG8_MMA(0, 0, At, B0); PG8_MMA(0, 1, At, B1); PG8_BAR; PG8_SCHED;
            PG8_LDA(At, 1, 1); PG8_STAGE(PG8_SB(1, 0), b3, voffB); PG8_STAGE(PG8_SB(1, 1), b3 + hstep, voffB); PG8_STAGE(PG8_SA(1, 0), a3, g2[0]);
            PG8_WAIT_V(8); PG8_WAIT_L(0); PG8_BAR; PG8_MMA(1, 0, At, B0); PG8_MMA(1, 1, At, B1); PG8_BAR; PG8_SCHED;
            } else {
            PG8_LDB(B0, 0, 0); PG8_SCHED; PG8_LDA(At, 0, 0); PG8_STAGE(PG8_SA(1, 1), a1 + hstep, gA[0]);
            PG8_WAIT_L(8); PG8_BAR; PG8_WAIT_L(0); PG8_MMA(0, 0, At, B0); PG8_BAR; PG8_SCHED;
            PG8_LDB(B1, 0, 1); PG8_STAGE(PG8_SB(0, 0), b2, voffB);
            PG8_BAR; PG8_WAIT_L(0); PG8_MMA(0, 1, At, B1); PG8_BAR;
            PG8_LDA(At, 0, 1); PG8_STAGE(PG8_SA(0, 0), a2, gA[0]);
            PG8_BAR; PG8_WAIT_L(0); PG8_MMA(1, 0, At, B0); PG8_BAR; PG8_SCHED;
            PG8_STAGE(PG8_SB(0, 1), b2 + hstep, voffB);
            PG8_WAIT_V(6); PG8_BAR; PG8_MMA(1, 1, At, B1); PG8_BAR;
            PG8_LDB(B0, 1, 0); PG8_SCHED; PG8_LDA(At, 1, 0); PG8_STAGE(PG8_SA(0, 1), a2 + hstep, gA[0]);
            PG8_WAIT_L(8); PG8_BAR; PG8_WAIT_L(0); PG8_MMA(0, 0, At, B0); PG8_BAR; PG8_SCHED;
            PG8_LDB(B1, 1, 1); PG8_STAGE(PG8_SB(1, 0), b3, voffB);
            PG8_BAR; PG8_WAIT_L(0); PG8_MMA(0, 1, At, B1); PG8_BAR;
            PG8_LDA(At, 1, 1); PG8_STAGE(PG8_SA(1, 0), a3, gA[0]);
            PG8_BAR; PG8_WAIT_L(0); PG8_MMA(1, 0, At, B0); PG8_BAR; PG8_SCHED;
            PG8_STAGE(PG8_SB(1, 1), b3 + hstep, voffB);
            PG8_WAIT_V(6); PG8_BAR; PG8_MMA(1, 1, At, B1); PG8_BAR;
            }
        }
        if constexpr (NSEG == 2) { if (sg < 2) { PG8_SCHED; E.mid(acc, cur, sg, wr, wc, fr, fq); PG8_SCHED; } }
        }
        if constexpr (ALIGN_EPI) { if (wr == 0) PG8_BAR; }
        if constexpr (!Epi::AFTER_DRAIN) {
            if constexpr (I8) { f32x4 accf[2][2][4][2];
#pragma unroll
                for (int a = 0; a < 2; ++a)
#pragma unroll
                    for (int b = 0; b < 2; ++b)
#pragma unroll
                        for (int m = 0; m < 4; ++m)
#pragma unroll
                            for (int n = 0; n < 2; ++n) accf[a][b][m][n] = (f32x4){(float)acc[a][b][m][n][0], (float)acc[a][b][m][n][1], (float)acc[a][b][m][n][2], (float)acc[a][b][m][n][3]};
                E(accf, cur, wr, wc, fr, fq); }
            else E(acc, cur, wr, wc, fr, fq);
            S.done(cur); }
        if (!has_next) break;
#pragma unroll
        for (int a = 0; a < 2; ++a)
#pragma unroll
            for (int b = 0; b < 2; ++b)
#pragma unroll
                for (int m = 0; m < 4; ++m)
#pragma unroll
                    for (int n = 0; n < 2; ++n) acc[a][b][m][n] = (acc_t){0, 0, 0, 0};
        cur = nxt; cA = nA; cB = nB; ++ui;
        if constexpr (GATHER) {
#pragma unroll
            for (int h = 0; h < 2; ++h)
#pragma unroll
                for (int i = 0; i < 2; ++i) gA[h][i] = gAn[h][i]; }
        if constexpr (ALIGN_EPI) { if (wr == 1) PG8_BAR; }
    }
    PG8_WAIT_V(0);
    if constexpr (!ALIGN_EPI) { if (wr == 0) PG8_BAR; }
    PG8_BAR;
    if constexpr (Epi::AFTER_DRAIN) { static_assert(!Epi::AFTER_DRAIN || !I8, "no int8 after-drain epilogues"); }
#undef PG8_SA
#undef PG8_SB
#undef PG8_STAGE
#undef PG8_LDA
#undef PG8_LDB
#undef PG8_MMA
#undef PG8_WAIT_V
#undef PG8_WAIT_L
#undef PG8_BAR
#undef PG8_SCHED
}
}
namespace att {
constexpr int D = 128, NW = 8, QBLK = 32, KVBLK = 64;
constexpr float SCALE = 0.088388347648318440f;
constexpr float THR = 8.f;
constexpr int SDEPTH = 2;
constexpr int LDQ = 1024, LDK = 256, LDO = 1024;
constexpr size_t SHM_V = KVBLK * D * 2, SHM_K = KVBLK * D * 2, SHM_ATTN = 2 * SHM_V + 2 * SHM_K + NW * 64 * 4;
typedef bf16_t bf16;
__device__ __forceinline__ unsigned cvtpk(float lo, float hi) { return cvt_pk_bf16(lo, hi); }
struct St { using T = bf16x8;
  __device__ static __forceinline__ T ld8(const bf16* p) { return *reinterpret_cast<const bf16x8*>(p); }
  __device__ static __forceinline__ bf16x8 tobf(T x) { return x; } };
#define KSWZ(row, colB) ((row) * 256 + ((colB) ^ (((row) & 7) << 4)))
#define SBAR() __builtin_amdgcn_sched_barrier(0)
__device__ __forceinline__ int crow(int r, int hi) { return (r & 3) + 8 * (r >> 2) + 4 * hi; }
__device__ __forceinline__ void partialSM(f32x16& p0, f32x16& p1, float& m_reg, float& mn, float& alpha) {
  constexpr float C = SCALE * 1.4426950408889634f;
  float pmax = p0[0]; for (int r = 1; r < 16; ++r) pmax = fmaxf(pmax, p0[r]); for (int r = 0; r < 16; ++r) pmax = fmaxf(pmax, p1[r]);
  { auto rr = __builtin_amdgcn_permlane32_swap(__float_as_uint(pmax), __float_as_uint(pmax), false, false);
    pmax = fmaxf(__uint_as_float(rr[0]), __uint_as_float(rr[1])); }
  if (__builtin_expect(__all(pmax - m_reg <= THR / SCALE), 1)) { mn = m_reg; alpha = 1.f; }
  else { mn = fmaxf(m_reg, pmax); alpha = __builtin_amdgcn_exp2f((m_reg - mn) * C); m_reg = mn; }
  float mnC = -mn * C;
  for (int r = 0; r < 16; ++r) p0[r] = fmaf(p0[r], C, mnC); for (int r = 0; r < 16; ++r) p1[r] = fmaf(p1[r], C, mnC);
  for (int r = 0; r < 16; ++r) p0[r] = __builtin_amdgcn_exp2f(p0[r]);
}
__device__ __forceinline__ void finishSM(f32x16& p0, f32x16& p1, float alpha, float& l_reg, bf16x8& pa0, bf16x8& pa1, bf16x8& pa2, bf16x8& pa3) {
  for (int r = 0; r < 16; ++r) p1[r] = __builtin_amdgcn_exp2f(p1[r]);
  float ps = 0; for (int r = 0; r < 16; ++r) ps += p0[r]; for (int r = 0; r < 16; ++r) ps += p1[r];
  { auto rr = __builtin_amdgcn_permlane32_swap(__float_as_uint(ps), __float_as_uint(ps), false, false);
    ps = __uint_as_float(rr[0]) + __uint_as_float(rr[1]); }
  l_reg = l_reg * alpha + ps;
#define PK4(P, BASE, OUT) do { unsigned a0 = cvtpk(P[BASE + 0], P[BASE + 1]), a1 = cvtpk(P[BASE + 2], P[BASE + 3]);   \
    unsigned b0 = cvtpk(P[BASE + 4], P[BASE + 5]), b1 = cvtpk(P[BASE + 6], P[BASE + 7]);                              \
    auto r0 = __builtin_amdgcn_permlane32_swap(a0, b0, false, false); auto r1 = __builtin_amdgcn_permlane32_swap(a1, b1, false, false); \
    u32x4 w = {r0[0], r1[0], r0[1], r1[1]}; OUT = *reinterpret_cast<bf16x8*>(&w); } while (0)
  PK4(p0, 0, pa0); PK4(p0, 8, pa1); PK4(p1, 0, pa2); PK4(p1, 8, pa3);
#undef PK4
}
__device__ __forceinline__ void qkt(f32x16& p0, f32x16& p1, const bf16* Ks, const bf16x8* qr, int r32, int hi) {
  p0 = f32x16{}; p1 = f32x16{};
  for (int d0 = 0; d0 < 8; ++d0) { int cb = (d0 * 16 + hi * 8) * 2;
    bf16x8 b0 = *reinterpret_cast<const bf16x8*>((const char*)Ks + KSWZ(r32, cb));
    bf16x8 b1 = *reinterpret_cast<const bf16x8*>((const char*)Ks + KSWZ(32 + r32, cb));
    p0 = __builtin_amdgcn_mfma_f32_32x32x16_bf16(b0, qr[d0], p0, 0, 0, 0);
    p1 = __builtin_amdgcn_mfma_f32_32x32x16_bf16(b1, qr[d0], p1, 0, 0, 0); }
}
__device__ __forceinline__ int v_st(int k, int c) { const int kk = (k & ~0xC) | ((k & 4) << 1) | ((k & 8) >> 1); return ((kk >> 3) * 4 + (c >> 5)) * 512 + ((kk & 7) * 32 + (c & 31)) * 2; }
__device__ __forceinline__ int v_rd_base(int lane) { return ((lane & 3) << 3) | (((lane >> 2) & 3) << 6) | (((lane >> 4) & 1) << 5) | (((lane >> 5) & 1) << 8); }
constexpr int v_rd_off(int d0, int ks, int half) { return d0 * 512 + ks * 4096 + half * 2048; }
template <int OFF> __device__ __forceinline__ s16x4 tr_read(int vb) {
  s16x4 r; asm volatile("ds_read_b64_tr_b16 %0, %1 offset:%2" : "=&v"(r) : "v"(vb), "i"(OFF) : "memory"); return r;
}
template <int D0> __device__ __forceinline__ void pv_one(f32x16& od, int vb, bf16x8 pa0, bf16x8 pa1, bf16x8 pa2, bf16x8 pa3) {
  const s16x4 l0 = tr_read<v_rd_off(D0, 0, 0)>(vb), h0 = tr_read<v_rd_off(D0, 0, 1)>(vb), l1 = tr_read<v_rd_off(D0, 1, 0)>(vb), h1 = tr_read<v_rd_off(D0, 1, 1)>(vb);
  const s16x4 l2 = tr_read<v_rd_off(D0, 2, 0)>(vb), h2 = tr_read<v_rd_off(D0, 2, 1)>(vb), l3 = tr_read<v_rd_off(D0, 3, 0)>(vb), h3 = tr_read<v_rd_off(D0, 3, 1)>(vb);
  asm volatile("s_waitcnt lgkmcnt(0)" ::: "memory"); SBAR();
#define PK(L, H) (bf16x8){L[0], L[1], L[2], L[3], H[0], H[1], H[2], H[3]}
  od = __builtin_amdgcn_mfma_f32_32x32x16_bf16(pa0, PK(l0, h0), od, 0, 0, 0);
  od = __builtin_amdgcn_mfma_f32_32x32x16_bf16(pa1, PK(l1, h1), od, 0, 0, 0);
  od = __builtin_amdgcn_mfma_f32_32x32x16_bf16(pa2, PK(l2, h2), od, 0, 0, 0);
  od = __builtin_amdgcn_mfma_f32_32x32x16_bf16(pa3, PK(l3, h3), od, 0, 0, 0);
#undef PK
}
__device__ __forceinline__ void pv_d0(f32x16* o, int vb, bf16x8 pa0, bf16x8 pa1, bf16x8 pa2, bf16x8 pa3) {
  pv_one<0>(o[0], vb, pa0, pa1, pa2, pa3); pv_one<1>(o[1], vb, pa0, pa1, pa2, pa3); pv_one<2>(o[2], vb, pa0, pa1, pa2, pa3); pv_one<3>(o[3], vb, pa0, pa1, pa2, pa3);
}

__device__ __forceinline__ void attn_dense_body(const bf16* Qb, const bf16* __restrict__ Kh, const bf16* __restrict__ Vh,
                                                bf16* Ob, int seq, char* lds, int tid_in, const float* qgain, const float* ropc, const float* rops, int t0) {
  using SQ = St;
  int tid_ = tid_in; asm volatile("" : "+v"(tid_));
  const int tid = tid_, wid = tid >> 6, lane = tid & 63, r32 = lane & 31, hi = lane >> 5;
  bf16* V_lds = (bf16*)lds; bf16* K_lds = (bf16*)(lds + 2 * SHM_V);
  float* ws = (float*)(lds + 2 * SHM_V + 2 * SHM_K) + wid * 64; float* li_l = ws; float* al_l = ws + 32;
  float m_reg = -1e30f, l_reg = 0; f32x16 o[4] = {}; bf16x8 qr[8];
  const bf16* Qw = Qb + (long)(wid * QBLK + r32) * LDQ + hi * 8;
#pragma unroll
  for (int d0 = 0; d0 < 8; ++d0) qr[d0] = SQ::tobf(SQ::ld8(Qw + d0 * 16));
  { float qf[8][8]; float ss = 0.f;
#pragma unroll
    for (int d0 = 0; d0 < 8; ++d0) { const u32x4 w = __builtin_bit_cast(u32x4, qr[d0]);
      qf[d0][0] = bflo(w.x); qf[d0][1] = bfhi(w.x); qf[d0][2] = bflo(w.y); qf[d0][3] = bfhi(w.y); qf[d0][4] = bflo(w.z); qf[d0][5] = bfhi(w.z); qf[d0][6] = bflo(w.w); qf[d0][7] = bfhi(w.w);
#pragma unroll
      for (int j = 0; j < 8; ++j) ss = fmaf(qf[d0][j], qf[d0][j], ss); }
    { auto rr = __builtin_amdgcn_permlane32_swap(__float_as_uint(ss), __float_as_uint(ss), false, false); ss = __uint_as_float(rr[0]) + __uint_as_float(rr[1]); }
    const float rms = rsqrtf(ss * (1.f / 128.f) + 1e-6f);
#pragma unroll
    for (int d0 = 0; d0 < 8; ++d0) { const f32x4 g0 = *(const f32x4*)(qgain + d0 * 16 + hi * 8), g1 = *(const f32x4*)(qgain + d0 * 16 + hi * 8 + 4);
      qf[d0][0] *= rms * g0.x; qf[d0][1] *= rms * g0.y; qf[d0][2] *= rms * g0.z; qf[d0][3] *= rms * g0.w; qf[d0][4] *= rms * g1.x; qf[d0][5] *= rms * g1.y; qf[d0][6] *= rms * g1.z; qf[d0][7] *= rms * g1.w; }
    if (t0 >= 0) { const int t = t0 + wid * QBLK + r32;
#pragma unroll
      for (int d0 = 0; d0 < 4; ++d0) { const float* cp = ropc + (long)t * 64 + d0 * 16 + hi * 8; const float* sp = rops + (long)t * 64 + d0 * 16 + hi * 8;
        const f32x4 c0 = *(const f32x4*)cp, c1 = *(const f32x4*)(cp + 4), s0 = *(const f32x4*)sp, s1 = *(const f32x4*)(sp + 4);
        const float cs[8] = {c0.x, c0.y, c0.z, c0.w, c1.x, c1.y, c1.z, c1.w}, sn[8] = {s0.x, s0.y, s0.z, s0.w, s1.x, s1.y, s1.z, s1.w};
#pragma unroll
        for (int j = 0; j < 8; ++j) { const float x1 = qf[d0][j], x2 = qf[d0 + 4][j]; qf[d0][j] = x1 * cs[j] - x2 * sn[j]; qf[d0 + 4][j] = x2 * cs[j] + x1 * sn[j]; } } }
#pragma unroll
    for (int d0 = 0; d0 < 8; ++d0) { u32x4 w = {cvtpk(qf[d0][0], qf[d0][1]), cvtpk(qf[d0][2], qf[d0][3]), cvtpk(qf[d0][4], qf[d0][5]), cvtpk(qf[d0][6], qf[d0][7])}; qr[d0] = __builtin_bit_cast(bf16x8, w); } }
  const int sr = tid >> 4, sc = (tid & 15) * 8, vst0 = v_st(sr, sc), vst1 = v_st(32 + sr, sc);
  const int vb0 = (int)(uintptr_t)V_lds + v_rd_base(lane);
  struct { typename St::T vs0, vs1, ks0, ks1; } sr_[SDEPTH];
#define SLOAD(i, k0) do { sr_[i].vs0 = St::ld8(&Vh[(long)((k0) + sr) * LDK + sc]); sr_[i].vs1 = St::ld8(&Vh[(long)((k0) + 32 + sr) * LDK + sc]); \
    sr_[i].ks0 = St::ld8(&Kh[(long)((k0) + sr) * LDK + sc]); sr_[i].ks1 = St::ld8(&Kh[(long)((k0) + 32 + sr) * LDK + sc]); } while (0)
#define SWRITE(b, i) do { *(bf16x8*)((char*)V_lds + (b) * SHM_V + vst0) = St::tobf(sr_[i].vs0);          \
    *(bf16x8*)((char*)V_lds + (b) * SHM_V + vst1) = St::tobf(sr_[i].vs1); int kc = sc * 2;               \
    *(bf16x8*)((char*)K_lds + (b) * SHM_K + KSWZ(sr, kc)) = St::tobf(sr_[i].ks0);                       \
    *(bf16x8*)((char*)K_lds + (b) * SHM_K + KSWZ(32 + sr, kc)) = St::tobf(sr_[i].ks1); } while (0)
#define SWAIT() do { if constexpr (SDEPTH == 2) asm volatile("s_waitcnt vmcnt(4)" ::: "memory"); else asm volatile("s_waitcnt vmcnt(0)" ::: "memory"); } while (0)
#define RESC(a) do { if (__any((a) < 1.f)) { if (hi == 0) al_l[r32] = (a); asm volatile("s_waitcnt lgkmcnt(0)" ::: "memory"); \
    for (int d = 0; d < 4; ++d) for (int r = 0; r < 16; ++r) o[d][r] *= al_l[crow(r, hi)]; } } while (0)
  f32x16 pA0, pA1, pB0, pB1; float mnA, mnB, alA, alB; bf16x8 pa0, pa1, pa2, pa3; const int NT = seq / KVBLK;
  constexpr int SE = 0, SO = SDEPTH - 1;
  SLOAD(SE, 0); asm volatile("s_waitcnt vmcnt(0)" ::: "memory"); SWRITE(0, SE); __syncthreads();
  qkt(pA0, pA1, K_lds, qr, r32, hi); partialSM(pA0, pA1, m_reg, mnA, alA);
  SLOAD(SO, KVBLK); if constexpr (SDEPTH == 2) { if (2 < NT) SLOAD(SE, 2 * KVBLK); }
  SWAIT(); SWRITE(1, SO); __syncthreads();
  for (int j = 1; j + 1 < NT; j += 2) {
    SBAR(); qkt(pB0, pB1, (bf16*)((char*)K_lds + SHM_K), qr, r32, hi);
    finishSM(pA0, pA1, alA, l_reg, pa0, pa1, pa2, pa3); SBAR();
    SLOAD(SO, (j + SDEPTH) * KVBLK); SBAR();
    pv_d0(o, vb0, pa0, pa1, pa2, pa3); partialSM(pB0, pB1, m_reg, mnB, alB);
    __syncthreads(); SWAIT(); SWRITE(0, SE);
    RESC(alB); __syncthreads();
    SBAR(); qkt(pA0, pA1, K_lds, qr, r32, hi);
    finishSM(pB0, pB1, alB, l_reg, pa0, pa1, pa2, pa3); SBAR();
    if (SDEPTH == 1 || j + 3 < NT) SLOAD(SE, (j + 1 + SDEPTH) * KVBLK); SBAR();
    pv_d0(o, vb0 + (int)SHM_V, pa0, pa1, pa2, pa3); partialSM(pA0, pA1, m_reg, mnA, alA);
    __syncthreads(); SWAIT(); SWRITE(1, SO);
    RESC(alA); __syncthreads();
  }
  SBAR(); qkt(pB0, pB1, (bf16*)((char*)K_lds + SHM_K), qr, r32, hi);
  finishSM(pA0, pA1, alA, l_reg, pa0, pa1, pa2, pa3); SBAR();
  pv_d0(o, vb0, pa0, pa1, pa2, pa3); partialSM(pB0, pB1, m_reg, mnB, alB);
  __syncthreads(); RESC(alB);
  finishSM(pB0, pB1, alB, l_reg, pa0, pa1, pa2, pa3); SBAR();
  pv_d0(o, vb0 + (int)SHM_V, pa0, pa1, pa2, pa3);
  if (hi == 0) li_l[r32] = l_reg; asm volatile("s_waitcnt lgkmcnt(0)" ::: "memory");
  float rli[16];
#pragma unroll
  for (int r = 0; r < 16; ++r) rli[r] = __builtin_amdgcn_rcpf(li_l[crow(r, hi)]);
  bf16* Ow = Ob + (long)(wid * QBLK) * LDO;
#pragma unroll
  for (int r = 0; r < 16; ++r) { int orow = crow(r, hi);
#pragma unroll
    for (int d0 = 0; d0 < 4; ++d0) Ow[(long)orow * LDO + d0 * 32 + r32] = f2bf(o[d0][r] * rli[r]); }
  __syncthreads();
#undef SLOAD
#undef SWRITE
#undef SWAIT
#undef RESC
}
}
struct Args { const float* in[N_IN]; float* out; unsigned char* ws; int lo, hi; };
struct Frame {
    LAS unsigned char* lds; unsigned char* lds_gen;
    int tid, lane, wave, G, bid;
    const float* const* in; float* out; unsigned char* ws;
};
__device__ __forceinline__ const float* fin_ptr(const float* const* tab, int i) {
    const unsigned long long p = (unsigned long long)tab[i];
    const unsigned lo = __builtin_amdgcn_readfirstlane((unsigned)p), hi = __builtin_amdgcn_readfirstlane((unsigned)(p >> 32));
    return (const float*)(const GAS float*)(((unsigned long long)hi << 32) | lo);
}
#define FIN(i) fin_ptr(F.in, (i))
__device__ __forceinline__ float* hrow_ptr(const Frame& F, int chunk, int r) {
    const int bl = r / TOK, pos = r - bl * TOK, b = chunk * BC + bl;
    return pos < CTX ? (float*)(F.ws + WS_HC) + ((size_t)(b * CTX + pos) << 10) : F.out + ((size_t)(b * SEQ + pos - CTX) << 10);
}
__device__ __forceinline__ const float* hrow_src(const float* lat, const float* ctxb, int chunk, int r) {
    const int bl = r / TOK, pos = r - bl * TOK, b = chunk * BC + bl;
    return pos < CTX ? ctxb + ((size_t)(b * CTX + pos) << 10) : lat + ((size_t)(b * SEQ + pos - CTX) << 10);
}
__device__ __forceinline__ int mod_row(int chunk, int r) { const int bl = r / TOK, pos = r - bl * TOK; return pos < CTX ? 16 : chunk * BC + bl; }
__device__ __forceinline__ const float* mod_ptr(const Frame& F, int l, int mrow, int part) { return (const float*)(F.ws + WS_MOD) + ((size_t)(l * 17 + mrow) * 6 + part) * DM; }

__device__ __forceinline__ void p_prologue(const Frame& F, const Args& args) {
#undef FIN
#define FIN(i) (args.in[i])
    if (F.bid == 0 && F.tid < N_IN) { const float* v = nullptr;
#pragma unroll
        for (int i = 0; i < N_IN; ++i) v = (F.tid == i) ? args.in[i] : v;
        ((const float**)(F.ws + WS_TAB))[F.tid] = v; }
    {
        float* ropc = (float*)(F.ws + WS_ROPE); float* rops = ropc + SEQ * 64;
        for (int i = F.bid * 512 + F.tid; i < SEQ * 64; i += F.G * 512) { const int t = i >> 6, pp = i & 63;
            const float inv = exp2f(-(float)(pp & 31) * (13.287712379549449f / 32.0f)), ang = (float)(pp < 32 ? t / GRIDW : t % GRIDW) * inv; float s, c; sincos_rr(ang, s, c);
            ropc[i] = c; rops[i] = s; }
    }
    LAS float* sl = (LAS float*)F.lds; LAS float* red = sl + 17 * DM;
    for (int cbk = F.bid; cbk < (DEPTH * 6 * DM) / 128; cbk += F.G) {
        __syncthreads();
        for (int i = F.tid; i < 17 * DM; i += 512) { const float v = i < 16 * DM ? FIN(I_C)[i] : FIN(I_CCTX)[i - 16 * DM]; sl[i] = silu_f(v); }
        __syncthreads();
        const int kq = F.tid >> 7, cn = F.tid & 127, col = cbk * 128 + cn, l = col / (6 * DM), n = col - l * 6 * DM;
        const float* w = FIN(I_MODW) + (size_t)l * DM * 6 * DM + (size_t)(256 * kq) * 6 * DM + n;
        float acc[17];
#pragma unroll
        for (int j = 0; j < 17; ++j) acc[j] = 0.f;
        for (int k0 = 0; k0 < 256; k0 += 8) { float wv[8];
#pragma unroll
            for (int q = 0; q < 8; ++q) wv[q] = w[(size_t)(k0 + q) * 6 * DM];
#pragma unroll
            for (int q = 0; q < 8; ++q)
#pragma unroll
                for (int j = 0; j < 17; ++j) acc[j] = fmaf(sl[j * DM + 256 * kq + k0 + q], wv[q], acc[j]); }
        if (kq > 0) {
#pragma unroll
            for (int j = 0; j < 17; ++j) red[((kq - 1) * 17 + j) * 128 + cn] = acc[j]; }
        __syncthreads();
        if (kq == 0) { const float bv = FIN(I_MODB)[l * 6 * DM + n]; float* mo = (float*)(F.ws + WS_MOD) + (size_t)l * 17 * 6 * DM + n;
#pragma unroll
            for (int j = 0; j < 17; ++j) mo[(size_t)j * 6 * DM] = acc[j] + red[(0 * 17 + j) * 128 + cn] + red[(1 * 17 + j) * 128 + cn] + red[(2 * 17 + j) * 128 + cn] + bv; }
    }
    __syncthreads();
#undef FIN
#define FIN(i) fin_ptr(F.in, (i))
}

__device__ __forceinline__ void transpose_item(const float* __restrict__ W, int N, int k0, int n0, bf16_t* dst  , int Kd, LAS float* scr, int lane, float wscale = 1.0f) {
    {
        int step = 2 * N; asm volatile("" : "+v"(step));
        const float* wp = W + (size_t)(k0 + (lane >> 5)) * N + n0 + (lane & 31);
        float v[32];
#pragma unroll
        for (int i = 0; i < 32; ++i) { v[i] = __builtin_nontemporal_load(wp); wp += step; }
#pragma unroll
        for (int i = 0; i < 32; ++i) scr[(2 * i + (lane >> 5)) * 33 + (lane & 31)] = v[i] * wscale;
    }
    LDS_WAIT(); asm volatile("" ::: "memory");
    const int c = lane & 7;
#pragma unroll
    for (int j = 0; j < 4; ++j) { const int n = (lane >> 3) + 8 * j; const LAS float* s = scr + (8 * c) * 33 + n;
        u32x4 o; o.x = cvt_pk_bf16_nv(s[0 * 33], s[1 * 33]); o.y = cvt_pk_bf16_nv(s[2 * 33], s[3 * 33]); o.z = cvt_pk_bf16_nv(s[4 * 33], s[5 * 33]); o.w = cvt_pk_bf16_nv(s[6 * 33], s[7 * 33]);
        *(u32x4*)(dst + (size_t)n * Kd + k0 + 8 * c) = o; }
    LDS_WAIT(); asm volatile("" ::: "memory");
}
__device__ __forceinline__ void quant_item(const float* __restrict__ W, int ldw, int n0, signed char* dst, float* sdst, LAS int* scr, int lane) {
    const int cn = lane & 31, hi = lane >> 5;
    const float* wp0 = W + (size_t)hi * ldw + n0 + cn;
    float mx = 0.f;
    for (int kb = 0; kb < 32; ++kb) { float v[16];
#pragma unroll
        for (int i = 0; i < 16; ++i) v[i] = wp0[(size_t)(32 * kb + 2 * i) * ldw];
#pragma unroll
        for (int i = 0; i < 16; ++i) mx = fmaxf(mx, fabsf(v[i])); }
    mx = fmaxf(mx, __shfl_xor(mx, 32));
    const float inv = mx > 0.f ? 127.0f / mx : 0.f;
    if (lane < 32) sdst[lane] = mx * (1.0f / 127.0f);
    for (int kc = 0; kc < 8; ++kc) {
#pragma unroll
        for (int hb = 0; hb < 4; ++hb) { float v[16];
#pragma unroll
            for (int i = 0; i < 16; ++i) v[i] = wp0[(size_t)(128 * kc + 32 * hb + 2 * i) * ldw];
#pragma unroll
            for (int i = 0; i < 16; ++i) scr[(32 * hb + 2 * i + hi) * 33 + cn] = (int)rintf(v[i] * inv); }
        LDS_WAIT(); asm volatile("" ::: "memory");
#pragma unroll
        for (int t = 0; t < 4; ++t) { const int chunk = lane + 64 * t, n = chunk >> 3, c16 = chunk & 7; const LAS int* s = scr + (16 * c16) * 33 + n; unsigned w[4];
#pragma unroll
            for (int q = 0; q < 4; ++q) w[q] = (unsigned)(s[(4 * q) * 33] & 255) | ((unsigned)(s[(4 * q + 1) * 33] & 255) << 8) | ((unsigned)(s[(4 * q + 2) * 33] & 255) << 16) | ((unsigned)(s[(4 * q + 3) * 33] & 255) << 24);
            u32x4 o; o.x = w[0]; o.y = w[1]; o.z = w[2]; o.w = w[3]; *(u32x4*)(dst + (size_t)n * DM + 128 * kc + 16 * c16) = o; }
        LDS_WAIT(); asm volatile("" ::: "memory");
    }
}
__device__ __forceinline__ void quant_item_wg(const Frame& F, const float* __restrict__ W, int ldw, int n0, signed char* dst, float* sdst, int par) {
    LAS int* scr = (LAS int*)(F.lds + F.wave * 16896); LAS float* cmx = (LAS float*)(F.lds + 8 * 16896) + par * 256;
    const int lane = F.lane, cn = lane & 31, hi = lane >> 5;
    int step = 2 * ldw; asm volatile("" : "+v"(step));
    const float* wp = W + (size_t)(128 * F.wave + hi) * ldw + n0 + cn;
    float v[64];
#pragma unroll
    for (int i = 0; i < 64; ++i) { v[i] = __builtin_nontemporal_load(wp); wp += step; }
    float mx = 0.f;
#pragma unroll
    for (int i = 0; i < 64; ++i) mx = fmaxf(mx, fabsf(v[i]));
    mx = fmaxf(mx, __shfl_xor(mx, 32));
    if (lane < 32) cmx[F.wave * 32 + lane] = mx;
    __syncthreads();
    float m = 0.f;
#pragma unroll
    for (int w = 0; w < 8; ++w) m = fmaxf(m, cmx[w * 32 + cn]);
    const float inv = m > 0.f ? 127.0f / m : 0.f;
    if (F.wave == 0 && lane < 32) sdst[lane] = m * (1.0f / 127.0f);
#pragma unroll
    for (int i = 0; i < 64; ++i) scr[(2 * i + hi) * 33 + cn] = (int)rintf(v[i] * inv);
    LDS_WAIT(); asm volatile("" ::: "memory");
#pragma unroll
    for (int t = 0; t < 4; ++t) { const int chunk = lane + 64 * t, n = chunk >> 3, c16 = chunk & 7; const LAS int* s = scr + (16 * c16) * 33 + n; unsigned w[4];
#pragma unroll
        for (int q = 0; q < 4; ++q) w[q] = (unsigned)(s[(4 * q) * 33] & 255) | ((unsigned)(s[(4 * q + 1) * 33] & 255) << 8) | ((unsigned)(s[(4 * q + 2) * 33] & 255) << 16) | ((unsigned)(s[(4 * q + 3) * 33] & 255) << 24);
        u32x4 o; o.x = w[0]; o.y = w[1]; o.z = w[2]; o.w = w[3]; *(u32x4*)(dst + (size_t)n * DM + 128 * F.wave + 16 * c16) = o; }
    LDS_WAIT(); asm volatile("" ::: "memory");
}
__device__ __forceinline__ void filt_unit(const Frame& F, int l, int n, int i0, bf16_t* FR) {
    const int lane = F.lane;
    const float* fw1 = FIN(I_FW1) + (size_t)l * 33 * 64; const float* fb1 = FIN(I_FB1) + l * 64;
    const float* fw2 = FIN(I_FW2) + (size_t)l * 64 * 64; const float* fb2 = FIN(I_FB2) + l * 64;
    const float* fw3 = FIN(I_FW3) + (size_t)l * 64 * 1024; const float* fq = FIN(I_FREQ) + l * 128;
    LAS bf16_t* T = (LAS bf16_t*)F.lds;
    float h2[4], tt[4], w1v[33];
#pragma unroll
    for (int q = 0; q < 33; ++q) w1v[q] = fw1[q * 64 + lane];
    const float b1v = fb1[lane], b2v = fb2[lane], f0v = fq[lane], f1v = fq[64 + lane];
    float w2v[64];
#pragma unroll
    for (int q = 0; q < 64; ++q) w2v[q] = fw2[q * 64 + lane];
    asm volatile("" ::: "memory");
#pragma unroll
    for (int p = 0; p < 4; ++p) { const int i = i0 + 4 * F.wave + p;
        const float t = (float)i / (float)(n - 1), w = (6.283185307179586f / (float)n) * (float)i; tt[p] = t;
        float a = b1v + t * w1v[0];
#pragma unroll
        for (int q = 0; q < 16; ++q) { const float f = 1e-4f + (float)q * ((15.0f - 1e-4f) / 15.0f); float s, c; sincos_rr(f * w, s, c);
            a = fmaf(c, w1v[1 + q], a); a = fmaf(-s, w1v[17 + q], a); }
        float sn, cs; sincos_rr(f0v * a, sn, cs); const float h1 = sn;
        float a2 = b2v;
#pragma unroll
        for (int q = 0; q < 64; ++q) a2 = fmaf(__shfl(h1, q), w2v[q], a2);
        sincos_rr(f1v * a2, sn, cs); h2[p] = sn; }
    float o[4][16];
#pragma unroll
    for (int p = 0; p < 4; ++p)
#pragma unroll
        for (int m = 0; m < 16; ++m) o[p][m] = 0.f;
    for (int q = 0; q < 64; q += 4) { float hq[4][4];
#pragma unroll
        for (int qq = 0; qq < 4; ++qq)
#pragma unroll
            for (int p = 0; p < 4; ++p) hq[qq][p] = __shfl(h2[p], q + qq);
        float wv[4][16];
#pragma unroll
        for (int qq = 0; qq < 4; ++qq)
#pragma unroll
            for (int m = 0; m < 16; ++m) wv[qq][m] = fw3[(q + qq) * 1024 + m * 64 + lane];
        asm volatile("" ::: "memory");
#pragma unroll
        for (int qq = 0; qq < 4; ++qq)
#pragma unroll
            for (int m = 0; m < 16; ++m)
#pragma unroll
                for (int p = 0; p < 4; ++p) o[p][m] = fmaf(hq[qq][p], wv[qq][m], o[p][m]); }
    const float mind = -3.0701134573253945f, maxd = -15.350567286626973f;
    __syncthreads();
#pragma unroll
    for (int m = 0; m < 8; ++m) { const int c = m * 64 + lane; const float dl = mind + (float)c * ((maxd - mind) / 511.0f);
#pragma unroll
        for (int p = 0; p < 4; ++p) { const float dec = __expf(tt[p] * dl);
            T[c * 32 + 4 * F.wave + p] = f2bf(o[p][m] * dec); T[(512 + c) * 32 + 4 * F.wave + p] = f2bf(o[p][m + 8] * dec); } }
    __syncthreads();
    const int CL = 2 * n + 16, pp = F.tid & 31, i = i0 + pp;
    for (int row = F.tid >> 5; row < 1024; row += 16) { const int dir = row >> 9, c = row & 511; float v = bf2f(T[row * 32 + pp]);
        if (i == 0) { if (dir) continue; v += bf2f(T[(512 + c) * 32 + pp]); }
        FR[(size_t)c * CL + (dir ? n + i : n - i)] = f2bf(v); }
}
__device__ __forceinline__ void p_weights(const Frame& F, int l) {
    LAS float* scr = (LAS float*)(F.lds + F.wave * 16896);
    const int gw = F.bid * 8 + F.wave, NGW = F.G * 8;
    constexpr int I_B = 16 * 32, I_C2 = 8 * 32, I_E = 16 * 32;
    constexpr int I_A = 0;
    constexpr int NITEMS = I_A + I_B + 2 * I_C2 + I_E;
    for (int u = F.bid; u < (SEQ + CTX) / 32; u += F.G) {
        if (u < SEQ / 32) filt_unit(F, l, SEQ, 32 * u, (bf16_t*)(F.ws + WS_FRL));
        else filt_unit(F, l, CTX, 32 * (u - SEQ / 32), (bf16_t*)(F.ws + WS_FRC));
    }
    __syncthreads();
    constexpr int NFB = (SEQ + CTX) / 32;
    const int nfw = (F.G > NFB ? NFB : F.G) * 8, now = (F.G > NFB ? F.G - NFB : 0) * 8, nslots = nfw + 3 * now;
    for (int sl0 = (F.bid < NFB ? gw : nfw + 3 * (gw - nfw)), rep3 = 0; rep3 < (F.bid < NFB ? 1 : 3); ++rep3)
    for (int it = sl0 + rep3; it < NITEMS; it += nslots) {
        int r = it;
        if (r < I_A) { const int kb = r / 128, nb = r % 128; transpose_item(FIN(I_WIN) + (size_t)l * DM * IN_TOTAL, IN_TOTAL, 64 * kb, 32 * nb, (bf16_t*)(F.ws + WS_WINB) + (size_t)(32 * nb) * DM, DM, scr, F.lane); continue; } r -= I_A;
        if (r < I_B) { const int kb = r / 32, nb = r % 32; transpose_item(FIN(I_WAO) + (size_t)l * DM * DM, DM, 64 * kb, 32 * nb, (bf16_t*)(F.ws + WS_WA) + (size_t)(32 * nb) * DM, DM, scr, F.lane, 1.0f / 255.0f); continue; } r -= I_B;
        if (r < I_C2) { const int kb = r / 32, nb = r % 32; transpose_item(FIN(I_WHO) + (size_t)l * 512 * DM, DM, 64 * kb, 32 * nb, (bf16_t*)(F.ws + WS_WH) + (size_t)(32 * nb) * 1024, 1024, scr, F.lane, 1.0f / 255.0f); continue; } r -= I_C2;
        if (r < I_C2) { const int kb = r / 32, nb = r % 32; transpose_item(FIN(I_WLO) + (size_t)l * 512 * DM, DM, 64 * kb, 32 * nb, (bf16_t*)(F.ws + WS_WH) + (size_t)(32 * nb) * 1024 + 512, 1024, scr, F.lane, 1.0f / 255.0f); continue; } r -= I_C2;
        { const int kb = r / 32, nb = r % 32; transpose_item(FIN(I_WOUT) + (size_t)l * DM * DM, DM, 64 * kb, 32 * nb, (bf16_t*)(F.ws + WS_WO) + (size_t)(32 * nb) * DM, DM, scr, F.lane); }
    }
    __syncthreads();
    { int par = 0;
      for (int nb = F.G - 1 - F.bid; nb < 224; nb += F.G, par ^= 1)
        quant_item_wg(F, FIN(I_WIN) + (size_t)l * DM * IN_TOTAL, IN_TOTAL, 32 * nb, (signed char*)(F.ws + WS_WIN) + (size_t)(32 * nb) * DM, (float*)(F.ws + WS_SWIN) + 32 * nb, par); }
    __syncthreads();
}
__device__ __forceinline__ void w_filters(const Frame& F, int l, int first) {
    if (F.G <= first) first = 0; if (F.bid < first) return;
    for (int u = F.bid - first; u < (SEQ + CTX) / 32; u += F.G - first) {
        if (u < SEQ / 32) filt_unit(F, l, SEQ, 32 * u, (bf16_t*)(F.ws + WS_FRL));
        else filt_unit(F, l, CTX, 32 * (u - SEQ / 32), (bf16_t*)(F.ws + WS_FRC));
    }
    __syncthreads();
}
__device__ __forceinline__ void w_quant_in(const Frame& F, int l, int first) {
    if (F.G <= first) first = 0; if (F.bid < first) return;
    __syncthreads();
    int par = 0;
    for (int nb = F.bid - first; nb < 224; nb += F.G - first, par ^= 1)
        quant_item_wg(F, FIN(I_WIN) + (size_t)l * DM * IN_TOTAL, IN_TOTAL, 32 * nb, (signed char*)(F.ws + WS_WIN) + (size_t)(32 * nb) * DM, (float*)(F.ws + WS_SWIN) + 32 * nb, par);
    __syncthreads();
}
__device__ __forceinline__ void w_transposes(const Frame& F, int l, int first) {
    if (F.G <= first) first = 0; if (F.bid < first) return;
    LAS float* scr = (LAS float*)(F.lds + F.wave * 16896);
    constexpr int I_B = 16 * 32, I_C2 = 8 * 32, I_E = 16 * 32, NITEMS = I_B + 2 * I_C2 + I_E;
    for (int it = (F.bid - first) * 8 + F.wave; it < NITEMS; it += (F.G - first) * 8) {
        int r = it;
        if (r < I_B) { const int kb = r / 32, nb = r % 32; transpose_item(FIN(I_WAO) + (size_t)l * DM * DM, DM, 64 * kb, 32 * nb, (bf16_t*)(F.ws + WS_WA) + (size_t)(32 * nb) * DM, DM, scr, F.lane, 1.0f / 255.0f); continue; } r -= I_B;
        if (r < I_C2) { const int kb = r / 32, nb = r % 32; transpose_item(FIN(I_WHO) + (size_t)l * 512 * DM, DM, 64 * kb, 32 * nb, (bf16_t*)(F.ws + WS_WH) + (size_t)(32 * nb) * 1024, 1024, scr, F.lane, 1.0f / 255.0f); continue; } r -= I_C2;
        if (r < I_C2) { const int kb = r / 32, nb = r % 32; transpose_item(FIN(I_WLO) + (size_t)l * 512 * DM, DM, 64 * kb, 32 * nb, (bf16_t*)(F.ws + WS_WH) + (size_t)(32 * nb) * 1024 + 512, 1024, scr, F.lane, 1.0f / 255.0f); continue; } r -= I_C2;
        { const int kb = r / 32, nb = r % 32; transpose_item(FIN(I_WOUT) + (size_t)l * DM * DM, DM, 64 * kb, 32 * nb, (bf16_t*)(F.ws + WS_WO) + (size_t)(32 * nb) * DM, DM, scr, F.lane); }
    }
}
__device__ __forceinline__ bool exp_wave(const Frame& F, int l, int& j, int& pw) {
    const int first = (l == DEPTH - 1 || F.G <= 64) ? 0 : 64;
    j = (F.bid - first) * 8 + F.wave; pw = (F.G - first) * 8; return F.bid >= first; }
__device__ __forceinline__ void p_weights_exp13(const Frame& F, int l) {
    int j, pw; if (!exp_wave(F, l, j, pw)) return;
    int par = 0;
    for (int it = j >> 3; it < 2 * NE * 32; it += (pw >> 3), par ^= 1) {
        const int which = it / (NE * 32), e = (it / 32) % NE, nb = it % 32, n0 = 32 * nb, drow = 256 * (n0 >> 7) + 128 * which + (n0 & 127);
        quant_item_wg(F, FIN(which ? I_EW3 : I_EW1) + ((size_t)l * NE + e) * DM * DM, DM, n0, (signed char*)(F.ws + WS_W13) + ((size_t)e * 2048 + drow) * DM, (float*)(F.ws + WS_SW13) + (size_t)e * 2048 + drow, par); }
    __syncthreads();
}
__device__ __forceinline__ void p_weights_exp2(const Frame& F, int l) {
    LAS float* scr = (LAS float*)(F.lds + F.wave * 16896); int j, pw; if (!exp_wave(F, l, j, pw)) return;
    for (int r = j; r < NE * 512; r += pw) { const int e = r / 512, q = r % 512, kb = q / 32, nb = q % 32;
        transpose_item(FIN(I_EW2) + ((size_t)l * NE + e) * DM * DM, DM, 64 * kb, 32 * nb, (bf16_t*)(F.ws + WS_W2) + ((size_t)e * DM + 32 * nb) * DM, DM, scr, F.lane); }
}


template <bool ROUTE, bool COMBINE>
__device__ __forceinline__ void p_norm(const Frame& F, int l, int chunk, const float* gain, int part_shift, int part_scale, bf16_t* U, float* AFF, int lc = 0, const int* INV = nullptr, const bf16_t* YS = nullptr, const float* xsrc = nullptr, const float* csrc = nullptr, const bf16_t* DLT = nullptr, bool dlt_skip_ctx = false, signed char* UQ = nullptr, float* SU = nullptr) {
    bf16_t* HB = (bf16_t*)(F.ws + WS_CH + CH_HRES);
    constexpr int R = ROUTE ? 1 : 2;
    LAS float* rw = (LAS float*)F.lds;
    if (ROUTE) { const float* r = FIN(I_ROUT) + (size_t)l * DM * NE;
        for (int i = F.tid; i < DM * NE; i += 512) { const int col = i >> 4, e = i & 15; rw[e * DM + col] = r[i]; }
        __syncthreads(); }
    const int gw = F.bid * 8 + F.wave, NGW = F.G * 8, lane = F.lane;
    f32x4 gq[4];
#pragma unroll
    for (int j = 0; j < 4; ++j) gq[j] = ((const f32x4*)gain)[lane + 64 * j];
    for (int r0 = gw * R; r0 < RC; r0 += NGW * R) {
        f32x4 v[R][4]; int mr[R];
#pragma unroll
        for (int q = 0; q < R; ++q) { const int r = r0 + q < RC ? r0 + q : RC - 1; mr[q] = mod_row(chunk, r);
            if (xsrc) { const f32x4* hp = (const f32x4*)hrow_src(xsrc, csrc, chunk, r) + lane;
#pragma unroll
                for (int j = 0; j < 4; ++j) v[q][j] = hp[64 * j]; }
            else { const u32x2* hb = (const u32x2*)(HB + (size_t)r * DM) + lane; u32x2 t[4];
#pragma unroll
                for (int j = 0; j < 4; ++j) t[j] = hb[64 * j];
#pragma unroll
                for (int j = 0; j < 4; ++j) v[q][j] = (f32x4){bflo(t[j].x), bfhi(t[j].x), bflo(t[j].y), bfhi(t[j].y)}; } }
        if (DLT) {
#pragma unroll
            for (int q = 0; q < R; ++q) { const int r = r0 + q; if (r >= RC) break; if (dlt_skip_ctx && mr[q] == 16) continue;
                const u32x2* dp = (const u32x2*)(DLT + (size_t)r * DM) + lane; u32x2 dv[4];
#pragma unroll
                for (int j = 0; j < 4; ++j) dv[j] = dp[64 * j];
                u32x2* hw = (u32x2*)(HB + (size_t)r * DM) + lane;
#pragma unroll
                for (int j = 0; j < 4; ++j) { v[q][j].x += bflo(dv[j].x); v[q][j].y += bfhi(dv[j].x); v[q][j].z += bflo(dv[j].y); v[q][j].w += bfhi(dv[j].y);
                    u32x2 w; w.x = cvt_pk_bf16_nv(v[q][j].x, v[q][j].y); w.y = cvt_pk_bf16_nv(v[q][j].z, v[q][j].w); hw[64 * j] = w; } }
        }
        if (COMBINE) {
#pragma unroll
            for (int q = 0; q < R; ++q) { const int r = r0 + q; if (r >= RC) break;
                f32x4 acc[4];
#pragma unroll
                for (int j = 0; j < 4; ++j) acc[j] = (f32x4){0.f, 0.f, 0.f, 0.f};
                const int xl = INV[(size_t)r * NE + (lane & 15)];
                unsigned mk = (unsigned)__ballot(xl >= 0) & 0xffffu;
                const bool any = mk != 0u;
                while (mk) {
                    const int e0 = __builtin_ctz(mk); mk &= mk - 1u; const bool two = mk != 0u; const int e1 = two ? __builtin_ctz(mk) : e0; if (two) mk &= mk - 1u;
                    const int x0 = __builtin_amdgcn_readlane(xl, e0), x1 = __builtin_amdgcn_readlane(xl, e1); const float w1 = two ? 1.f : 0.f;
                    const u32x2* y0 = (const u32x2*)(YS + ((size_t)e0 * XROWS + x0) * 1024) + lane; const u32x2* y1 = (const u32x2*)(YS + ((size_t)e1 * XROWS + x1) * 1024) + lane;
                    u32x2 a[4], b[4];
#pragma unroll
                    for (int j = 0; j < 4; ++j) { a[j] = y0[64 * j]; b[j] = y1[64 * j]; }
#pragma unroll
                    for (int j = 0; j < 4; ++j) { acc[j].x += bflo(a[j].x) + w1 * bflo(b[j].x); acc[j].y += bfhi(a[j].x) + w1 * bfhi(b[j].x); acc[j].z += bflo(a[j].y) + w1 * bflo(b[j].y); acc[j].w += bfhi(a[j].y) + w1 * bfhi(b[j].y); }
                }
                if (any) { const f32x4* g2 = (const f32x4*)mod_ptr(F, lc, mr[q], 5) + lane; u32x2* hw = (u32x2*)(HB + (size_t)r * DM) + lane;
#pragma unroll
                    for (int j = 0; j < 4; ++j) { v[q][j] = v[q][j] + g2[64 * j] * acc[j]; u32x2 w; w.x = cvt_pk_bf16_nv(v[q][j].x, v[q][j].y); w.y = cvt_pk_bf16_nv(v[q][j].z, v[q][j].w); hw[64 * j] = w; } }
            }
        }
        float rstd[R]; f32x4 shq[R][4], scq[R][4];
#pragma unroll
        for (int q = 0; q < R; ++q) { float ss = 0.f;
#pragma unroll
            for (int j = 0; j < 4; ++j) ss += (v[q][j].x * v[q][j].x + v[q][j].y * v[q][j].y) + (v[q][j].z * v[q][j].z + v[q][j].w * v[q][j].w);
            rstd[q] = rsqrtf(wave_sum(ss) * (1.f / DM) + NORM_EPS);
            const f32x4* shp = (const f32x4*)mod_ptr(F, l, mr[q], part_shift) + lane; const f32x4* scp = (const f32x4*)mod_ptr(F, l, mr[q], part_scale) + lane;
#pragma unroll
            for (int j = 0; j < 4; ++j) { shq[q][j] = shp[64 * j]; scq[q][j] = scp[64 * j]; } }
        asm volatile("" ::: "memory");
        float lg[ROUTE ? R : 1][16];
        unsigned rwo = 0u; if (ROUTE) asm volatile("" : "+v"(rwo));
        if (ROUTE) {
#pragma unroll
            for (int q = 0; q < R; ++q)
#pragma unroll
                for (int e = 0; e < 16; ++e) lg[q][e] = 0.f; }
        float qinv[R]; const bool qout = UQ != nullptr;
        if (qout) {
#pragma unroll
            for (int q = 0; q < R; ++q) { float mx = 0.f;
#pragma unroll
                for (int j = 0; j < 4; ++j) { f32x4 y = v[q][j] * rstd[q] * gq[j]; y = y * (scq[q][j] + 1.0f) + shq[q][j]; mx = fmaxf(mx, fmaxf(fmaxf(fabsf(y.x), fabsf(y.y)), fmaxf(fabsf(y.z), fabsf(y.w)))); }
#pragma unroll
                for (int o = 1; o < 64; o <<= 1) mx = fmaxf(mx, __shfl_xor(mx, o));
                qinv[q] = mx > 0.f ? 127.0f / mx : 0.f;
                if (lane == 0 && r0 + q < RC) SU[r0 + q] = mx * (1.0f / 127.0f); } }
#pragma unroll
        for (int j = 0; j < 4; ++j) { f32x4 y[R];
#pragma unroll
            for (int q = 0; q < R; ++q) { y[q] = v[q][j] * rstd[q] * gq[j]; y[q] = y[q] * (scq[q][j] + 1.0f) + shq[q][j];
                if (r0 + q < RC) {
                    if (U) { u32x2 w; w.x = cvt_pk_bf16_nv(y[q].x, y[q].y); w.y = cvt_pk_bf16_nv(y[q].z, y[q].w); ((u32x2*)(U + (size_t)(r0 + q) * DM))[lane + 64 * j] = w; }
                    if (qout) { const int a0 = (int)rintf(y[q].x * qinv[q]), a1 = (int)rintf(y[q].y * qinv[q]), a2 = (int)rintf(y[q].z * qinv[q]), a3 = (int)rintf(y[q].w * qinv[q]);
                        ((unsigned*)(UQ + (size_t)(r0 + q) * DM))[lane + 64 * j] = (unsigned)(a0 & 255) | ((unsigned)(a1 & 255) << 8) | ((unsigned)(a2 & 255) << 16) | ((unsigned)(a3 & 255) << 24); }
                } }
            if (ROUTE) {
#pragma unroll
                for (int e = 0; e < 16; ++e) { const f32x4 wv = *(const LAS f32x4*)(rw + rwo + e * DM + 256 * j + 4 * lane);
#pragma unroll
                    for (int q = 0; q < R; ++q) lg[q][e] += (y[q].x * wv.x + y[q].y * wv.y) + (y[q].z * wv.z + y[q].w * wv.w);
                    if ((e & 7) == 7) asm volatile("" ::: "memory"); } } }
        if (ROUTE) {
#pragma unroll
            for (int q = 0; q < R; ++q) {
                float t8[8], t4[4], t2[2], t1;
                { const bool up = (lane & 32) != 0;
#pragma unroll
                  for (int k = 0; k < 8; ++k) { const float send = up ? lg[q][k] : lg[q][k + 8], keep = up ? lg[q][k + 8] : lg[q][k]; t8[k] = keep + __shfl_xor(send, 32); } }
                { const bool up = (lane & 16) != 0;
#pragma unroll
                  for (int k = 0; k < 4; ++k) { const float send = up ? t8[k] : t8[k + 4], keep = up ? t8[k + 4] : t8[k]; t4[k] = keep + __shfl_xor(send, 16); } }
                { const bool up = (lane & 8) != 0;
#pragma unroll
                  for (int k = 0; k < 2; ++k) { const float send = up ? t4[k] : t4[k + 2], keep = up ? t4[k + 2] : t4[k]; t2[k] = keep + __shfl_xor(send, 8); } }
                { const bool up = (lane & 4) != 0; const float send = up ? t2[0] : t2[1], keep = up ? t2[1] : t2[0]; t1 = keep + __shfl_xor(send, 4); }
                t1 += __shfl_xor(t1, 2); t1 += __shfl_xor(t1, 1);
                float mx = t1; mx = fmaxf(mx, __shfl_xor(mx, 4)); mx = fmaxf(mx, __shfl_xor(mx, 8)); mx = fmaxf(mx, __shfl_xor(mx, 16)); mx = fmaxf(mx, __shfl_xor(mx, 32));
                const float ex = __expf(t1 - mx); float den = ex; den += __shfl_xor(den, 4); den += __shfl_xor(den, 8); den += __shfl_xor(den, 16); den += __shfl_xor(den, 32);
                const int e = ((lane >> 5) & 1) * 8 + ((lane >> 4) & 1) * 4 + ((lane >> 3) & 1) * 2 + ((lane >> 2) & 1);
                if ((lane & 3) == 0 && r0 + q < RC) AFF[(size_t)(r0 + q) * NE + e] = ex * __builtin_amdgcn_rcpf(den);
            }
        }
    }
    if (ROUTE) __syncthreads();
}

__device__ __forceinline__ int win_tile(int t, int sel) { return sel == 1 ? (t < 6 ? t : t + 6) : sel == 2 ? (t < 6 ? t + 6 : t + 8) : t; }
struct GemmPlain { static constexpr int NSEG = 1; const bf16_t* A; const bf16_t* Bt; int K; int tsel = 0; static constexpr bool GATHER = false; static constexpr int ESZ = 2;
    __device__ __forceinline__ const char* a_tile(const pg8::Unit& u) const { return (const char*)A + (size_t)u.pm * 256 * K * 2; }
    __device__ __forceinline__ const char* b_tile(const pg8::Unit& u) const { return (const char*)Bt + (size_t)win_tile(u.pn, tsel) * 256 * K * 2; } };
constexpr int XPAN = XROWS / 256;
struct GemmExpert { static constexpr int NSEG = 1; const bf16_t* A; const bf16_t* Bt; int K; int nrows_b; static constexpr bool GATHER = false; static constexpr int ESZ = 2;
    __device__ __forceinline__ const char* a_tile(const pg8::Unit& u) const { return (const char*)A + (size_t)u.pm * 256 * K * 2; }
    __device__ __forceinline__ const char* b_tile(const pg8::Unit& u) const { const int e = u.pm / XPAN; return (const char*)Bt + ((size_t)e * nrows_b + (size_t)u.pn * 256) * K * 2; } };
struct GemmExpertGather { static constexpr int NSEG = 1; const bf16_t* A; const int* rowsrc; const bf16_t* Bt; int K; int nrows_b; static constexpr bool GATHER = true; static constexpr int ESZ = 2;
    __device__ __forceinline__ const char* a_tile(const pg8::Unit&) const { return (const char*)A; }
    __device__ __forceinline__ int a_row(const pg8::Unit& u, int r) const { return rowsrc[u.pm * 256 + r]; }
    __device__ __forceinline__ const char* b_tile(const pg8::Unit& u) const { const int e = u.pm / XPAN; return (const char*)Bt + ((size_t)e * nrows_b + (size_t)u.pn * 256) * K * 2; } };

struct GemmPlainQ { static constexpr int NSEG = 1; const signed char* A; const signed char* Bt; int K; int tsel = 0; static constexpr bool GATHER = false; static constexpr int ESZ = 1;
    __device__ __forceinline__ const char* a_tile(const pg8::Unit& u) const { return (const char*)A + (size_t)u.pm * 256 * K; }
    __device__ __forceinline__ const char* b_tile(const pg8::Unit& u) const { return (const char*)Bt + (size_t)win_tile(u.pn, tsel) * 256 * K; } };
struct GemmExpertGatherQ { static constexpr int NSEG = 1; const signed char* A; const int* rowsrc; const signed char* Bt; int K; int nrows_b; static constexpr bool GATHER = true; static constexpr int ESZ = 1;
    __device__ __forceinline__ const char* a_tile(const pg8::Unit&) const { return (const char*)A; }
    __device__ __forceinline__ int a_row(const pg8::Unit& u, int r) const { return rowsrc[u.pm * 256 + r]; }
    __device__ __forceinline__ const char* b_tile(const pg8::Unit& u) const { const int e = u.pm / XPAN; return (const char*)Bt + ((size_t)e * nrows_b + (size_t)u.pn * 256) * K; } };

struct EpiIn {
    static constexpr bool PERM = true, AFTER_DRAIN = false;
    unsigned char* ch; int pn_off; const float* su; const float* sw; int tsel = 0;
    __device__ __forceinline__ void operator()(const f32x4 (&acc)[2][2][4][2], const pg8::Unit& u, int wr, int wc, int fr, int fq) const {
        const int pn = win_tile(u.pn, tsel) + pn_off; bf16_t* base; int ld, ct, act = 0;
        if (pn < 4) { base = (bf16_t*)(ch + CH_Q); ld = 1024; ct = pn; }
        else if (pn == 4) { base = (bf16_t*)(ch + CH_K); ld = 256; ct = 0; }
        else if (pn == 5) { base = (bf16_t*)(ch + CH_V); ld = 256; ct = 0; }
        else if (pn < 12) { base = (bf16_t*)(ch + CH_HY); ld = 1536; ct = pn - 6; }
        else if (pn < 14) { base = (bf16_t*)(ch + CH_RX); ld = 512; ct = pn - 12; }
        else if (pn < 16) { base = (bf16_t*)(ch + CH_RG); ld = 512; ct = pn - 14; act = 1; }
        else { base = (bf16_t*)(ch + CH_GATE); ld = 3072; ct = pn - 16; act = 2; }
        const f32x4 one4 = {1.f, 1.f, 1.f, 1.f}; f32x4 sw0a = one4, sw0b = one4, sw1a = one4, sw1b = one4; float sxr[2][4];
        if (su) { const float* swp = sw + pn * 256 + wc * 32 + 8 * fq; sw0a = *(const f32x4*)swp; sw0b = *(const f32x4*)(swp + 4); sw1a = *(const f32x4*)(swp + 128); sw1b = *(const f32x4*)(swp + 132); }
#pragma unroll
        for (int ai = 0; ai < 2; ++ai)
#pragma unroll
            for (int m = 0; m < 4; ++m) sxr[ai][m] = su ? su[u.pm * 256 + wr * 64 + fr + ai * 128 + m * 16] : 1.f;
        const bool tiled = pn >= 16;
        const int etid = ((wr * 4 + wc) * 64) + fq * 16 + fr;
        int rl = wr * 64 + fr, cl = wc * 32 + 8 * fq; asm volatile("" : "+v"(rl), "+v"(cl));
        const int row0 = u.pm * 256 + rl, col0 = ct * 256 + cl;
#pragma unroll
        for (int ai = 0; ai < 2; ++ai)
#pragma unroll
            for (int m = 0; m < 4; ++m) { bf16_t* rowp = base + (size_t)(row0 + ai * 128 + m * 16) * ld + col0; u32x4 gpk = {0u, 0u, 0u, 0u};
#pragma unroll
                for (int bj = 0; bj < 2; ++bj) { f32x4 v0 = acc[ai][bj][m][0] * (bj ? sw1a : sw0a) * sxr[ai][m], v1 = acc[ai][bj][m][1] * (bj ? sw1b : sw0b) * sxr[ai][m];
                    if (act == 1) {
#pragma unroll
                        for (int j = 0; j < 4; ++j) { v0[j] = gelu_tanh_f(v0[j]); v1[j] = gelu_tanh_f(v1[j]); } }
                    else if (act == 2) {
#pragma unroll
                        for (int j = 0; j < 4; ++j) { v0[j] = sigmoid_f(v0[j]); v1[j] = sigmoid_f(v1[j]); } }
                    if (tiled) { unsigned lo = 0u, hi = 0u;
#pragma unroll
                        for (int j = 0; j < 4; ++j) { lo |= (unsigned)fmaxf(fmaf(255.0f, v0[j], 0.5f), 1.0f) << (8 * j); hi |= (unsigned)fmaxf(fmaf(255.0f, v1[j], 0.5f), 1.0f) << (8 * j); }
                        if (bj == 0) { gpk.x = lo; gpk.y = hi; } else { gpk.z = lo; gpk.w = hi; } }
                    else { u32x4 w; w.x = cvt_pk_bf16_nv(v0[0], v0[1]); w.y = cvt_pk_bf16_nv(v0[2], v0[3]); w.z = cvt_pk_bf16_nv(v1[0], v1[1]); w.w = cvt_pk_bf16_nv(v1[2], v1[3]);
                        *(u32x4*)(rowp + bj * 128) = w; } }
                if (tiled) *(u32x4*)((unsigned char*)base + ((((size_t)(u.pm * 12 + ct) * 8 + (ai * 4 + m)) * 512 + etid) << 4)) = gpk; }
    }
};
struct EpiPlain {
    static constexpr bool PERM = true, AFTER_DRAIN = false;
    bf16_t* O;
    __device__ __forceinline__ void operator()(const f32x4 (&acc)[2][2][4][2], const pg8::Unit& u, int wr, int wc, int fr, int fq) const {
        int rl = wr * 64 + fr, cl = wc * 32 + 8 * fq; asm volatile("" : "+v"(rl), "+v"(cl));
        const int row0 = u.pm * 256 + rl, col0 = u.pn * 256 + cl;
#pragma unroll
        for (int ai = 0; ai < 2; ++ai)
#pragma unroll
            for (int m = 0; m < 4; ++m)
#pragma unroll
                for (int bj = 0; bj < 2; ++bj) { const f32x4 v0 = acc[ai][bj][m][0], v1 = acc[ai][bj][m][1];
                    u32x4 w; w.x = cvt_pk_bf16_nv(v0[0], v0[1]); w.y = cvt_pk_bf16_nv(v0[2], v0[3]); w.z = cvt_pk_bf16_nv(v1[0], v1[1]); w.w = cvt_pk_bf16_nv(v1[2], v1[3]);
                    *(u32x4*)(O + (size_t)(row0 + ai * 128 + m * 16) * 1024 + col0 + bj * 128) = w; }
    }
};
template <bool ACCUM, bool FINAL> struct EpiMerge {
    static constexpr bool PERM = true, AFTER_DRAIN = false;
    bf16_t* Y; bf16_t* Yt; const unsigned char* gate; int sub;
    __device__ __forceinline__ void operator()(const f32x4 (&acc)[2][2][4][2], const pg8::Unit& u, int wr, int wc, int fr, int fq) const {
        int rl = wr * 64 + fr, cl = wc * 32 + 8 * fq, et = ((wr * 4 + wc) * 64) + fq * 16 + fr; asm volatile("" : "+v"(rl), "+v"(cl), "+v"(et));
        const int row0 = u.pm * 256 + rl, col0 = u.pn * 256 + cl;
        const unsigned char* gt = gate + (((size_t)(u.pm * 12 + 4 * sub + u.pn) * 8 * 512 + et) << 4); bf16_t* yt = Yt + (((size_t)(u.pm * 4 + u.pn) * 16 * 512 + et) << 3);
#pragma unroll
        for (int ai = 0; ai < 2; ++ai) {
            u32x4 gv[4], yv[4][2];
#pragma unroll
            for (int m = 0; m < 4; ++m) { gv[m] = *(const u32x4*)(gt + ((size_t)(ai * 4 + m) * 512 << 4));
#pragma unroll
                for (int bj = 0; bj < 2; ++bj) { const int k = ai * 8 + m * 2 + bj; if (ACCUM) yv[m][bj] = *(const u32x4*)(yt + ((size_t)k * 512 << 3)); } }
            asm volatile("" ::: "memory");
#pragma unroll
            for (int m = 0; m < 4; ++m)
#pragma unroll
                for (int bj = 0; bj < 2; ++bj) { const int k = ai * 8 + m * 2 + bj; const unsigned g0 = bj ? gv[m].z : gv[m].x, g1 = bj ? gv[m].w : gv[m].y;
                    f32x4 v0 = acc[ai][bj][m][0], v1 = acc[ai][bj][m][1];
                    v0[0] *= (float)(g0 & 255u); v0[1] *= (float)((g0 >> 8) & 255u); v0[2] *= (float)((g0 >> 16) & 255u); v0[3] *= (float)(g0 >> 24);
                    v1[0] *= (float)(g1 & 255u); v1[1] *= (float)((g1 >> 8) & 255u); v1[2] *= (float)((g1 >> 16) & 255u); v1[3] *= (float)(g1 >> 24);
                    if (ACCUM) { const u32x4 o = yv[m][bj]; v0[0] += bflo(o.x); v0[1] += bfhi(o.x); v0[2] += bflo(o.y); v0[3] += bfhi(o.y); v1[0] += bflo(o.z); v1[1] += bfhi(o.z); v1[2] += bflo(o.w); v1[3] += bfhi(o.w); }
                    u32x4 w; w.x = cvt_pk_bf16_nv(v0[0], v0[1]); w.y = cvt_pk_bf16_nv(v0[2], v0[3]); w.z = cvt_pk_bf16_nv(v1[0], v1[1]); w.w = cvt_pk_bf16_nv(v1[2], v1[3]);
                    if (FINAL) *(u32x4*)(Y + (size_t)(row0 + ai * 128 + m * 16) * 1024 + col0 + bj * 128) = w; else *(u32x4*)(yt + ((size_t)k * 512 << 3)) = w; }
            asm volatile("" ::: "memory");
        }
    }
};
struct GemmMerge { const bf16_t* A; const bf16_t* Bt; const bf16_t* A2; const bf16_t* Bt2; int K; static constexpr bool GATHER = false; static constexpr int ESZ = 2; static constexpr int NSEG = 2;
    __device__ __forceinline__ const char* a_tile(const pg8::Unit& u) const { return (const char*)A + (size_t)u.pm * 256 * K * 2; }
    __device__ __forceinline__ const char* b_tile(const pg8::Unit& u) const { return (const char*)Bt + (size_t)u.pn * 256 * K * 2; }
    __device__ __forceinline__ long seg_delta_a() const { return (long)((const char*)A2 - (const char*)A); }
    __device__ __forceinline__ long seg_delta_b() const { return (long)((const char*)Bt2 - (const char*)Bt); } };
struct EpiMergeFused {
    static constexpr bool PERM = true, AFTER_DRAIN = false;
    bf16_t* Y; const unsigned char* gate;
    __device__ __forceinline__ void mid(f32x4 (&acc)[2][2][4][2], const pg8::Unit& u, int stage, int wr, int wc, int fr, int fq) const {
        int et = ((wr * 4 + wc) * 64) + fq * 16 + fr; asm volatile("" : "+v"(et));
        const unsigned char* gn = gate + (((size_t)(u.pm * 12 + 4 * stage + u.pn) * 8 * 512 + et) << 4); const unsigned char* gd = gn + ((size_t)4 * 8 * 512 << 4);
        u32x4 nv[2][4], dv[2][4];
#pragma unroll
        for (int ai = 0; ai < 2; ++ai)
#pragma unroll
            for (int m = 0; m < 4; ++m) { nv[ai][m] = *(const u32x4*)(gn + ((size_t)(ai * 4 + m) * 512 << 4)); dv[ai][m] = *(const u32x4*)(gd + ((size_t)(ai * 4 + m) * 512 << 4)); }
        asm volatile("" ::: "memory");
#pragma unroll
        for (int ai = 0; ai < 2; ++ai)
#pragma unroll
            for (int m = 0; m < 4; ++m)
#pragma unroll
                for (int bj = 0; bj < 2; ++bj) { const unsigned n0 = bj ? nv[ai][m].z : nv[ai][m].x, n1 = bj ? nv[ai][m].w : nv[ai][m].y, d0 = bj ? dv[ai][m].z : dv[ai][m].x, d1 = bj ? dv[ai][m].w : dv[ai][m].y;
#pragma unroll
                    for (int j = 0; j < 4; ++j) { acc[ai][bj][m][0][j] *= (float)((n0 >> (8 * j)) & 255u) * __builtin_amdgcn_rcpf((float)((d0 >> (8 * j)) & 255u));
                                                  acc[ai][bj][m][1][j] *= (float)((n1 >> (8 * j)) & 255u) * __builtin_amdgcn_rcpf((float)((d1 >> (8 * j)) & 255u)); }
                    __builtin_amdgcn_sched_barrier(0); }
        asm volatile("" ::: "memory");
    }
    __device__ __forceinline__ void operator()(const f32x4 (&acc)[2][2][4][2], const pg8::Unit& u, int wr, int wc, int fr, int fq) const {
        int rl = wr * 64 + fr, cl = wc * 32 + 8 * fq, et = ((wr * 4 + wc) * 64) + fq * 16 + fr; asm volatile("" : "+v"(rl), "+v"(cl), "+v"(et));
        const int row0 = u.pm * 256 + rl, col0 = u.pn * 256 + cl;
        const unsigned char* gt = gate + (((size_t)(u.pm * 12 + 8 + u.pn) * 8 * 512 + et) << 4);
#pragma unroll
        for (int ai = 0; ai < 2; ++ai) { u32x4 gv[4];
#pragma unroll
            for (int m = 0; m < 4; ++m) gv[m] = *(const u32x4*)(gt + ((size_t)(ai * 4 + m) * 512 << 4));
            asm volatile("" ::: "memory");
#pragma unroll
            for (int m = 0; m < 4; ++m)
#pragma unroll
                for (int bj = 0; bj < 2; ++bj) { const unsigned g0 = bj ? gv[m].z : gv[m].x, g1 = bj ? gv[m].w : gv[m].y;
                    f32x4 v0 = acc[ai][bj][m][0], v1 = acc[ai][bj][m][1];
                    v0[0] *= (float)(g0 & 255u); v0[1] *= (float)((g0 >> 8) & 255u); v0[2] *= (float)((g0 >> 16) & 255u); v0[3] *= (float)(g0 >> 24);
                    v1[0] *= (float)(g1 & 255u); v1[1] *= (float)((g1 >> 8) & 255u); v1[2] *= (float)((g1 >> 16) & 255u); v1[3] *= (float)(g1 >> 24);
                    u32x4 w; w.x = cvt_pk_bf16_nv(v0[0], v0[1]); w.y = cvt_pk_bf16_nv(v0[2], v0[3]); w.z = cvt_pk_bf16_nv(v1[0], v1[1]); w.w = cvt_pk_bf16_nv(v1[2], v1[3]);
                    *(u32x4*)(Y + (size_t)(row0 + ai * 128 + m * 16) * 1024 + col0 + bj * 128) = w; }
            asm volatile("" ::: "memory");
        }
    }
};
struct EpiDelta {
    static constexpr bool PERM = true, AFTER_DRAIN = false;
    bf16_t* DLT; const float* modl; int chunk;
    __device__ __forceinline__ void operator()(const f32x4 (&acc)[2][2][4][2], const pg8::Unit& u, int wr, int wc, int fr, int fq) const {
        const int bl = u.pm / 17, p = u.pm - bl * 17, b = chunk * BC + bl;
        const float* g1 = modl + ((size_t)(p == 0 ? 16 : b) * 6 + 2) * DM;
        int rl = wr * 64 + fr, cl = wc * 32 + 8 * fq; asm volatile("" : "+v"(rl), "+v"(cl));
        const int row0 = u.pm * 256 + rl, col0 = u.pn * 256 + cl;
        f32x4 gv[2][2];
#pragma unroll
        for (int bj = 0; bj < 2; ++bj)
#pragma unroll
            for (int n = 0; n < 2; ++n) gv[bj][n] = *(const f32x4*)(g1 + col0 + bj * 128 + 4 * n);
#pragma unroll
        for (int ai = 0; ai < 2; ++ai)
#pragma unroll
            for (int m = 0; m < 4; ++m) { bf16_t* rowp = DLT + (size_t)(row0 + ai * 128 + m * 16) * 1024 + col0;
#pragma unroll
                for (int bj = 0; bj < 2; ++bj) { const f32x4 v0 = acc[ai][bj][m][0] * gv[bj][0], v1 = acc[ai][bj][m][1] * gv[bj][1];
                    u32x4 w; w.x = cvt_pk_bf16_nv(v0[0], v0[1]); w.y = cvt_pk_bf16_nv(v0[2], v0[3]); w.z = cvt_pk_bf16_nv(v1[0], v1[1]); w.w = cvt_pk_bf16_nv(v1[2], v1[3]);
                    *(u32x4*)(rowp + bj * 128) = w; } }
    }
};
struct EpiResid {
    static constexpr bool PERM = false, AFTER_DRAIN = false;
    float* out; float* hc; const float* modl; int chunk; const float* rin; const float* rinc;
    __device__ __forceinline__ void operator()(const f32x4 (&acc)[2][2][4][2], const pg8::Unit& u, int wr, int wc, int fr, int fq) const {
        const int bl = u.pm / 17, p = u.pm - bl * 17, b = chunk * BC + bl;
        float* tb = p == 0 ? hc + ((size_t)(b * CTX) << 10) : out + ((size_t)(b * SEQ + (p - 1) * 256) << 10);
        const float* tr = p == 0 ? rinc + ((size_t)(b * CTX) << 10) : rin + ((size_t)(b * SEQ + (p - 1) * 256) << 10);
        const float* g1 = modl + ((size_t)(p == 0 ? 16 : b) * 6 + 2) * DM;
        int rl = wr * 64 + fr, cl = wc * 32 + 4 * fq; asm volatile("" : "+v"(rl), "+v"(cl));
        const int row0 = rl, col0 = u.pn * 256 + cl;
        f32x4 gv[2][2];
#pragma unroll
        for (int bj = 0; bj < 2; ++bj)
#pragma unroll
            for (int n = 0; n < 2; ++n) gv[bj][n] = *(const f32x4*)(g1 + col0 + bj * 128 + n * 16);
#pragma unroll
        for (int ai = 0; ai < 2; ++ai) {
            f32x4 hv[4][2][2];
#pragma unroll
            for (int m = 0; m < 4; ++m)
#pragma unroll
                for (int bj = 0; bj < 2; ++bj)
#pragma unroll
                    for (int n = 0; n < 2; ++n) hv[m][bj][n] = *(const f32x4*)(tr + (size_t)(row0 + ai * 128 + m * 16) * DM + col0 + bj * 128 + n * 16);
            asm volatile("" ::: "memory");
#pragma unroll
            for (int m = 0; m < 4; ++m)
#pragma unroll
                for (int bj = 0; bj < 2; ++bj)
#pragma unroll
                    for (int n = 0; n < 2; ++n) *(f32x4*)(tb + (size_t)(row0 + ai * 128 + m * 16) * DM + col0 + bj * 128 + n * 16) = hv[m][bj][n] + gv[bj][n] * acc[ai][bj][m][n];
            asm volatile("" ::: "memory");
        }
    }
};
struct EpiSwiglu {
    static constexpr bool PERM = true, AFTER_DRAIN = false;
    bf16_t* HID;
    __device__ __forceinline__ void operator()(const f32x4 (&acc)[2][2][4][2], const pg8::Unit& u, int wr, int wc, int fr, int fq) const {
        int rl = wr * 64 + fr, cl = wc * 32 + 8 * fq; asm volatile("" : "+v"(rl), "+v"(cl));
        const int row0 = u.pm * 256 + rl, col0 = u.pn * 128 + cl;
#pragma unroll
        for (int ai = 0; ai < 2; ++ai)
#pragma unroll
            for (int m = 0; m < 4; ++m) { f32x4 v0, v1;
#pragma unroll
                for (int j = 0; j < 4; ++j) { v0[j] = silu_f(acc[ai][0][m][0][j]) * acc[ai][1][m][0][j]; v1[j] = silu_f(acc[ai][0][m][1][j]) * acc[ai][1][m][1][j]; }
                u32x4 w; w.x = cvt_pk_bf16_nv(v0[0], v0[1]); w.y = cvt_pk_bf16_nv(v0[2], v0[3]); w.z = cvt_pk_bf16_nv(v1[0], v1[1]); w.w = cvt_pk_bf16_nv(v1[2], v1[3]);
                *(u32x4*)(HID + (size_t)(row0 + ai * 128 + m * 16) * 1024 + col0) = w; }
    }
};
struct EpiSwigluQ {
    static constexpr bool PERM = true, AFTER_DRAIN = false;
    bf16_t* HID; const float* xscl; const float* sw13;
    __device__ __forceinline__ void operator()(const f32x4 (&acc)[2][2][4][2], const pg8::Unit& u, int wr, int wc, int fr, int fq) const {
        int rl = wr * 64 + fr, cl = wc * 32 + 8 * fq; asm volatile("" : "+v"(rl), "+v"(cl));
        const int row0 = u.pm * 256 + rl, col0 = u.pn * 128 + cl; const int e = u.pm / XPAN;
        const float* swp = sw13 + (size_t)e * 2048 + u.pn * 256 + cl;
        const f32x4 s1a = *(const f32x4*)swp, s1b = *(const f32x4*)(swp + 4), s3a = *(const f32x4*)(swp + 128), s3b = *(const f32x4*)(swp + 132);
        float sx[2][4];
#pragma unroll
        for (int ai = 0; ai < 2; ++ai)
#pragma unroll
            for (int m = 0; m < 4; ++m) sx[ai][m] = xscl[row0 + ai * 128 + m * 16];
        asm volatile("" ::: "memory");
#pragma unroll
        for (int ai = 0; ai < 2; ++ai)
#pragma unroll
            for (int m = 0; m < 4; ++m) { const float s = sx[ai][m]; f32x4 v0, v1;
#pragma unroll
                for (int j = 0; j < 4; ++j) { v0[j] = silu_f(acc[ai][0][m][0][j] * (s * s1a[j])) * (acc[ai][1][m][0][j] * (s * s3a[j])); v1[j] = silu_f(acc[ai][0][m][1][j] * (s * s1b[j])) * (acc[ai][1][m][1][j] * (s * s3b[j])); }
                u32x4 w; w.x = cvt_pk_bf16_nv(v0[0], v0[1]); w.y = cvt_pk_bf16_nv(v0[2], v0[3]); w.z = cvt_pk_bf16_nv(v1[0], v1[1]); w.w = cvt_pk_bf16_nv(v1[2], v1[3]);
                *(u32x4*)(HID + (size_t)(row0 + ai * 128 + m * 16) * 1024 + col0) = w; }
    }
};
struct EpiDown {
    static constexpr bool PERM = true, AFTER_DRAIN = false;
    bf16_t* YS; const float* gatev;
    __device__ __forceinline__ void operator()(const f32x4 (&acc)[2][2][4][2], const pg8::Unit& u, int wr, int wc, int fr, int fq) const {
        int rl = wr * 64 + fr, cl = wc * 32 + 8 * fq; asm volatile("" : "+v"(rl), "+v"(cl));
        const int row0 = u.pm * 256 + rl, col0 = u.pn * 256 + cl;
        float gq[2][4];
#pragma unroll
        for (int ai = 0; ai < 2; ++ai)
#pragma unroll
            for (int m = 0; m < 4; ++m) gq[ai][m] = gatev[row0 + ai * 128 + m * 16];
        asm volatile("" ::: "memory");
#pragma unroll
        for (int ai = 0; ai < 2; ++ai)
#pragma unroll
            for (int m = 0; m < 4; ++m) { const int row = row0 + ai * 128 + m * 16; const float g = gq[ai][m];
#pragma unroll
                for (int bj = 0; bj < 2; ++bj) { const f32x4 v0 = acc[ai][bj][m][0] * g, v1 = acc[ai][bj][m][1] * g;
                    u32x4 w; w.x = cvt_pk_bf16_nv(v0[0], v0[1]); w.y = cvt_pk_bf16_nv(v0[2], v0[3]); w.z = cvt_pk_bf16_nv(v1[0], v1[1]); w.w = cvt_pk_bf16_nv(v1[2], v1[3]);
                    *(u32x4*)(YS + (size_t)row * 1024 + col0 + bj * 128) = w; } }
    }
};

__device__ __forceinline__ u32x4 qk_head8(u32x4 raw, const float (&g)[8], const float (&cs)[8], const float (&sn)[8], bool second) {
    float x[8] = {bflo(raw.x), bfhi(raw.x), bflo(raw.y), bfhi(raw.y), bflo(raw.z), bfhi(raw.z), bflo(raw.w), bfhi(raw.w)};
    float ss = 0.f;
#pragma unroll
    for (int k = 0; k < 8; ++k) ss = fmaf(x[k], x[k], ss);
    ss = row16_sum(ss);
    const float rms = rsqrtf(ss * (1.f / 128.f) + NORM_EPS);
    float o[8];
#pragma unroll
    for (int k = 0; k < 8; ++k) { const float y = x[k] * rms * g[k], pr = row16_xor8(y); o[k] = second ? fmaf(pr, sn[k], y * cs[k]) : fmaf(-pr, sn[k], y * cs[k]); }
    u32x4 w; w.x = cvt_pk_bf16_nv(o[0], o[1]); w.y = cvt_pk_bf16_nv(o[2], o[3]); w.z = cvt_pk_bf16_nv(o[4], o[5]); w.w = cvt_pk_bf16_nv(o[6], o[7]); return w;
}
__device__ __forceinline__ void p_qknorm(const Frame& F, int l, unsigned char* ch) {
    const int gw = F.bid * 8 + F.wave, NGW = F.G * 8, lane = F.lane, rsel = lane >> 5, hk = (lane >> 4) & 1, l16 = lane & 15, pi = (l16 & 7) * 8; const bool second = l16 >= 8;
    const float* ropc = (const float*)(F.ws + WS_ROPE); const float* rops = ropc + SEQ * 64;
    float gk[8];
    { const float* kg = FIN(I_KNG) + l * 128 + (second ? 64 : 0) + pi;
#pragma unroll
      for (int k = 0; k < 8; ++k) gk[k] = kg[k]; }
    for (int r0 = gw * 2; r0 < RC; r0 += 4 * NGW) {
        const int ra = r0 + rsel, rbq = r0 + 2 * NGW + rsel; const bool twob = r0 + 2 * NGW < RC; const int rb = twob ? rbq : ra;
        bf16_t* kpa = (bf16_t*)(ch + CH_K) + (size_t)ra * 256 + hk * 128 + l16 * 8; bf16_t* kpb = (bf16_t*)(ch + CH_K) + (size_t)rb * 256 + hk * 128 + l16 * 8;
        const u32x4 a2 = *(const u32x4*)kpa, b2 = *(const u32x4*)kpb;
        const int posa = ra % TOK, posb = rb % TOK; float csa[8], sna[8], csb[8], snb[8];
#pragma unroll
        for (int k = 0; k < 8; ++k) { csa[k] = 1.f; sna[k] = 0.f; csb[k] = 1.f; snb[k] = 0.f; }
        if (posa >= CTX) { const f32x4* cp = (const f32x4*)(ropc + (size_t)(posa - CTX) * 64 + pi); const f32x4* sp = (const f32x4*)(rops + (size_t)(posa - CTX) * 64 + pi);
            const f32x4 c0 = cp[0], c1 = cp[1], s0 = sp[0], s1 = sp[1];
            csa[0] = c0.x; csa[1] = c0.y; csa[2] = c0.z; csa[3] = c0.w; csa[4] = c1.x; csa[5] = c1.y; csa[6] = c1.z; csa[7] = c1.w;
            sna[0] = s0.x; sna[1] = s0.y; sna[2] = s0.z; sna[3] = s0.w; sna[4] = s1.x; sna[5] = s1.y; sna[6] = s1.z; sna[7] = s1.w; }
        if (posb >= CTX) { const f32x4* cp = (const f32x4*)(ropc + (size_t)(posb - CTX) * 64 + pi); const f32x4* sp = (const f32x4*)(rops + (size_t)(posb - CTX) * 64 + pi);
            const f32x4 c0 = cp[0], c1 = cp[1], s0 = sp[0], s1 = sp[1];
            csb[0] = c0.x; csb[1] = c0.y; csb[2] = c0.z; csb[3] = c0.w; csb[4] = c1.x; csb[5] = c1.y; csb[6] = c1.z; csb[7] = c1.w;
            snb[0] = s0.x; snb[1] = s0.y; snb[2] = s0.z; snb[3] = s0.w; snb[4] = s1.x; snb[5] = s1.y; snb[6] = s1.z; snb[7] = s1.w; }
        asm volatile("" ::: "memory");
        const u32x4 wa2 = qk_head8(a2, gk, csa, sna, second), wb2 = qk_head8(b2, gk, csb, snb, second);
        *(u32x4*)kpa = wa2; if (twob) *(u32x4*)kpb = wb2;
    }
}
struct Rows3 { u32x4 a, b, c; };
__device__ __forceinline__ Rows3 conv3_load(const bf16_t* hy, size_t rowoff, int ch0, bool hasl, bool hasr) {
    const u32x4 z = {0u, 0u, 0u, 0u}; Rows3 r;
    r.a = hasl ? *(const u32x4*)(hy + rowoff - 1536 + ch0) : z; r.b = *(const u32x4*)(hy + rowoff + ch0); r.c = hasr ? *(const u32x4*)(hy + rowoff + 1536 + ch0) : z; return r;
}
__device__ __forceinline__ void conv3_calc(const Rows3& r, const LAS float* WT, int cl, float (&o)[8]) {
    const unsigned aw[4] = {r.a.x, r.a.y, r.a.z, r.a.w}, bw[4] = {r.b.x, r.b.y, r.b.z, r.b.w}, cw[4] = {r.c.x, r.c.y, r.c.z, r.c.w};
    const LAS f32x4* w0 = (const LAS f32x4*)(WT + cl); const LAS f32x4* w1 = (const LAS f32x4*)(WT + 128 + cl); const LAS f32x4* w2 = (const LAS f32x4*)(WT + 256 + cl); const LAS f32x4* b4 = (const LAS f32x4*)(WT + 384 + cl);
#pragma unroll
    for (int h = 0; h < 2; ++h) { const f32x4 wa = w0[h], wb = w1[h], wc = w2[h], bv = b4[h];
#pragma unroll
        for (int q = 0; q < 2; ++q) { const int j = 2 * h + q;
            o[2 * j] = bv[2 * q] + wa[2 * q] * bflo(aw[j]) + wb[2 * q] * bflo(bw[j]) + wc[2 * q] * bflo(cw[j]);
            o[2 * j + 1] = bv[2 * q + 1] + wa[2 * q + 1] * bfhi(aw[j]) + wb[2 * q + 1] * bfhi(bw[j]) + wc[2 * q + 1] * bfhi(cw[j]); } }
}
__device__ __forceinline__ void p_hyena_pre(const Frame& F, int l, unsigned char* ch) {
    const bf16_t* hy = (const bf16_t*)(ch + CH_HY); bf16_t* X0 = (bf16_t*)(ch + CH_X0); bf16_t* PT = (bf16_t*)(ch + CH_P);
    const float* w = FIN(I_HYCW) + (size_t)l * 3 * 1536; const float* bb = FIN(I_HYCB) + l * 1536;
    LAS bf16_t* T = (LAS bf16_t*)F.lds;
    LAS float* WT = (LAS float*)(F.lds + 32768);
    const int rr = F.tid >> 3, cs = F.tid & 7, cc = F.tid >> 2, pc = F.tid & 3;
    int cb_loaded = -1;
    for (int u = F.bid; u < (RC / 64) * 4; u += F.G) {
        const int rb = u >> 2, cb = u & 3, r = rb * 64 + rr, pos = r % TOK, c0 = cb * 128 + cs * 16;
        if (cb != cb_loaded) { __syncthreads();
            for (int i = F.tid; i < 3 * 4 * 128; i += 512) { const int gq = i / 512, j = (i >> 7) & 3, c = i & 127, chn = gq * 512 + cb * 128 + c; WT[i] = j < 3 ? w[j * 1536 + chn] : bb[chn]; }
            cb_loaded = cb; }
        const bool hasl = pos != 0 && pos != CTX, hasr = pos != CTX - 1 && pos != TOK - 1;
        __syncthreads();
        Rows3 ld[2][3];
#pragma unroll
        for (int h = 0; h < 2; ++h)
#pragma unroll
            for (int gq = 0; gq < 3; ++gq) ld[h][gq] = conv3_load(hy, (size_t)r * 1536, gq * 512 + c0 + 8 * h, hasl, hasr);
        asm volatile("" ::: "memory");
#pragma unroll
        for (int h = 0; h < 2; ++h) { const int c8 = c0 + 8 * h, cl = cs * 16 + 8 * h; float x0[8], x1[8], v[8];
            conv3_calc(ld[h][0], WT, cl, x0); conv3_calc(ld[h][1], WT + 512, cl, x1); conv3_calc(ld[h][2], WT + 1024, cl, v);
            u32x4 a; a.x = cvt_pk_bf16_nv(x0[0], x0[1]); a.y = cvt_pk_bf16_nv(x0[2], x0[3]); a.z = cvt_pk_bf16_nv(x0[4], x0[5]); a.w = cvt_pk_bf16_nv(x0[6], x0[7]);
            *(u32x4*)(X0 + (size_t)r * 512 + c8) = a;
#pragma unroll
            for (int k = 0; k < 8; ++k) T[(cs * 16 + 8 * h + k) * 72 + rr] = f2bf(v[k] * x1[k]);
            asm volatile("" ::: "memory"); }
        __syncthreads();
        const int r0 = rb * 64, bl = r0 / TOK, pos0 = r0 - bl * TOK, c = cb * 128 + cc;
        const u32x4 t0 = *(const LAS u32x4*)(T + cc * 72 + 16 * pc), t1 = *(const LAS u32x4*)(T + cc * 72 + 16 * pc + 8);
        u32x4* dst = (u32x4*)(PT + ((size_t)c * BC + bl) * TOK + pos0 + 16 * pc); dst[0] = t0; dst[1] = t1;
    }
    __syncthreads();
}
__device__ __forceinline__ void p_hyena_post(const Frame& F, unsigned char* ch) {
    const bf16_t* X0 = (const bf16_t*)(ch + CH_X0); const bf16_t* YT = (const bf16_t*)(ch + CH_YT); bf16_t* HYO = (bf16_t*)(ch + CH_HL);
    LAS bf16_t* T = (LAS bf16_t*)F.lds;
    const int rr = F.tid >> 3, cs = F.tid & 7, cc = F.tid >> 2, pc = F.tid & 3;
    for (int u = F.bid; u < (RC / 64) * 4; u += F.G) {
        const int rb = u >> 2, cb = u & 3, r0 = rb * 64, bl = r0 / TOK, pos0 = r0 - bl * TOK, c = cb * 128 + cc;
        __syncthreads();
        const u32x4* src = (const u32x4*)(YT + ((size_t)c * BC + bl) * TOK + pos0 + 16 * pc);
        const int r = r0 + rr, c0 = cb * 128 + cs * 16;
        const u32x4 y0 = src[0], y1 = src[1], xa = *(const u32x4*)(X0 + (size_t)r * 512 + c0), xb = *(const u32x4*)(X0 + (size_t)r * 512 + c0 + 8);
        *(LAS u32x4*)(T + cc * 72 + 16 * pc) = y0; *(LAS u32x4*)(T + cc * 72 + 16 * pc + 8) = y1;
        __syncthreads();
#pragma unroll
        for (int h = 0; h < 2; ++h) { const int c8 = c0 + 8 * h; const u32x4 x = h ? xb : xa; const unsigned xw[4] = {x.x, x.y, x.z, x.w}; unsigned ow[4];
#pragma unroll
            for (int k = 0; k < 4; ++k) { const float y0f = bf2f(T[(cs * 16 + 8 * h + 2 * k) * 72 + rr]), y1f = bf2f(T[(cs * 16 + 8 * h + 2 * k + 1) * 72 + rr]); ow[k] = cvt_pk_bf16_nv(bflo(xw[k]) * y0f, bfhi(xw[k]) * y1f); }
            u32x4 o; o.x = ow[0]; o.y = ow[1]; o.z = ow[2]; o.w = ow[3]; *(u32x4*)(HYO + (size_t)r * 1024 + c8) = o; }
    }
    __syncthreads();
}
__device__ __forceinline__ void p_lru_conv(const Frame& F, int l, unsigned char* ch) {
    const bf16_t* rx = (const bf16_t*)(ch + CH_RX); bf16_t* XC = (bf16_t*)(ch + CH_XC);
    const float* w = FIN(I_LCW) + (size_t)l * 4 * 512; const float* bb = FIN(I_LCB) + l * 512;
    const size_t total = (size_t)RC * 64, stride = (size_t)F.G * 512;
    const int cfix = (F.tid & 63) * 8;
    float wq[4][8], bq8[8];
    { const f32x4 b0 = *(const f32x4*)(bb + cfix), b1 = *(const f32x4*)(bb + cfix + 4); bq8[0] = b0.x; bq8[1] = b0.y; bq8[2] = b0.z; bq8[3] = b0.w; bq8[4] = b1.x; bq8[5] = b1.y; bq8[6] = b1.z; bq8[7] = b1.w;
#pragma unroll
      for (int j = 0; j < 4; ++j) { const f32x4 w0 = *(const f32x4*)(w + j * 512 + cfix), w1 = *(const f32x4*)(w + j * 512 + cfix + 4);
          wq[j][0] = w0.x; wq[j][1] = w0.y; wq[j][2] = w0.z; wq[j][3] = w0.w; wq[j][4] = w1.x; wq[j][5] = w1.y; wq[j][6] = w1.z; wq[j][7] = w1.w; } }
    for (size_t i0 = (size_t)F.bid * 512 + F.tid; i0 < total; i0 += 2 * stride) {
        u32x4 xv[2][4]; int rr[2], cc[2]; bool val[2][4];
#pragma unroll
        for (int t = 0; t < 2; ++t) { const size_t i = i0 + t * stride < total ? i0 + t * stride : i0; const int r = (int)(i >> 6), c0 = (int)(i & 63) * 8, pos = r % TOK;
            const int lo = pos < CTX ? 0 : CTX, hi = pos < CTX ? CTX : TOK; rr[t] = r; cc[t] = c0;
#pragma unroll
            for (int j = 0; j < 4; ++j) { const int pp = pos - 2 + j; val[t][j] = pp >= lo && pp < hi; xv[t][j] = val[t][j] ? *(const u32x4*)(rx + (size_t)(r - 2 + j) * 512 + c0) : (u32x4){0u, 0u, 0u, 0u}; } }
        asm volatile("" ::: "memory");
#pragma unroll
        for (int t = 0; t < 2; ++t) { if (t == 1 && i0 + stride >= total) break; const int r = rr[t], c0 = cc[t];
            float o[8];
#pragma unroll
            for (int q = 0; q < 8; ++q) o[q] = bq8[q];
#pragma unroll
            for (int j = 0; j < 4; ++j) { const u32x4 x = xv[t][j]; const unsigned xw[4] = {x.x, x.y, x.z, x.w};
#pragma unroll
                for (int q = 0; q < 4; ++q) { o[2 * q] += wq[j][2 * q] * bflo(xw[q]); o[2 * q + 1] += wq[j][2 * q + 1] * bfhi(xw[q]); } }
            u32x4 a; a.x = cvt_pk_bf16_nv(o[0], o[1]); a.y = cvt_pk_bf16_nv(o[2], o[3]); a.z = cvt_pk_bf16_nv(o[4], o[5]); a.w = cvt_pk_bf16_nv(o[6], o[7]);
            *(u32x4*)(XC + (size_t)r * 512 + c0) = a; }
    }
}

__device__ __forceinline__ void p_attention(const Frame& F, int l, unsigned char* ch, bool with_ctx, bf16_t* O) {
    bf16_t* Q = (bf16_t*)(ch + CH_Q); const bf16_t* K = (const bf16_t*)(ch + CH_K); const bf16_t* V = (const bf16_t*)(ch + CH_V);
    const float* qgain = FIN(I_QNG) + l * 128; const float* ropc = (const float*)(F.ws + WS_ROPE); const float* rops = ropc + SEQ * 64;
    const int nunits = BC * 8 * 16 + (with_ctx ? BC * 8 : 0);
    const bool xmap = false;
    for (int u = F.bid; u < nunits; u += F.G) {
        int bl, h, qrow0, seq;
        if (u < BC * 8 * 16) { int qb;
            if (xmap) { const int i = u >> 8, x = F.bid & 7, j = F.bid >> 3, grp = i * 4 + (x >> 1), w = (x & 1) * 32 + j; bl = grp >> 1; h = (grp & 1) * 4 + (w >> 4); qb = w & 15; }
            else { qb = u & 15; h = (u >> 4) & 7; bl = u >> 7; }
            qrow0 = bl * TOK + CTX + qb * 256; seq = TOK; }
        else { const int uu = u - BC * 8 * 16; h = uu & 7; bl = uu >> 3; qrow0 = bl * TOK; seq = CTX; }
        const size_t q0 = (size_t)qrow0 * 1024 + h * 128, k0 = (size_t)(bl * TOK) * 256 + (h >> 2) * 128;
        att::attn_dense_body(Q + q0, K + k0, V + k0, O + q0, seq, (char*)F.lds_gen, F.tid, qgain, ropc, rops, seq == TOK ? qrow0 - bl * TOK - CTX : -1);
    }
}
template <int J, int NSEG>
__device__ __forceinline__ void conv_task(const LAS unsigned char* cop, const bf16_t* PTc, bf16_t* YTc, float bias, int q, int par, int lane) {
    constexpr int CL = 2 * NSEG + 16, NSTEP = NSEG / 32;
    const int i = lane & 15, g = lane >> 4, il = i & 7, ih = i >> 3, A0 = J * q;
    const int abase = (il * CL + NSEG - 16 * par + 8 * g - 8 * ih) * 2;
    bf16x8 fw[J]; f32x4 acc[J];
#pragma unroll
    for (int j = 0; j < J; ++j) { acc[j] = (f32x4){0.f, 0.f, 0.f, 0.f}; fw[j] = (bf16x8){0, 0, 0, 0, 0, 0, 0, 0}; }
#pragma unroll
    for (int j = 1; j < J; ++j) fw[j] = *(const LAS bf16x8*)(cop + abase - 64 * (A0 + j));
    const bool bval = i < BC;
    const bf16_t* bp = PTc + (size_t)(i % BC) * TOK + 8 * g;
    const bf16x8 zero8 = (bf16x8){0, 0, 0, 0, 0, 0, 0, 0};
    bf16x8 bq[4];
#pragma unroll
    for (int s = 0; s < 4; ++s) bq[s] = (bval && s < NSTEP) ? *(const bf16x8*)(bp + 32 * s) : zero8;
    for (int bb0 = 0; bb0 < NSTEP; bb0 += J) {
#pragma unroll
        for (int bb = 0; bb < J; ++bb) {
            const int b = bb0 + bb;
            fw[(J - bb) % J] = *(const LAS bf16x8*)(cop + abase - 64 * (A0 - b));
            const bf16x8 bcur = bq[bb & 3];
            bq[bb & 3] = (bval && b + 4 < NSTEP) ? *(const bf16x8*)(bp + 32 * (b + 4)) : zero8;
            asm volatile("" ::: "memory");
#pragma unroll
            for (int j = 1; j < J; ++j) acc[j] = __builtin_amdgcn_mfma_f32_16x16x32_bf16(fw[(j - bb + J) % J], bcur, acc[j], 0, 0, 0);
            acc[0] = __builtin_amdgcn_mfma_f32_16x16x32_bf16(fw[(J - bb) % J], bcur, acc[0], 0, 0, 0);
        }
    }
    if (bval) {
        u32x2 pvv[J];
#pragma unroll
        for (int j = 0; j < J; ++j) pvv[j] = *(const u32x2*)(PTc + (size_t)i * TOK + 16 * (2 * J * q + par + 2 * j) + 4 * g);
        asm volatile("" ::: "memory");
#pragma unroll
        for (int j = 0; j < J; ++j) { const size_t idx = (size_t)i * TOK + 16 * (2 * J * q + par + 2 * j) + 4 * g; const u32x2 pv = pvv[j]; u32x2 o;
            o.x = cvt_pk_bf16_nv(acc[j][0] + bias * bflo(pv.x), acc[j][1] + bias * bfhi(pv.x)); o.y = cvt_pk_bf16_nv(acc[j][2] + bias * bflo(pv.y), acc[j][3] + bias * bfhi(pv.y));
            *(u32x2*)(YTc + idx) = o; }
    }
}
template <int NSEG>
__device__ __forceinline__ void conv_build_copies(const Frame& F, const bf16_t* FRc) {
    constexpr int CL = 2 * NSEG + 16, NCK = CL / 8;
    LAS bf16_t* C = (LAS bf16_t*)F.lds;
    for (int k = F.tid; k < NCK; k += 512) *(LAS u32x4*)(C + 8 * k) = *(const u32x4*)(FRc + 8 * k);
    __syncthreads();
    for (int id = F.tid; id < 7 * NCK; id += 512) { const int a = 1 + id / NCK, k = id - (a - 1) * NCK; unsigned w[4];
#pragma unroll
        for (int e = 0; e < 4; ++e) { const int x0 = 8 * k + 2 * e - a, x1 = x0 + 1; const unsigned lo = x0 >= 0 ? C[x0] : 0u, hi = x1 >= 0 ? C[x1] : 0u; w[e] = lo | (hi << 16); }
        u32x4 o; o.x = w[0]; o.y = w[1]; o.z = w[2]; o.w = w[3]; *(LAS u32x4*)(C + a * CL + 8 * k) = o; }
    __syncthreads();
}
__device__ __forceinline__ void p_hyena_conv(const Frame& F, int l, unsigned char* ch) {
    const bf16_t* PT = (const bf16_t*)(ch + CH_P); bf16_t* YT = (bf16_t*)(ch + CH_YT);
    const float* bias = FIN(I_HYBIAS) + l * 512;
    for (int u = F.bid; u < 1024; u += F.G) {
        const int c = u & 511, seg = u >> 9;
        __syncthreads();
        if (seg == 0) { conv_build_copies<SEQ>(F, (const bf16_t*)(F.ws + WS_FRL) + (size_t)c * (2 * SEQ + 16));
            const float bc = bias[c];
#pragma unroll 1
            for (int task = F.wave; task < 16; task += 8)
                conv_task<16, SEQ>((const LAS unsigned char*)F.lds, PT + (size_t)c * BC * TOK + CTX, YT + (size_t)c * BC * TOK + CTX, bc, task & 7, task >> 3, F.lane); }
        else { conv_build_copies<CTX>(F, (const bf16_t*)(F.ws + WS_FRC) + (size_t)c * (2 * CTX + 16));
            if (F.wave < 2) conv_task<8, CTX>((const LAS unsigned char*)F.lds, PT + (size_t)c * BC * TOK, YT + (size_t)c * BC * TOK, bias[c], 0, F.wave, F.lane); }
    }
    __syncthreads();
}
__device__ __forceinline__ int lru_pos(int d, int tau) { return d == 0 ? tau : (tau < CTX ? CTX - 1 - tau : TOK + CTX - 1 - tau); }
__device__ __forceinline__ void p_lru_scan(const Frame& F, int l, unsigned char* ch) {
    LAS float* ab = (LAS float*)(F.lds + F.wave * 16384);
    LAS float* agg = (LAS float*)(F.lds + 131072);
    const int lane = F.lane, n = lane & 15, g = lane >> 4, wave = F.wave;
    for (int u = F.bid; u < BC * 8 * 2; u += F.G)
    for (int d = 0; d < 2; ++d) {
        const int half = u & 1, nb = (u >> 1) & 7, bl = u >> 4;
        const float* wa = FIN(I_LWA) + ((size_t)(l * 2 + d) * 8 + nb) * 4096; const float* wx = FIN(I_LWX) + ((size_t)(l * 2 + d) * 8 + nb) * 4096;
        bf16x8 Bwa[2][2], Bwx[2][2]; float ba[2], bx[2], sp8[2];
#pragma unroll
        for (int kh = 0; kh < 2; ++kh)
#pragma unroll
            for (int nh = 0; nh < 2; ++nh) { const int col = half * 32 + nh * 16 + n, k0 = 32 * kh + 8 * g; float wf[8], xf[8];
#pragma unroll
                for (int e = 0; e < 8; ++e) { wf[e] = wa[(k0 + e) * 64 + col]; xf[e] = wx[(k0 + e) * 64 + col]; }
                asm volatile("" ::: "memory");
                u32x4 t; t.x = cvt_pk_bf16_nv(wf[0], wf[1]); t.y = cvt_pk_bf16_nv(wf[2], wf[3]); t.z = cvt_pk_bf16_nv(wf[4], wf[5]); t.w = cvt_pk_bf16_nv(wf[6], wf[7]); Bwa[kh][nh] = __builtin_bit_cast(bf16x8, t);
                t.x = cvt_pk_bf16_nv(xf[0], xf[1]); t.y = cvt_pk_bf16_nv(xf[2], xf[3]); t.z = cvt_pk_bf16_nv(xf[4], xf[5]); t.w = cvt_pk_bf16_nv(xf[6], xf[7]); Bwx[kh][nh] = __builtin_bit_cast(bf16x8, t); }
#pragma unroll
        for (int nh = 0; nh < 2; ++nh) { const int chj = nb * 64 + half * 32 + nh * 16 + n, o = (l * 2 + d) * 512 + chj;
            ba[nh] = FIN(I_LBA)[o]; bx[nh] = FIN(I_LBX)[o]; sp8[nh] = -8.0f * log1pf(__expf(-FIN(I_LLAM)[o])); }
        const bf16_t* XCb = (const bf16_t*)(ch + CH_XC) + (size_t)bl * TOK * 512; const int ldo = d ? 1024 : 512; bf16_t* HOb = d ? (bf16_t*)(ch + CH_HL) + (size_t)bl * TOK * 1024 + 512 : (bf16_t*)(ch + CH_HF) + (size_t)bl * TOK * 512;
        const bf16_t* HFb = (const bf16_t*)(ch + CH_HF) + (size_t)bl * TOK * 512; const bf16_t* RGb = (const bf16_t*)(ch + CH_RG) + (size_t)bl * TOK * 512;
        const int chj0 = nb * 64 + half * 32 + n;
        float H[2] = {0.f, 0.f};
        __syncthreads();
        for (int sc = 0; sc < 9; ++sc) {
            float As[2] = {1.f, 1.f}, Bs[2] = {0.f, 0.f};
            bf16x8 A0q[4], A1q[4]; bf16_t xrq[4][2][4];
#pragma unroll
            for (int tt = 0; tt < 4; ++tt) { const int tau0 = sc * 512 + wave * 64 + tt * 16; const bool live = tau0 < TOK;
                const bf16_t* ap = XCb + (size_t)lru_pos(d, live ? tau0 + n : 0) * 512 + nb * 64 + 8 * g; A0q[tt] = *(const bf16x8*)ap; A1q[tt] = *(const bf16x8*)(ap + 32);
#pragma unroll
                for (int r = 0; r < 4; ++r) { const int pr = lru_pos(d, live ? tau0 + 4 * g + r : 0); xrq[tt][0][r] = XCb[(size_t)pr * 512 + chj0]; xrq[tt][1][r] = XCb[(size_t)pr * 512 + chj0 + 16]; } }
            asm volatile("" ::: "memory");
#pragma unroll
            for (int tt = 0; tt < 4; ++tt) {
                const int tau0 = sc * 512 + wave * 64 + tt * 16; const bool live = tau0 < TOK;
                const bf16x8 A0 = A0q[tt], A1 = A1q[tt];
                bf16_t xr[2][4];
#pragma unroll
                for (int r = 0; r < 4; ++r) { xr[0][r] = xrq[tt][0][r]; xr[1][r] = xrq[tt][1][r]; }
#pragma unroll
                for (int nh = 0; nh < 2; ++nh) {
                    f32x4 ra = (f32x4){0.f, 0.f, 0.f, 0.f}, ri = ra;
                    ra = __builtin_amdgcn_mfma_f32_16x16x32_bf16(A0, Bwa[0][nh], ra, 0, 0, 0); ra = __builtin_amdgcn_mfma_f32_16x16x32_bf16(A1, Bwa[1][nh], ra, 0, 0, 0);
                    ri = __builtin_amdgcn_mfma_f32_16x16x32_bf16(A0, Bwx[0][nh], ri, 0, 0, 0); ri = __builtin_amdgcn_mfma_f32_16x16x32_bf16(A1, Bwx[1][nh], ri, 0, 0, 0);
                    float a[4], b[4];
#pragma unroll
                    for (int r = 0; r < 4; ++r) { const float xj = bf2f(xr[nh][r]);
                        const float la = sp8[nh] * sigmoid_f(ra[r] + ba[nh]), x2 = 2.0f * la;
                        float em1 = x2 * (1.0f + x2 * (0.5f + x2 * (0.16666667f + x2 * (0.041666668f + x2 * 0.0083333338f))));
                        if (x2 < -0.25f) em1 = __expf(x2) - 1.0f;
                        a[r] = live ? __expf(la) : 1.f; b[r] = live ? __builtin_amdgcn_sqrtf(fmaxf(-em1, 0.f)) * sigmoid_f(ri[r] + bx[nh]) * xj : 0.f;
                        *(LAS f32x2*)(ab + ((((tt * 2 + nh) * 4 + r) * 64 + lane) << 1)) = (f32x2){a[r], b[r]}; }
                    float A = a[0], B = b[0];
#pragma unroll
                    for (int r = 1; r < 4; ++r) { B = fmaf(B, a[r], b[r]); A *= a[r]; }
                    float Ai = A, Bi = B;
                    { const float Ap = __shfl_up(Ai, 16), Bp = __shfl_up(Bi, 16); if (g >= 1) { Bi = fmaf(Bp, Ai, Bi); Ai *= Ap; } }
                    { const float Ap = __shfl_up(Ai, 32), Bp = __shfl_up(Bi, 32); if (g >= 2) { Bi = fmaf(Bp, Ai, Bi); Ai *= Ap; } }
                    Bs[nh] = fmaf(Bs[nh], Ai, Bi); As[nh] *= Ai;
                }
            }
            LAS float* ag = agg + (sc & 1) * (8 * 2 * 16 * 2);
            if (g == 3) {
#pragma unroll
                for (int nh = 0; nh < 2; ++nh) { ag[((wave * 2 + nh) * 16 + n) * 2] = As[nh]; ag[((wave * 2 + nh) * 16 + n) * 2 + 1] = Bs[nh]; } }
            __syncthreads();
            float hst[2];
#pragma unroll
            for (int nh = 0; nh < 2; ++nh) { float h = H[nh], hin = H[nh];
#pragma unroll
                for (int w = 0; w < 8; ++w) { if (w == wave) hin = h; h = fmaf(ag[((w * 2 + nh) * 16 + n) * 2], h, ag[((w * 2 + nh) * 16 + n) * 2 + 1]); }
                hst[nh] = hin; H[nh] = h; }
#pragma unroll 1
            for (int tt = 0; tt < 4; ++tt) {
                const int tau0 = sc * 512 + wave * 64 + tt * 16; if (tau0 >= TOK) break;
                int posr[4];
#pragma unroll
                for (int r = 0; r < 4; ++r) posr[r] = lru_pos(d, tau0 + 4 * g + r);
                bf16_t hfq[2][4], rgq[2][4];
                if (d) {
#pragma unroll
                    for (int nh = 0; nh < 2; ++nh)
#pragma unroll
                        for (int r = 0; r < 4; ++r) { const size_t ix = (size_t)posr[r] * 512 + chj0 + 16 * nh; hfq[nh][r] = HFb[ix]; rgq[nh][r] = RGb[ix]; } }
#pragma unroll
                for (int nh = 0; nh < 2; ++nh) { float a[4], b[4];
#pragma unroll
                    for (int r = 0; r < 4; ++r) { const f32x2 t2 = *(const LAS f32x2*)(ab + ((((tt * 2 + nh) * 4 + r) * 64 + lane) << 1)); a[r] = t2.x; b[r] = t2.y; }
                    float A = a[0], B = b[0];
#pragma unroll
                    for (int r = 1; r < 4; ++r) { B = fmaf(B, a[r], b[r]); A *= a[r]; }
                    float Ai = A, Bi = B;
                    { const float Ap = __shfl_up(Ai, 16), Bp = __shfl_up(Bi, 16); if (g >= 1) { Bi = fmaf(Bp, Ai, Bi); Ai *= Ap; } }
                    { const float Ap = __shfl_up(Ai, 32), Bp = __shfl_up(Bi, 32); if (g >= 2) { Bi = fmaf(Bp, Ai, Bi); Ai *= Ap; } }
                    float Ae = __shfl_up(Ai, 16), Be = __shfl_up(Bi, 16); if (g == 0) { Ae = 1.f; Be = 0.f; }
                    float h = fmaf(Ae, hst[nh], Be);
                    bf16_t* hop = HOb + chj0 + 16 * nh;
#pragma unroll
                    for (int r = 0; r < 4; ++r) { h = fmaf(a[r], h, b[r]); hop[(size_t)posr[r] * ldo] = f2bf(d ? (bf2f(hfq[nh][r]) + h) * bf2f(rgq[nh][r]) : h); }
                    hst[nh] = __shfl(h, 48 + n);
                }
            }
        }
    }
    __syncthreads();
}
__device__ __forceinline__ void p_lru_post(const Frame& F, unsigned char* ch) {
    const u32x4* hf = (const u32x4*)(ch + CH_HF); const u32x4* hb = (const u32x4*)(ch + CH_HB); const u32x4* rg = (const u32x4*)(ch + CH_RG); u32x4* o = (u32x4*)(ch + CH_LRUO);
    const size_t total = (size_t)RC * 64, stride = (size_t)F.G * 512;
    for (size_t i = (size_t)F.bid * 512 + F.tid; i < total; i += 2 * stride) {
        const size_t i2 = i + stride; const bool two = i2 < total;
        const u32x4 a = hf[i], b = hb[i], g = rg[i]; u32x4 a2 = a, b2 = b, g2 = g; if (two) { a2 = hf[i2]; b2 = hb[i2]; g2 = rg[i2]; }
        u32x4 w, w2;
        w.x = cvt_pk_bf16_nv((bflo(a.x) + bflo(b.x)) * bflo(g.x), (bfhi(a.x) + bfhi(b.x)) * bfhi(g.x));
        w.y = cvt_pk_bf16_nv((bflo(a.y) + bflo(b.y)) * bflo(g.y), (bfhi(a.y) + bfhi(b.y)) * bfhi(g.y));
        w.z = cvt_pk_bf16_nv((bflo(a.z) + bflo(b.z)) * bflo(g.z), (bfhi(a.z) + bfhi(b.z)) * bfhi(g.z));
        w.w = cvt_pk_bf16_nv((bflo(a.w) + bflo(b.w)) * bflo(g.w), (bfhi(a.w) + bfhi(b.w)) * bfhi(g.w));
        w2.x = cvt_pk_bf16_nv((bflo(a2.x) + bflo(b2.x)) * bflo(g2.x), (bfhi(a2.x) + bfhi(b2.x)) * bfhi(g2.x));
        w2.y = cvt_pk_bf16_nv((bflo(a2.y) + bflo(b2.y)) * bflo(g2.y), (bfhi(a2.y) + bfhi(b2.y)) * bfhi(g2.y));
        w2.z = cvt_pk_bf16_nv((bflo(a2.z) + bflo(b2.z)) * bflo(g2.z), (bfhi(a2.z) + bfhi(b2.z)) * bfhi(g2.z));
        w2.w = cvt_pk_bf16_nv((bflo(a2.w) + bflo(b2.w)) * bflo(g2.w), (bfhi(a2.w) + bfhi(b2.w)) * bfhi(g2.w));
        o[i] = w; if (two) o[i2] = w2;
    }
}

__device__ __forceinline__ void p_topk(const Frame& F, unsigned char* ch) {
    const float* AFF = (const float*)(ch + CH_AFF); int* ROWSRC = (int*)(ch + CH_ROWSRC); float* GATEV = (float*)(ch + CH_GATEV); int* INV = (int*)(ch + CH_INV);
    const float* SU = (const float*)(ch + CH_SU); float* XSCL = (float*)(ch + CH_XSCL);
    LAS unsigned* sh = (LAS unsigned*)F.lds;
    const int tid = F.tid, lane = F.lane, wave = F.wave;
    for (int u = F.bid; u < BC * NE * 2; u += F.G) {
        const int set = u / (BC * NE), e = u % NE, bl = (u / NE) % BC;
        const int n = set ? CTX : SEQ, cap = set ? CAP_C : CAP_L, r0 = bl * TOK + (set ? 0 : CTX);
        unsigned key[8];
#pragma unroll
        for (int k = 0; k < 8; ++k) { const int i = tid * 8 + k; key[k] = i < n ? __float_as_uint(AFF[(size_t)(r0 + i) * NE + e]) : 0u; }
        __syncthreads();
        unsigned T = 0u;
#pragma unroll 1
        for (int b = 30; b >= 0; b -= 2) {
            const unsigned l1 = T | (1u << b), l2 = T | (2u << b), l3 = T | (3u << b);
            int pk = 0;
#pragma unroll
            for (int k = 0; k < 8; ++k) pk += (key[k] >= l1 ? 1 : 0) + (key[k] >= l2 ? (1 << 10) : 0) + (key[k] >= l3 ? (1 << 20) : 0);
            pk = __float_as_int(row16_sum_i(pk)); pk += __shfl_xor(pk, 16); pk += __shfl_xor(pk, 32);
            LAS unsigned* bank = sh + ((b & 2) << 2);
            if (lane == 0) bank[wave] = (unsigned)pk;
            __syncthreads();
            unsigned t1 = 0, t2 = 0, t3 = 0;
#pragma unroll
            for (int w = 0; w < 8; ++w) { const unsigned q = bank[w]; t1 += q & 1023u; t2 += (q >> 10) & 1023u; t3 += q >> 20; }
            T = (int)t3 >= cap ? l3 : (int)t2 >= cap ? l2 : (int)t1 >= cap ? l1 : T;
        }
        int tg = 0, te = 0;
#pragma unroll
        for (int k = 0; k < 8; ++k) { tg += key[k] > T ? 1 : 0; te += key[k] == T ? 1 : 0; }
        int ig = tg, ie = te;
#pragma unroll
        for (int o = 1; o < 64; o <<= 1) { const int a = __shfl_up(ig, o), b = __shfl_up(ie, o); if (lane >= o) { ig += a; ie += b; } }
        __syncthreads();
        if (lane == 63) { sh[16 + wave] = (unsigned)ig; sh[32 + wave] = (unsigned)ie; }
        __syncthreads();
        int pg = ig - tg, pe = ie - te, totg = 0;
#pragma unroll
        for (int w = 0; w < 8; ++w) { const int a = (int)sh[16 + w], b = (int)sh[32 + w]; if (w < wave) { pg += a; pe += b; } totg += a; }
        const int need = cap - totg;
#pragma unroll
        for (int k = 0; k < 8; ++k) { const int i = tid * 8 + k;
            if (i < n) { const bool gt = key[k] > T, eq = key[k] == T; int xr = -1;
                if (gt || (eq && pe < need)) { xr = (set ? BC * CAP_L + bl * CAP_C : bl * CAP_L) + pg + (pe < need ? pe : need); ROWSRC[e * XROWS + xr] = r0 + i; GATEV[e * XROWS + xr] = __uint_as_float(key[k]); XSCL[e * XROWS + xr] = SU[r0 + i]; }
                INV[(size_t)(r0 + i) * NE + e] = xr;
                pg += gt ? 1 : 0; pe += eq ? 1 : 0; } }
    }
    __syncthreads();
}
__device__ __forceinline__ void p_combine(const Frame& F, int l, int chunk, unsigned char* ch) {
    const int* INV = (const int*)(ch + CH_INV); const bf16_t* YS = (const bf16_t*)(ch + CH_YS);
    const int gw = F.bid * 8 + F.wave, NGW = F.G * 8;
    for (int r = gw; r < RC; r += NGW) {
        float acc[16];
#pragma unroll
        for (int j = 0; j < 16; ++j) acc[j] = 0.f;
        int any = 0;
        for (int e = 0; e < NE; ++e) { const int xr = INV[(size_t)r * NE + e];
            if (xr >= 0) { any = 1; const u32x4* yp = (const u32x4*)(YS + ((size_t)e * XROWS + xr) * 1024) + F.lane;
#pragma unroll
                for (int j = 0; j < 2; ++j) { const u32x4 y = yp[64 * j];
                    acc[8 * j + 0] += bflo(y.x); acc[8 * j + 1] += bfhi(y.x); acc[8 * j + 2] += bflo(y.y); acc[8 * j + 3] += bfhi(y.y);
                    acc[8 * j + 4] += bflo(y.z); acc[8 * j + 5] += bfhi(y.z); acc[8 * j + 6] += bflo(y.w); acc[8 * j + 7] += bfhi(y.w); } } }
        if (any) {
            float* hp = hrow_ptr(F, chunk, r); const float* g2 = mod_ptr(F, l, mod_row(chunk, r), 5);
#pragma unroll
            for (int j = 0; j < 2; ++j)
#pragma unroll
                for (int q = 0; q < 2; ++q) { const int col = 512 * j + 8 * F.lane + 4 * q; f32x4* p4 = (f32x4*)(hp + col); const f32x4 g = *(const f32x4*)(g2 + col);
                    f32x4 a; a.x = acc[8 * j + 4 * q]; a.y = acc[8 * j + 4 * q + 1]; a.z = acc[8 * j + 4 * q + 2]; a.w = acc[8 * j + 4 * q + 3];
                    *p4 = *p4 + g * a; }
        }
    }
}
__device__ __forceinline__ void p_final(const Frame& F, unsigned char* ch) {
    const int* INV = (const int*)(ch + CH_INV); const bf16_t* YS = (const bf16_t*)(ch + CH_YS);
    const int gw = F.bid * 8 + F.wave, NGW = F.G * 8; const f32x4* gp = (const f32x4*)FIN(I_FNG) + F.lane;
    for (int r = gw; r < NB * SEQ; r += NGW) {
        const int b = r >> 12, t = r & (SEQ - 1), rr = b * TOK + CTX + t;
        f32x4* hp = (f32x4*)(F.out + ((size_t)r << 10)) + F.lane; f32x4 v[4], acc[4]; float ss = 0.f;
        { const u32x2* hb = (const u32x2*)((const bf16_t*)(ch + CH_HRES) + (size_t)rr * DM) + F.lane;
#pragma unroll
          for (int j = 0; j < 4; ++j) { const u32x2 t = hb[64 * j]; v[j] = (f32x4){bflo(t.x), bfhi(t.x), bflo(t.y), bfhi(t.y)}; acc[j] = (f32x4){0.f, 0.f, 0.f, 0.f}; } }
        { const int xl = INV[(size_t)rr * NE + (F.lane & 15)]; unsigned mk = (unsigned)__ballot(xl >= 0) & 0xffffu;
          while (mk) { const int e0 = __builtin_ctz(mk); mk &= mk - 1u; const bool two = mk != 0u; const int e1 = two ? __builtin_ctz(mk) : e0; if (two) mk &= mk - 1u;
              const int x0 = __builtin_amdgcn_readlane(xl, e0), x1 = __builtin_amdgcn_readlane(xl, e1); const float w1 = two ? 1.f : 0.f;
              const u32x2* y0 = (const u32x2*)(YS + ((size_t)e0 * XROWS + x0) * 1024) + F.lane; const u32x2* y1 = (const u32x2*)(YS + ((size_t)e1 * XROWS + x1) * 1024) + F.lane;
              u32x2 a[4], bb[4];
#pragma unroll
              for (int j = 0; j < 4; ++j) { a[j] = y0[64 * j]; bb[j] = y1[64 * j]; }
#pragma unroll
              for (int j = 0; j < 4; ++j) { acc[j].x += bflo(a[j].x) + w1 * bflo(bb[j].x); acc[j].y += bfhi(a[j].x) + w1 * bfhi(bb[j].x); acc[j].z += bflo(a[j].y) + w1 * bflo(bb[j].y); acc[j].w += bfhi(a[j].y) + w1 * bfhi(bb[j].y); } } }
        const f32x4* g2 = (const f32x4*)mod_ptr(F, DEPTH - 1, b, 5) + F.lane; f32x4 g2q[4], gfq[4];
#pragma unroll
        for (int j = 0; j < 4; ++j) { g2q[j] = g2[64 * j]; gfq[j] = gp[64 * j]; }
        asm volatile("" ::: "memory");
#pragma unroll
        for (int j = 0; j < 4; ++j) { v[j] = v[j] + g2q[j] * acc[j]; ss += (v[j].x * v[j].x + v[j].y * v[j].y) + (v[j].z * v[j].z + v[j].w * v[j].w); }
        const float rstd = rsqrtf(wave_sum(ss) * (1.f / DM) + NORM_EPS);
#pragma unroll
        for (int j = 0; j < 4; ++j) hp[64 * j] = v[j] * rstd * gfq[j];
    }
}
constexpr int STEPS_PER_LAYER = 12, NSTEPS = 1 + DEPTH * STEPS_PER_LAYER + 1;
constexpr unsigned ALL_PHASES = 0xFFFFFFFFu;
#ifndef PROBE_REPMASK
#define PROBE_REPMASK 0u
#endif

template <unsigned PHMASK>
__global__ void __launch_bounds__(512, 2) fwd_kernel(Args args) {
    extern __shared__ __attribute__((aligned(16))) unsigned char lds_raw[];
    Frame F0;
    F0.lds = (LAS unsigned char*)lds_raw; F0.lds_gen = lds_raw;
    F0.tid = 0; F0.lane = 0; F0.wave = __builtin_amdgcn_readfirstlane((int)threadIdx.x >> 6); F0.G = gridDim.x; F0.bid = blockIdx.x;
    F0.in = nullptr; F0.out = args.out; F0.ws = args.ws;
    for (int u = threadIdx.x; u < (LDS_BYTES - LDSCTL_OFF) / 4; u += 512) ((LAS unsigned*)(F0.lds + LDSCTL_OFF))[u] = 0u;
    __syncthreads();
    XcdBarrier bar = xcd_barrier_post((unsigned*)(F0.ws + WS_CTL) + CW_BAR, (volatile LAS unsigned*)(F0.lds + LDSCTL_OFF + 64));
    const int lo = args.lo, hi = args.hi; const unsigned repmask = PROBE_REPMASK;
    int step = 0, l0_ = 0;
#define PH_BEGIN_(k) if (step >= lo && step < hi && ((PHMASK >> (k)) & 1u)) for (int rep_ = 0; rep_ <= (int)((repmask >> (k)) & 1u); ++rep_) { Frame F = F0; \
        { GAS unsigned char* w_ = (GAS unsigned char*)F.ws; GAS float* o_ = (GAS float*)F.out; asm volatile("" : "+s"(w_), "+s"(o_)); \
          F.ws = (unsigned char*)w_; F.out = (float*)o_; F.in = (const float* const*)(F.ws + WS_TAB); } \
        asm volatile("" : "+s"(F.wave), "+s"(F.bid), "+s"(F.G)); \
        { int ln_; asm volatile("v_mbcnt_lo_u32_b32 %0, -1, 0\n\tv_mbcnt_hi_u32_b32 %0, -1, %0" : "=v"(ln_));     \
          F.lane = ln_; F.tid = F.wave * 64 + ln_; } \
        unsigned char* ch = F.ws + WS_CH; (void)ch; int l = l0_; asm volatile("" : "+s"(l)); (void)l;
#define SUBF(name) Frame name = F; { int ln2_; asm volatile("v_mbcnt_lo_u32_b32 %0, -1, 0\n\tv_mbcnt_hi_u32_b32 %0, -1, %0" : "=v"(ln2_)); name.lane = ln2_; name.tid = name.wave * 64 + ln2_; }
#define PH_END } if (step >= lo && step + 1 < hi) { XcdBarrier bb_ = bar; { GAS unsigned* p_ = (GAS unsigned*)bb_.bar; unsigned x_ = bb_.x; asm volatile("" : "+s"(p_), "+s"(x_)); bb_.bar = (unsigned*)p_; bb_.x = x_; } \
        xcd_barrier(bb_); } ++step;

    PH_BEGIN_(0) p_prologue(F, args); PH_END
    for (l0_ = 0; l0_ < DEPTH; ++l0_) {
        constexpr int chunk = 0;
        PH_BEGIN_(1) if (l == 0) p_weights(F, l);
                     if (l == 0) p_norm<false, false>(F, l, chunk, FIN(I_N1G) + l * DM, 0, 1, nullptr, nullptr, 0, nullptr, nullptr, FIN(I_X), FIN(I_CTX), nullptr, false, (signed char*)(ch + CH_U), (float*)(F.ws + WS_SUN));
                     else p_norm<false, true>(F, l, chunk, FIN(I_N1G) + l * DM, 0, 1, nullptr, nullptr, l - 1, (const int*)(ch + CH_INV), (const bf16_t*)(ch + CH_YS), nullptr, nullptr, nullptr, false, (signed char*)(ch + CH_U), (float*)(F.ws + WS_SUN)); PH_END
        PH_BEGIN_(3) { GemmPlainQ g{(const signed char*)(ch + CH_U), (const signed char*)(F.ws + WS_WIN), DM}; pg8::StaticOrder S; S.init(PANELS, 16, F.G, F.bid); EpiIn E{ch, 0, (const float*)(F.ws + WS_SUN), (const float*)(F.ws + WS_SWIN)};
                   pg8::gemm_phase<GemmPlainQ, EpiIn, pg8::StaticOrder>(F.lds, g, S, E, F.tid); } PH_END
        PH_BEGIN_(4) if (rep_ == 0) p_qknorm(F, l, ch); { SUBF(Fb) p_hyena_pre(Fb, l, ch); } { SUBF(Fc) p_lru_conv(Fc, l, ch); } PH_END
        PH_BEGIN_(5) p_attention(F, l, ch, l != DEPTH - 1, (bf16_t*)(ch + (rep_ ? CH_HY : CH_Q))); if (rep_ == 0) { { SUBF(Fb) p_hyena_conv(Fb, l, ch); } { SUBF(Fc) p_lru_scan(Fc, l, ch); } } PH_END
        PH_BEGIN_(8) p_hyena_post(F, ch); PH_END
        PH_BEGIN_(6) { GemmPlainQ g{(const signed char*)(ch + CH_U), (const signed char*)(F.ws + WS_WIN) + (size_t)4096 * DM, DM}; pg8::MappedOrder S; const bool lastl = (l == DEPTH - 1); S.init(lastl ? BC * 16 : PANELS, 12, F.G, F.bid); S.mode = lastl ? 1 : 0; EpiIn E{ch, 16, (const float*)(F.ws + WS_SUN), (const float*)(F.ws + WS_SWIN)};
                   pg8::gemm_phase<GemmPlainQ, EpiIn, pg8::MappedOrder>(F.lds, g, S, E, F.tid); } PH_END
        PH_BEGIN_(9) { { pg8::MappedOrder S; const bool lastl = (l == DEPTH - 1); S.init(lastl ? BC * 16 : PANELS, 4, F.G, F.bid); S.mode = lastl ? 1 : 0;
                     GemmMerge g{(const bf16_t*)(ch + CH_Q), (const bf16_t*)(F.ws + WS_WA), (const bf16_t*)(ch + CH_HL), (const bf16_t*)(F.ws + WS_WH), 1024}; EpiMergeFused E{(bf16_t*)(ch + CH_Y), (const unsigned char*)(ch + CH_GATE)};
                     pg8::gemm_phase<GemmMerge, EpiMergeFused, pg8::MappedOrder>(F.lds, g, S, E, F.tid); }
                   { SUBF(Fw) p_weights_exp13(Fw, l); if (l + 1 < DEPTH) w_filters(Fw, l + 1, 64); } } PH_END
        PH_BEGIN_(10) { GemmPlain g{(const bf16_t*)(ch + CH_Y), (const bf16_t*)(F.ws + WS_WO), 1024}; pg8::MappedOrder S; const bool lastl = (l == DEPTH - 1); S.init(lastl ? BC * 16 : PANELS, 4, F.G, F.bid); S.mode = lastl ? 1 : 0;
                   EpiDelta E{(bf16_t*)(ch + CH_DLT), (const float*)(F.ws + WS_MOD) + (size_t)l * 17 * 6 * DM, chunk};
                   pg8::gemm_phase<GemmPlain, EpiDelta, pg8::MappedOrder>(F.lds, g, S, E, F.tid); { SUBF(Fw) p_weights_exp2(Fw, l); if (l + 1 < DEPTH) w_quant_in(Fw, l + 1, 64); } } PH_END
        PH_BEGIN_(11) p_norm<true, false>(F, l, chunk, FIN(I_N2G) + l * DM, 3, 4, nullptr, (float*)(ch + CH_AFF), 0, nullptr, nullptr, l == 0 ? FIN(I_X) : nullptr, l == 0 ? FIN(I_CTX) : nullptr,
                                                (rep_ == 0) ? (const bf16_t*)(ch + CH_DLT) : nullptr, l == DEPTH - 1, (signed char*)(ch + CH_U2), (float*)(ch + CH_SU)); PH_END
        PH_BEGIN_(12) p_topk(F, ch); PH_END
        PH_BEGIN_(14) { GemmExpertGatherQ g{(const signed char*)(ch + CH_U2), (const int*)(ch + CH_ROWSRC), (const signed char*)(F.ws + WS_W13), 1024, 2048}; pg8::MappedOrder S; const bool lastl = (l == DEPTH - 1); S.init(lastl ? NE * 32 : NE * XPAN, 8, F.G, F.bid); S.mode = lastl ? 2 : 0; EpiSwigluQ E{(bf16_t*)(ch + CH_HID), (const float*)(ch + CH_XSCL), (const float*)(F.ws + WS_SW13)};
                   pg8::gemm_phase<GemmExpertGatherQ, EpiSwigluQ, pg8::MappedOrder>(F.lds, g, S, E, F.tid); } PH_END
        PH_BEGIN_(15) { GemmExpert g{(const bf16_t*)(ch + CH_HID), (const bf16_t*)(F.ws + WS_W2), 1024, 1024}; pg8::MappedOrder S; const bool lastl = (l == DEPTH - 1); S.init(lastl ? NE * 32 : NE * XPAN, 4, F.G, F.bid); S.mode = lastl ? 2 : 0; EpiDown E{(bf16_t*)(ch + CH_YS), (const float*)(ch + CH_GATEV)};
                   pg8::gemm_phase<GemmExpert, EpiDown, pg8::MappedOrder>(F.lds, g, S, E, F.tid); if (l + 1 < DEPTH) { SUBF(Fw) w_transposes(Fw, l + 1, 128); } } PH_END
    }
    PH_BEGIN_(17) p_final(F, ch); PH_END
#undef PH_BEGIN_
#undef PH_END
}

extern "C" void kernel_launch(void* const* d_in, const int* in_sizes, int n_in, void* d_out, int out_size, void* d_ws, size_t ws_size, hipStream_t stream) {
    static int grid = 0;
    if (grid == 0) {
        if (n_in != N_IN || out_size != NB * SEQ * DM || ws_size < WS_END) { fprintf(stderr, "kernel_launch: unexpected shapes: n_in %d out %d ws %zu (need %zu)\n", n_in, out_size, ws_size, (size_t)WS_END); grid = -1; return; }
        int dev = 0, cus = 0, per_cu = 0;
        if (hipGetDevice(&dev) != hipSuccess || hipDeviceGetAttribute(&cus, hipDeviceAttributeMultiprocessorCount, dev) != hipSuccess) { grid = -1; return; }
#if MK_ONE_LAUNCH
        if (hipFuncSetAttribute((const void*)fwd_kernel<ALL_PHASES>, hipFuncAttributeMaxDynamicSharedMemorySize, LDS_BYTES) != hipSuccess) { fprintf(stderr, "kernel_launch: hipFuncSetAttribute failed\n"); grid = -1; return; }
        if (hipOccupancyMaxActiveBlocksPerMultiprocessor(&per_cu, (const void*)fwd_kernel<ALL_PHASES>, 512, LDS_BYTES) != hipSuccess || per_cu < 1) { fprintf(stderr, "kernel_launch: occupancy query says %d\n", per_cu); }
#else
#define SET_ATTR(k) if (hipFuncSetAttribute((const void*)fwd_kernel<(1u << (k))>, hipFuncAttributeMaxDynamicSharedMemorySize, LDS_BYTES) != hipSuccess) { fprintf(stderr, "kernel_launch: hipFuncSetAttribute failed\n"); grid = -1; return; }
        SET_ATTR(0) SET_ATTR(1) SET_ATTR(2) SET_ATTR(3) SET_ATTR(4) SET_ATTR(5) SET_ATTR(6) SET_ATTR(7) SET_ATTR(8) SET_ATTR(9) SET_ATTR(10) SET_ATTR(11) SET_ATTR(12) SET_ATTR(13) SET_ATTR(14) SET_ATTR(15) SET_ATTR(16) SET_ATTR(17)
#undef SET_ATTR
        (void)per_cu;
#endif
        (void)hipGetLastError();
        grid = cus;
    }
    if (grid < 0) return;
    (void)hipMemsetAsync((char*)d_ws + WS_CTL, 0, CTL_ZERO_BYTES, stream);
    Args a{};
    for (int i = 0; i < N_IN; ++i) a.in[i] = (const float*)d_in[i];
    a.out = (float*)d_out; a.ws = (unsigned char*)d_ws;
#if MK_ONE_LAUNCH
    a.lo = 0; a.hi = NSTEPS;
    hipLaunchKernelGGL(fwd_kernel<ALL_PHASES>, dim3(grid), dim3(512), LDS_BYTES, stream, a);
#else
    {
        int s = 0;
#define LAUNCH_PH(k) do { a.lo = s; a.hi = s + 1; hipLaunchKernelGGL(fwd_kernel<(1u << (k))>, dim3(grid), dim3(512), LDS_BYTES, stream, a); ++s; } while (0)
        LAUNCH_PH(0);
        for (int l = 0; l < DEPTH; ++l) { LAUNCH_PH(1); LAUNCH_PH(3); LAUNCH_PH(4); LAUNCH_PH(5); LAUNCH_PH(8); LAUNCH_PH(6); LAUNCH_PH(9); LAUNCH_PH(10);
            LAUNCH_PH(11); LAUNCH_PH(12); LAUNCH_PH(14); LAUNCH_PH(15); }
        LAUNCH_PH(17);
#undef LAUNCH_PH
    }
#endif
    const hipError_t le = hipPeekAtLastError();
    if (le != hipSuccess) fprintf(stderr, "kernel_launch: launch failed: %s\n", hipGetErrorName(le));
}
```

```cpp
#include <hip/hip_runtime.h>
#include <cstdio>
#include <cstdint>

#define GAS __attribute__((address_space(1)))
#define LAS __attribute__((address_space(3)))
typedef unsigned short bf16_t;
typedef short bf16x8 __attribute__((ext_vector_type(8)));
typedef short s16x4 __attribute__((ext_vector_type(4)));
typedef float f32x16 __attribute__((ext_vector_type(16)));
typedef float f32x4 __attribute__((ext_vector_type(4)));
typedef float f32x2 __attribute__((ext_vector_type(2)));
typedef unsigned u32x4 __attribute__((ext_vector_type(4)));
typedef unsigned u32x2 __attribute__((ext_vector_type(2)));

#ifndef MK_ONE_LAUNCH
#define MK_ONE_LAUNCH 1
#endif

constexpr int NB = 16, SEQ = 4096, DM = 1024, DEPTH = 4, CTX = 256, TOK = SEQ + CTX;
constexpr int NCH = 1, BC = NB / NCH, RC = BC * TOK, PANELS = RC / 256;
constexpr int IN_TOTAL = 7168, GRIDW = 64;
constexpr int NE = 16, CAP_L = 512, CAP_C = 32, XPB = CAP_L + CAP_C, XROWS = BC * XPB;
constexpr float NORM_EPS = 1e-6f;
static_assert(RC % 256 == 0 && XROWS % 256 == 0 && TOK % 256 == 0, "panel alignment");

enum { I_X = 0, I_C, I_CTX, I_CCTX, I_MODW, I_MODB, I_N1G, I_N2G, I_WIN, I_QNG, I_KNG, I_HYCW, I_HYCB, I_FW1, I_FB1, I_FW2, I_FB2, I_FW3, I_FREQ, I_HYBIAS,
       I_LCW, I_LCB, I_LWA, I_LBA, I_LWX, I_LBX, I_LLAM, I_WAO, I_WHO, I_WLO, I_WOUT, I_ROUT, I_EW1, I_EW3, I_EW2, I_FNG, N_IN };
static_assert(N_IN == 36, "36 inputs");

constexpr size_t MiB = (size_t)1 << 20;
constexpr size_t WS_CTL = 0, CTL_ZERO_BYTES = 1 * MiB;
constexpr size_t WS_HC = 1 * MiB;
constexpr size_t WS_MOD = 17 * MiB;
constexpr size_t WS_FRL = 19 * MiB;
constexpr size_t WS_FRC = 35 * MiB;
constexpr size_t WS_ROPE = 30 * MiB;
constexpr size_t WS_WIN = 36 * MiB;
constexpr size_t WS_SWIN = 44 * MiB;
constexpr size_t WS_WINB = 88 * MiB;
constexpr size_t CH_HRES = 952 * MiB;
constexpr size_t CH_UB = 952 * MiB;
constexpr size_t WS_SUN = 35 * MiB + 640 * 1024;
constexpr size_t WS_WA = 50 * MiB, WS_WH = 52 * MiB, WS_WL = 53 * MiB, WS_WO = 54 * MiB;
constexpr size_t WS_W13 = 56 * MiB;
constexpr size_t WS_SW13 = 96 * MiB;
constexpr size_t WS_W2 = 120 * MiB;
constexpr size_t WS_CH = 152 * MiB;
constexpr size_t CH_U = 0, CH_Q = 136 * MiB, CH_K = 272 * MiB, CH_V = 306 * MiB, CH_HY = 340 * MiB, CH_RG = 544 * MiB, CH_X0 = 612 * MiB, CH_P = 680 * MiB, CH_XC = 748 * MiB,
                 CH_RX = 816 * MiB, CH_HYO = 884 * MiB, CH_END = 952 * MiB, CH_GATE = 272 * MiB;
constexpr size_t CH_YSUM = 680 * MiB;
constexpr size_t CH_DLT = 272 * MiB;
constexpr size_t CH_HL = CH_RX;
constexpr size_t CH_HF = CH_HY, CH_HB = CH_HY + 68 * MiB, CH_YT = CH_HY + 136 * MiB, CH_LRUO = CH_RX, CH_Y = CH_U;
constexpr size_t CH_U2 = 0, CH_AFF = 136 * MiB, CH_SU = 140 * MiB + MiB / 2, CH_ROWSRC = 141 * MiB, CH_GATEV = 141 * MiB + 3 * MiB / 4, CH_XSCL = 142 * MiB + MiB / 2, CH_INV = 143 * MiB + MiB / 4, CH_HID = 148 * MiB, CH_YS = 420 * MiB;
constexpr size_t WS_END = WS_CH + CH_END + 136 * MiB;
static_assert((size_t)RC * 1024 * 2 == 136 * MiB && (size_t)NE * XROWS * 1024 * 2 == 272 * MiB && CH_YS + 272 * MiB <= CH_END && CH_GATE + 408 * MiB <= CH_RG + 136 * MiB, "buffer sizes");
constexpr int CW_BAR = 4096;
constexpr size_t WS_TAB = WS_MOD + 2 * MiB - 4096;

constexpr int RING_BYTES = 131072, LDSCTL_OFF = 146432, LDS_BYTES = 147456;

__device__ __forceinline__ float bf2f(bf16_t v) { return __uint_as_float(((unsigned)v) << 16); }
__device__ __forceinline__ float bflo(unsigned w) { return __uint_as_float(w << 16); }
__device__ __forceinline__ float bfhi(unsigned w) { return __uint_as_float(w & 0xffff0000u); }
__device__ __forceinline__ unsigned cvt_pk_bf16(float lo, float hi) { unsigned r; asm volatile("v_cvt_pk_bf16_f32 %0, %1, %2" : "=v"(r) : "v"(lo), "v"(hi)); return r; }
__device__ __forceinline__ unsigned cvt_pk_bf16_nv(float lo, float hi) { unsigned r; asm("v_cvt_pk_bf16_f32 %0, %1, %2" : "=v"(r) : "v"(lo), "v"(hi)); return r; }
__device__ __forceinline__ bf16_t f2bf(float f) { return (bf16_t)(cvt_pk_bf16_nv(f, 0.f) & 0xffffu); }
__device__ __forceinline__ float sigmoid_f(float x) { return __builtin_amdgcn_rcpf(1.f + __builtin_amdgcn_exp2f(-1.4426950408889634f * x)); }
__device__ __forceinline__ float silu_f(float x) { return x * sigmoid_f(x); }
__device__ __forceinline__ float gelu_tanh_f(float x) { return x * sigmoid_f(1.5957691216057308f * (x + 0.044715f * x * x * x)); }
__device__ __forceinline__ void sincos_rr(float x, float& s, float& c) {
    const float k = rintf(x * 0.15915494309189535f);
    float r = fmaf(-k, 6.2831854820251465f, x); r = fmaf(-k, -1.7484556000744083e-07f, r);
    s = __sinf(r); c = __cosf(r);
}
template <int CTRL> __device__ __forceinline__ float dpp_f(float v) { return __int_as_float(__builtin_amdgcn_update_dpp(0, __float_as_int(v), CTRL, 0xF, 0xF, true)); }
__device__ __forceinline__ float row16_sum(float v) {
    v += dpp_f<0xB1>(v); v += dpp_f<0x4E>(v); v += dpp_f<0x141>(v); v += dpp_f<0x140>(v); return v;
}
template <int CTRL> __device__ __forceinline__ int dpp_i(int v) { return __builtin_amdgcn_update_dpp(0, v, CTRL, 0xF, 0xF, true); }
__device__ __forceinline__ float row16_sum_i(int v) { v += dpp_i<0xB1>(v); v += dpp_i<0x4E>(v); v += dpp_i<0x141>(v); v += dpp_i<0x140>(v); return __int_as_float(v); }
__device__ __forceinline__ float row16_xor8(float v) { return dpp_f<0x128>(v); }
__device__ __forceinline__ float wave_sum(float v) { v = row16_sum(v); v += __shfl_xor(v, 16); v += __shfl_xor(v, 32); return v; }
#define LDS_WAIT() asm volatile("s_waitcnt lgkmcnt(0)" ::: "memory")
#define VM_WAIT() asm volatile("s_waitcnt vmcnt(0)" ::: "memory")
#define XB_TMO      128
#define XB_XCNT(j)  (256  + 64 * (j))
#define XB_XSUB(j)  (1280 + 64 * (j))
#define XB_XGEN(j)  (2304 + 64 * (j))
#define XB_TOP      3328
#define XB_TOPGEN   3392
#define XCD_BAR_WORDS 3456
#define XB_SPIN_CAP (1u << 18)

__device__ __forceinline__ unsigned xb_ld(unsigned* p)              { return __hip_atomic_load(p, __ATOMIC_RELAXED, __HIP_MEMORY_SCOPE_AGENT); }
__device__ __forceinline__ unsigned xb_add(unsigned* p, unsigned v) { return __hip_atomic_fetch_add(p, v, __ATOMIC_RELAXED, __HIP_MEMORY_SCOPE_AGENT); }
__device__ __forceinline__ unsigned xb_xcc_id() { return (unsigned)__builtin_amdgcn_s_getreg((3 << 11) | 20) & 0xFu; }
#define XB_SPIN(cond, bar) do { unsigned _sp = 0; while (cond) { __builtin_amdgcn_s_sleep(1); \
    if ((++_sp & 255u) == 0u) { if (xb_ld(&(bar)[XB_TMO])) break; if (_sp > XB_SPIN_CAP) { atomicAdd(&(bar)[XB_TMO], 1u); break; } } } } while (0)

struct XcdBarrier {
    unsigned* bar; unsigned x;
    volatile LAS unsigned* st;
};

__device__ __forceinline__ XcdBarrier xcd_barrier_post(unsigned* bar, volatile LAS unsigned* st) {
    XcdBarrier b; b.bar = bar; b.x = xb_xcc_id(); b.st = st;
    if (threadIdx.x == 0) (void)xb_add(&bar[XB_XCNT(b.x)], 1u);
    return b;
}
__device__ __forceinline__ void xcd_barrier_complete(unsigned* bar, unsigned x, unsigned& nloc, unsigned& nx) {
    const unsigned G = gridDim.x * gridDim.y * gridDim.z;
    unsigned sum, cnt, mine, sp = 0u;
    for (;;) {
        sum = 0u; cnt = 0u; mine = 0u;
#pragma unroll
        for (unsigned j = 0; j < 16; ++j) { const unsigned c = xb_ld(&bar[XB_XCNT(j)]); sum += c; cnt += (c > 0u) ? 1u : 0u; mine = (j == x) ? c : mine; }
        if (sum == G) break;
        __builtin_amdgcn_s_sleep(1);
        if ((++sp & 255u) == 0u) { if (xb_ld(&bar[XB_TMO])) break; if (sp > XB_SPIN_CAP) { atomicAdd(&bar[XB_TMO], 1u); break; } }
    }
    nloc = mine > 0u ? mine : 1u; nx = cnt > 0u ? cnt : 1u;
}

__device__ __forceinline__ void xcd_barrier(const XcdBarrier& b) {
    asm volatile("s_waitcnt vmcnt(0)" ::: "memory");
    __syncthreads();
    if (threadIdx.x == 0) {
        unsigned* bar = b.bar;
        __builtin_amdgcn_s_waitcnt(0);
        unsigned nloc = b.st[0], nx = b.st[1];
        if (nloc == 0u) { xcd_barrier_complete(bar, b.x, nloc, nx); b.st[0] = nloc; b.st[1] = nx; }
        const unsigned old = xb_add(&bar[XB_XSUB(b.x)], 1u);
        const unsigned gen = old / nloc;
        if (old + 1u == (gen + 1u) * nloc) {
            __builtin_amdgcn_fence(__ATOMIC_RELEASE, "agent");
            asm volatile("s_waitcnt vmcnt(0)" ::: "memory");
            const unsigned og = xb_add(&bar[XB_TOP], 1u);
            const unsigned tg = og / nx;
            if (og + 1u == (tg + 1u) * nx) xb_add(&bar[XB_TOPGEN], 1u);
            else XB_SPIN(xb_ld(&bar[XB_TOPGEN]) == tg, bar);
            __builtin_amdgcn_fence(__ATOMIC_ACQUIRE, "agent");
            xb_add(&bar[XB_XGEN(b.x)], 1u);
            asm volatile("s_waitcnt vmcnt(0)" ::: "memory");
        } else {
            XB_SPIN(xb_ld(&bar[XB_XGEN(b.x)]) == gen, bar);
            __builtin_amdgcn_fence(__ATOMIC_ACQUIRE, "agent");
            asm volatile("s_waitcnt vmcnt(0)" ::: "memory");
        }
    }
    __syncthreads();
}
namespace pg8 {
#define PG8_LAS __attribute__((address_space(3)))
constexpr int BM = 256, BK = 64, HALF = 128, HTB = HALF * BK * 2  , STAGE_BYTES = 8 * HTB, NXCD = 8, WGM = 8;
__host__ __device__ __forceinline__ int lds_byte(int r, int c) { const int st = (r >> 4) * 2 + (c >> 5), rr = r & 15, cc = c & 31, ob = rr * 64 + cc * 2; return st * 1024 + (ob ^ (((ob >> 9) & 1) << 5)); }
__host__ __device__ __forceinline__ void stage_rc(int b, int& R, int& C) { const int st = b / 1024, sb = b % 1024, swz = sb ^ (((sb >> 9) & 1) << 5); R = (st >> 1) * 16 + swz / 64; C = (st & 1) * 32 + (swz % 64) / 2; }
__host__ __device__ __forceinline__ int perm32(int rho) { const int n = rho >> 4, i = rho & 15; return 8 * (i >> 2) + 4 * n + (i & 3); }
struct Unit { int pm, pn; };
struct StaticOrder {
    int nM, nN, nwg, G, c;
    __host__ __device__ void init(int nM_, int nN_, int G_, int c_) { nM = nM_; nN = nN_; nwg = nM * nN; G = G_; c = c_; }
    __host__ __device__ bool next(int i, Unit& u) const {
        const long L = (long)i * G + c; if (L >= nwg) return false;
        int wgid = (int)L; { const int q = nwg / NXCD, r = nwg % NXCD, xcd = wgid % NXCD, off = wgid / NXCD; wgid = (xcd < r ? xcd * (q + 1) : r * (q + 1) + (xcd - r) * q) + off; }
        const int nig = WGM * nN, gid = wgid / nig, fm = gid * WGM, gsz = (nM - fm) < WGM ? (nM - fm) : WGM;
        u.pm = fm + ((wgid % nig) % gsz); u.pn = (wgid % nig) / gsz; return true;
    }
    __device__ __forceinline__ void a_ready(const Unit&) const {}
    __device__ __forceinline__ void done(const Unit&) const {}
};
struct MappedOrder : StaticOrder {
    int mode;
    __host__ __device__ bool next(int i, Unit& u) const {
        if (!StaticOrder::next(i, u)) return false;
        if (mode == 1) u.pm = 17 * (u.pm >> 4) + 1 + (u.pm & 15); else if (mode == 2) u.pm = 34 * (u.pm >> 5) + (u.pm & 31);
        return true; }
};
typedef int i32x4 __attribute__((ext_vector_type(4)));
template <bool I8> struct AccSel { typedef f32x4 type; };
template <> struct AccSel<true> { typedef i32x4 type; };
template <class GemmT, class Epi, class Sched, bool ALIGN_EPI = true, bool SP2 = true>
__device__ __forceinline__ void gemm_phase(PG8_LAS unsigned char* lds, const GemmT g, const Sched& S, const Epi& E, int tid_in) {
    int tid_ = tid_in; asm volatile("" : "+v"(tid_));
    const int tid = tid_, wid = __builtin_amdgcn_readfirstlane(tid >> 6), lane = tid & 63, wr = wid >> 2, wc = wid & 3, fr = lane & 15, fq = lane >> 4;
    constexpr int ESZ = GemmT::ESZ;
    constexpr bool I8 = (ESZ == 1);
    constexpr bool GATHER = GemmT::GATHER;
    constexpr int NSEG = GemmT::NSEG;
    const int K = g.K, nt1 = K * ESZ / (BK * 2), nt = NSEG * nt1;
    static_assert(!GATHER || SP2, "the gathered-A form is written for the SP2 loop only");
    unsigned voffB[2], gA[2][2], gAn[2][2]; int sR[2], sC[2];
#pragma unroll
    for (int i = 0; i < 2; ++i) { int R, C; stage_rc(tid * 16 + i * 8192, R, C); const int Rb = Epi::PERM ? ((R & ~31) + perm32(R & 31)) : R; sR[i] = R; sC[i] = C;
        voffB[i] = (unsigned)(Rb * K * ESZ + C * 2); gA[0][i] = gA[1][i] = gAn[0][i] = gAn[1][i] = (unsigned)(R * K * ESZ + C * 2); }
    const size_t kstep = (size_t)(BK * 2);
    const size_t hstep = (size_t)HALF * K * ESZ;
    const size_t hA = GATHER ? (size_t)0 : hstep;
    const size_t tstep = 2 * hstep;
    long dA = 0, dB = 0; if constexpr (NSEG == 2) { dA = g.seg_delta_a() - (long)nt1 * (long)kstep; dB = g.seg_delta_b() - (long)nt1 * (long)kstep; }
    const unsigned ldsw = (unsigned)wid * 1024u;
    const int aoff = lds_byte(wr * 64 + fr, fq * 8), boff = lds_byte(wc * 32 + fr, fq * 8);
#define PG8_SA(b, h) (((b) * 2 + (h)) * HTB)
#define PG8_SB(b, h) ((4 + (b) * 2 + (h)) * HTB)
#define PG8_STAGE(bufoff, gbase, voff) do { _Pragma("unroll") for (int _i = 0; _i < 2; ++_i) \
        __builtin_amdgcn_global_load_lds((const unsigned*)((const char*)(gbase) + (voff)[_i]), (PG8_LAS unsigned*)(lds + (bufoff) + ldsw + _i * 8192), 16, 0, 0); } while (0)
#define PG8_LDA(dst, b, h) do { _Pragma("unroll") for (int m = 0; m < 4; ++m) _Pragma("unroll") for (int k = 0; k < 2; ++k) dst[m][k] = *(const PG8_LAS bf16x8*)(lds + PG8_SA(b, h) + aoff + m * 2048 + k * 1024); } while (0)
#define PG8_LDB(dst, b, h) do { _Pragma("unroll") for (int n = 0; n < 2; ++n) _Pragma("unroll") for (int k = 0; k < 2; ++k) dst[n][k] = *(const PG8_LAS bf16x8*)(lds + PG8_SB(b, h) + boff + n * 2048 + k * 1024); } while (0)
#define PG8_MMA(ai, bj, At, Bt) do { __builtin_amdgcn_s_setprio(1); _Pragma("unroll") for (int m = 0; m < 4; ++m) _Pragma("unroll") for (int n = 0; n < 2; ++n) _Pragma("unroll") for (int k = 0; k < 2; ++k) { \
        if constexpr (I8) acc[ai][bj][m][n] = __builtin_amdgcn_mfma_i32_16x16x64_i8(__builtin_bit_cast(i32x4, Bt[n][k]), __builtin_bit_cast(i32x4, At[m][k]), acc[ai][bj][m][n], 0, 0, 0); \
        else acc[ai][bj][m][n] = __builtin_amdgcn_mfma_f32_16x16x32_bf16(Bt[n][k], At[m][k], acc[ai][bj][m][n], 0, 0, 0); } __builtin_amdgcn_s_setprio(0); } while (0)
#define PG8_WAIT_V(n) asm volatile("s_waitcnt vmcnt(" #n ")" ::: "memory")
#define PG8_WAIT_L(n) asm volatile("s_waitcnt lgkmcnt(" #n ")" ::: "memory")
#define PG8_BAR __builtin_amdgcn_s_barrier()
#define PG8_SCHED __builtin_amdgcn_sched_barrier(0)
    Unit cur, nxt; int ui = 0;
    if (!S.next(0, cur)) return;
    typedef typename AccSel<I8>::type acc_t;
    acc_t acc[2][2][4][2];
#pragma unroll
    for (int a = 0; a < 2; ++a)
#pragma unroll
        for (int b = 0; b < 2; ++b)
#pragma unroll
            for (int m = 0; m < 4; ++m)
#pragma unroll
                for (int n = 0; n < 2; ++n) acc[a][b][m][n] = (acc_t){0, 0, 0, 0};
    bf16x8 At[4][2], B0[2][2], B1[2][2];
    const char* cA = g.a_tile(cur); const char* cB = g.b_tile(cur);
    S.a_ready(cur);
    if constexpr (GATHER) {
            { int r4[2][2];
#pragma unroll
        for (int h = 0; h < 2; ++h)
#pragma unroll
            for (int i = 0; i < 2; ++i) r4[h][i] = g.a_row(cur, h * HALF + sR[i]);
        asm volatile("" ::: "memory");
#pragma unroll
        for (int h = 0; h < 2; ++h)
#pragma unroll
            for (int i = 0; i < 2; ++i) gA[h][i] = (unsigned)(r4[h][i] * K * ESZ + sC[i] * 2); }
        PG8_WAIT_V(0); }
    if constexpr (SP2) {
        PG8_STAGE(PG8_SB(0, 0), cB, voffB); PG8_STAGE(PG8_SB(0, 1), cB + hstep, voffB); PG8_STAGE(PG8_SA(0, 0), cA, gA[0]); PG8_STAGE(PG8_SA(0, 1), cA + hA, gA[1]);
        if (wr == 1) PG8_BAR;
        PG8_WAIT_V(2); PG8_BAR;
        PG8_STAGE(PG8_SB(1, 0), cB + kstep, voffB); PG8_STAGE(PG8_SA(1, 0), cA + kstep, gA[0]); PG8_STAGE(PG8_SB(1, 1), cB + hstep + kstep, voffB);
        PG8_WAIT_V(6); PG8_BAR;
    } else {
        PG8_STAGE(PG8_SB(0, 0), cB, voffB); PG8_STAGE(PG8_SA(0, 0), cA, gA[0]); PG8_STAGE(PG8_SB(0, 1), cB + hstep, voffB); PG8_STAGE(PG8_SA(0, 1), cA + hstep, gA[0]);
        if (wr == 1) PG8_BAR;
        PG8_WAIT_V(4); PG8_BAR;
        PG8_STAGE(PG8_SB(1, 0), cB + kstep, voffB); PG8_STAGE(PG8_SA(1, 0), cA + kstep, gA[0]); PG8_STAGE(PG8_SB(1, 1), cB + hstep + kstep, voffB);
        PG8_WAIT_V(6); PG8_BAR;
    }
    for (;;) {
        const bool has_next = S.next(ui + 1, nxt);
        const char* nA = has_next ? g.a_tile(nxt) : cA; const char* nB = has_next ? g.b_tile(nxt) : cB;
        if constexpr (GATHER) {
                { int r4[2][2];
#pragma unroll
            for (int h = 0; h < 2; ++h)
#pragma unroll
                for (int i = 0; i < 2; ++i) r4[h][i] = has_next ? g.a_row(nxt, h * HALF + sR[i]) : 0;
            asm volatile("" ::: "memory");
#pragma unroll
            for (int h = 0; h < 2; ++h)
#pragma unroll
                for (int i = 0; i < 2; ++i) gAn[h][i] = has_next ? (unsigned)(r4[h][i] * K * ESZ + sC[i] * 2) : gA[h][i]; }
            PG8_WAIT_V(0); }
#pragma unroll 1
        for (int sg = 0; sg < (NSEG == 2 ? 3 : 1); ++sg) {
        const int tb = NSEG == 2 ? (sg == 0 ? 0 : sg == 1 ? nt1 : nt1 + nt1 / 2) : 0, te = NSEG == 2 ? (sg == 0 ? nt1 : sg == 1 ? nt1 + nt1 / 2 : nt) : nt;
#pragma unroll 1
        for (int t = tb; t < te; t += 2) {
            const bool last = (t == nt - 2);
            const long sAc = (NSEG == 2 && t >= nt1) ? dA : 0, sAn = (NSEG == 2 && t + 2 >= nt1) ? dA : 0, sBn = (NSEG == 2 && t + 2 >= nt1) ? dB : 0;
            const char* a1 = cA + sAc + (size_t)(t + 1) * kstep;
            const char* a2 = last ? nA : cA + sAn + (size_t)(t + 2) * kstep; const char* b2 = last ? nB : cB + sBn + (size_t)(t + 2) * kstep;
            const char* a3 = a2 + kstep; const char* b3 = b2 + kstep;
            if (last && has_next) S.a_ready(nxt);
            unsigned g2[2][2];
#pragma unroll
            for (int h = 0; h < 2; ++h)
#pragma unroll
                for (int i = 0; i < 2; ++i) g2[h][i] = (GATHER && last) ? gAn[h][i] : gA[h][i];
            if constexpr (SP2) {
            PG8_LDB(B0, 0, 0); PG8_LDB(B1, 0, 1); PG8_SCHED; PG8_LDA(At, 0, 0); PG8_STAGE(PG8_SA(1, 1), a1 + hA, gA[1]);
            PG8_WAIT_V(8); PG8_WAIT_L(0); PG8_BAR; PG8_MMA(0, 0, At, B0); PG8_MMA(0, 1, At, B1); PG8_BAR; PG8_SCHED;
            PG8_LDA(At, 0, 1); PG8_STAGE(PG8_SB(0, 0), b2, voffB); PG8_STAGE(PG8_SB(0, 1), b2 + hstep, voffB); PG8_STAGE(PG8_SA(0, 0), a2, g2[0]);
            PG8_WAIT_V(8); PG8_WAIT_L(0); PG8_BAR; PG8_MMA(1, 0, At, B0); PG8_MMA(1, 1, At, B1); PG8_BAR; PG8_SCHED;
            PG8_LDB(B0, 1, 0); PG8_LDB(B1, 1, 1); PG8_SCHED; PG8_LDA(At, 1, 0); PG8_STAGE(PG8_SA(0, 1), a2 + hA, g2[1]);
            PG8_WAIT_V(8); PG8_WAIT_L(0); PG8_BAR; PG8_MMA(0, 0, At, B0); PG8_MMA(0, 1, At, B1); PG8_BAR; PG8_SCHED;
            PG8_LDA(At, 1, 1); PG8_STAGE(PG8_SB(1, 0), b3, voffB); PG8_STAGE(PG8_SB(1, 1), b3 + hstep, voffB); PG8_STAGE(PG8_SA(1, 0), a3, g2[0]);
            PG8_WAIT_V(8); PG8_WAIT_L(0); PG8_BAR; PG8_MMA(1, 0, At, B0); PG8_MMA(1, 1, At, B1); PG8_BAR; PG8_SCHED;
            } else {
            PG8_LDB(B0, 0, 0); PG8_SCHED; PG8_LDA(At, 0, 0); PG8_STAGE(PG8_SA(1, 1), a1 + hstep, gA[0]);
            PG8_WAIT_L(8); PG8_BAR; PG8_WAIT_L(0); PG8_MMA(0, 0, At, B0); PG8_BAR; PG8_SCHED;
            PG8_LDB(B1, 0, 1); PG8_STAGE(PG8_SB(0, 0), b2, voffB);
            PG8_BAR; PG8_WAIT_L(0); PG8_MMA(0, 1, At, B1); PG8_BAR;
            PG8_LDA(At, 0, 1); PG8_STAGE(PG8_SA(0, 0), a2, gA[0]);
            PG8_BAR; PG8_WAIT_L(0); PG8_MMA(1, 0, At, B0); PG8_BAR; PG8_SCHED;
            PG8_STAGE(PG8_SB(0, 1), b2 + hstep, voffB);
            PG8_WAIT_V(6); PG8_BAR; PG8_MMA(1, 1, At, B1); PG8_BAR;
            PG8_LDB(B0, 1, 0); PG8_SCHED; PG8_LDA(At, 1, 0); PG8_STAGE(PG8_SA(0, 1), a2 + hstep, gA[0]);
            PG8_WAIT_L(8); PG8_BAR; PG8_WAIT_L(0); PG8_MMA(0, 0, At, B0); PG8_BAR; PG8_SCHED;
            PG8_LDB(B1, 1, 1); PG8_STAGE(PG8_SB(1, 0), b3, voffB);
            PG8_BAR; PG8_WAIT_L(0); PG8_MMA(0, 1, At, B1); PG8_BAR;
            PG8_LDA(At, 1, 1); PG8_STAGE(PG8_SA(1, 0), a3, gA[0]);
            PG8_BAR; PG8_WAIT_L(0); PG8_MMA(1, 0, At, B0); PG8_BAR; PG8_SCHED;
            PG8_STAGE(PG8_SB(1, 1), b3 + hstep, voffB);
            PG8_WAIT_V(6); PG8_BAR; PG8_MMA(1, 1, At, B1); PG8_BAR;
            }
        }
        if constexpr (NSEG == 2) { if (sg < 2) { PG8_SCHED; E.mid(acc, cur, sg, wr, wc, fr, fq); PG8_SCHED; } }
        }
        if constexpr (ALIGN_EPI) { if (wr == 0) PG8_BAR; }
        if constexpr (!Epi::AFTER_DRAIN) {
            if constexpr (I8) { f32x4 accf[2][2][4][2];
#pragma unroll
                for (int a = 0; a < 2; ++a)
#pragma unroll
                    for (int b = 0; b < 2; ++b)
#pragma unroll
                        for (int m = 0; m < 4; ++m)
#pragma unroll
                            for (int n = 0; n < 2; ++n) accf[a][b][m][n] = (f32x4){(float)acc[a][b][m][n][0], (float)acc[a][b][m][n][1], (float)acc[a][b][m][n][2], (float)acc[a][b][m][n][3]};
                E(accf, cur, wr, wc, fr, fq); }
            else E(acc, cur, wr, wc, fr, fq);
            S.done(cur); }
        if (!has_next) break;
#pragma unroll
        for (int a = 0; a < 2; ++a)
#pragma unroll
            for (int b = 0; b < 2; ++b)
#pragma unroll
                for (int m = 0; m < 4; ++m)
#pragma unroll
                    for (int n = 0; n < 2; ++n) acc[a][b][m][n] = (acc_t){0, 0, 0, 0};
        cur = nxt; cA = nA; cB = nB; ++ui;
        if constexpr (GATHER) {
#pragma unroll
            for (int h = 0; h < 2; ++h)
#pragma unroll
                for (int i = 0; i < 2; ++i) gA[h][i] = gAn[h][i]; }
        if constexpr (ALIGN_EPI) { if (wr == 1) PG8_BAR; }
    }
    PG8_WAIT_V(0);
    if constexpr (!ALIGN_EPI) { if (wr == 0) PG8_BAR; }
    PG8_BAR;
    if constexpr (Epi::AFTER_DRAIN) { static_assert(!Epi::AFTER_DRAIN || !I8, "no int8 after-drain epilogues"); }
#undef PG8_SA
#undef PG8_SB
#undef PG8_STAGE
#undef PG8_LDA
#undef PG8_LDB
#undef PG8_MMA
#undef PG8_WAIT_V
#undef PG8_WAIT_L
#undef PG8_BAR
#undef PG8_SCHED
}
}
namespace att {
constexpr int D = 128, NW = 8, QBLK = 32, KVBLK = 64;
constexpr float SCALE = 0.088388347648318440f;
constexpr float THR = 8.f;
constexpr int SDEPTH = 2;
constexpr int LDQ = 1024, LDK = 256, LDO = 1024;
constexpr size_t SHM_V = KVBLK * D * 2, SHM_K = KVBLK * D * 2, SHM_ATTN = 2 * SHM_V + 2 * SHM_K + NW * 64 * 4;
typedef bf16_t bf16;
__device__ __forceinline__ unsigned cvtpk(float lo, float hi) { return cvt_pk_bf16(lo, hi); }
struct St { using T = bf16x8;
  __device__ static __forceinline__ T ld8(const bf16* p) { return *reinterpret_cast<const bf16x8*>(p); }
  __device__ static __forceinline__ bf16x8 tobf(T x) { return x; } };
#define KSWZ(row, colB) ((row) * 256 + ((colB) ^ (((row) & 7) << 4)))
#define SBAR() __builtin_amdgcn_sched_barrier(0)
__device__ __forceinline__ int crow(int r, int hi) { return (r & 3) + 8 * (r >> 2) + 4 * hi; }
__device__ __forceinline__ void partialSM(f32x16& p0, f32x16& p1, float& m_reg, float& mn, float& alpha) {
  constexpr float C = SCALE * 1.4426950408889634f;
  float pmax = p0[0]; for (int r = 1; r < 16; ++r) pmax = fmaxf(pmax, p0[r]); for (int r = 0; r < 16; ++r) pmax = fmaxf(pmax, p1[r]);
  { auto rr = __builtin_amdgcn_permlane32_swap(__float_as_uint(pmax), __float_as_uint(pmax), false, false);
    pmax = fmaxf(__uint_as_float(rr[0]), __uint_as_float(rr[1])); }
  if (__builtin_expect(__all(pmax - m_reg <= THR / SCALE), 1)) { mn = m_reg; alpha = 1.f; }
  else { mn = fmaxf(m_reg, pmax); alpha = __builtin_amdgcn_exp2f((m_reg - mn) * C); m_reg = mn; }
  float mnC = -mn * C;
  for (int r = 0; r < 16; ++r) p0[r] = fmaf(p0[r], C, mnC); for (int r = 0; r < 16; ++r) p1[r] = fmaf(p1[r], C, mnC);
  for (int r = 0; r < 16; ++r) p0[r] = __builtin_amdgcn_exp2f(p0[r]);
}
__device__ __forceinline__ void finishSM(f32x16& p0, f32x16& p1, float alpha, float& l_reg, bf16x8& pa0, bf16x8& pa1, bf16x8& pa2, bf16x8& pa3) {
  for (int r = 0; r < 16; ++r) p1[r] = __builtin_amdgcn_exp2f(p1[r]);
  float ps = 0; for (int r = 0; r < 16; ++r) ps += p0[r]; for (int r = 0; r < 16; ++r) ps += p1[r];
  { auto rr = __builtin_amdgcn_permlane32_swap(__float_as_uint(ps), __float_as_uint(ps), false, false);
    ps = __uint_as_float(rr[0]) + __uint_as_float(rr[1]); }
  l_reg = l_reg * alpha + ps;
#define PK4(P, BASE, OUT) do { unsigned a0 = cvtpk(P[BASE + 0], P[BASE + 1]), a1 = cvtpk(P[BASE + 2], P[BASE + 3]);   \
    unsigned b0 = cvtpk(P[BASE + 4], P[BASE + 5]), b1 = cvtpk(P[BASE + 6], P[BASE + 7]);                              \
    auto r0 = __builtin_amdgcn_permlane32_swap(a0, b0, false, false); auto r1 = __builtin_amdgcn_permlane32_swap(a1, b1, false, false); \
    u32x4 w = {r0[0], r1[0], r0[1], r1[1]}; OUT = *reinterpret_cast<bf16x8*>(&w); } while (0)
  PK4(p0, 0, pa0); PK4(p0, 8, pa1); PK4(p1, 0, pa2); PK4(p1, 8, pa3);
#undef PK4
}
__device__ __forceinline__ void qkt(f32x16& p0, f32x16& p1, const bf16* Ks, const bf16x8* qr, int r32, int hi) {
  p0 = f32x16{}; p1 = f32x16{};
  for (int d0 = 0; d0 < 8; ++d0) { int cb = (d0 * 16 + hi * 8) * 2;
    bf16x8 b0 = *reinterpret_cast<const bf16x8*>((const char*)Ks + KSWZ(r32, cb));
    bf16x8 b1 = *reinterpret_cast<const bf16x8*>((const char*)Ks + KSWZ(32 + r32, cb));
    p0 = __builtin_amdgcn_mfma_f32_32x32x16_bf16(b0, qr[d0], p0, 0, 0, 0);
    p1 = __builtin_amdgcn_mfma_f32_32x32x16_bf16(b1, qr[d0], p1, 0, 0, 0); }
}
__device__ __forceinline__ int v_st(int k, int c) { const int kk = (k & ~0xC) | ((k & 4) << 1) | ((k & 8) >> 1); return ((kk >> 3) * 4 + (c >> 5)) * 512 + ((kk & 7) * 32 + (c & 31)) * 2; }
__device__ __forceinline__ int v_rd_base(int lane) { return ((lane & 3) << 3) | (((lane >> 2) & 3) << 6) | (((lane >> 4) & 1) << 5) | (((lane >> 5) & 1) << 8); }
constexpr int v_rd_off(int d0, int ks, int half) { return d0 * 512 + ks * 4096 + half * 2048; }
template <int OFF> __device__ __forceinline__ s16x4 tr_read(int vb) {
  s16x4 r; asm volatile("ds_read_b64_tr_b16 %0, %1 offset:%2" : "=&v"(r) : "v"(vb), "i"(OFF) : "memory"); return r;
}
template <int D0> __device__ __forceinline__ void pv_one(f32x16& od, int vb, bf16x8 pa0, bf16x8 pa1, bf16x8 pa2, bf16x8 pa3) {
  const s16x4 l0 = tr_read<v_rd_off(D0, 0, 0)>(vb), h0 = tr_read<v_rd_off(D0, 0, 1)>(vb), l1 = tr_read<v_rd_off(D0, 1, 0)>(vb), h1 = tr_read<v_rd_off(D0, 1, 1)>(vb);
  const s16x4 l2 = tr_read<v_rd_off(D0, 2, 0)>(vb), h2 = tr_read<v_rd_off(D0, 2, 1)>(vb), l3 = tr_read<v_rd_off(D0, 3, 0)>(vb), h3 = tr_read<v_rd_off(D0, 3, 1)>(vb);
  asm volatile("s_waitcnt lgkmcnt(0)" ::: "memory"); SBAR();
#define PK(L, H) (bf16x8){L[0], L[1], L[2], L[3], H[0], H[1], H[2], H[3]}
  od = __builtin_amdgcn_mfma_f32_32x32x16_bf16(pa0, PK(l0, h0), od, 0, 0, 0);
  od = __builtin_amdgcn_mfma_f32_32x32x16_bf16(pa1, PK(l1, h1), od, 0, 0, 0);
  od = __builtin_amdgcn_mfma_f32_32x32x16_bf16(pa2, PK(l2, h2), od, 0, 0, 0);
  od = __builtin_amdgcn_mfma_f32_32x32x16_bf16(pa3, PK(l3, h3), od, 0, 0, 0);
#undef PK
}
__device__ __forceinline__ void pv_d0(f32x16* o, int vb, bf16x8 pa0, bf16x8 pa1, bf16x8 pa2, bf16x8 pa3) {
  pv_one<0>(o[0], vb, pa0, pa1, pa2, pa3); pv_one<1>(o[1], vb, pa0, pa1, pa2, pa3); pv_one<2>(o[2], vb, pa0, pa1, pa2, pa3); pv_one<3>(o[3], vb, pa0, pa1, pa2, pa3);
}

__device__ __forceinline__ void attn_dense_body(const bf16* Qb, const bf16* __restrict__ Kh, const bf16* __restrict__ Vh,
                                                bf16* Ob, int seq, char* lds, int tid_in, const float* qgain, const float* ropc, const float* rops, int t0) {
  using SQ = St;
  int tid_ = tid_in; asm volatile("" : "+v"(tid_));
  const int tid = tid_, wid = tid >> 6, lane = tid & 63, r32 = lane & 31, hi = lane >> 5;
  bf16* V_lds = (bf16*)lds; bf16* K_lds = (bf16*)(lds + 2 * SHM_V);
  float* ws = (float*)(lds + 2 * SHM_V + 2 * SHM_K) + wid * 64; float* li_l = ws; float* al_l = ws + 32;
  float m_reg = -1e30f, l_reg = 0; f32x16 o[4] = {}; bf16x8 qr[8];
  const bf16* Qw = Qb + (long)(wid * QBLK + r32) * LDQ + hi * 8;
#pragma unroll
  for (int d0 = 0; d0 < 8; ++d0) qr[d0] = SQ::tobf(SQ::ld8(Qw + d0 * 16));
  { float qf[8][8]; float ss = 0.f;
#pragma unroll
    for (int d0 = 0; d0 < 8; ++d0) { const u32x4 w = __builtin_bit_cast(u32x4, qr[d0]);
      qf[d0][0] = bflo(w.x); qf[d0][1] = bfhi(w.x); qf[d0][2] = bflo(w.y); qf[d0][3] = bfhi(w.y); qf[d0][4] = bflo(w.z); qf[d0][5] = bfhi(w.z); qf[d0][6] = bflo(w.w); qf[d0][7] = bfhi(w.w);
#pragma unroll
      for (int j = 0; j < 8; ++j) ss = fmaf(qf[d0][j], qf[d0][j], ss); }
    { auto rr = __builtin_amdgcn_permlane32_swap(__float_as_uint(ss), __float_as_uint(ss), false, false); ss = __uint_as_float(rr[0]) + __uint_as_float(rr[1]); }
    const float rms = rsqrtf(ss * (1.f / 128.f) + 1e-6f);
#pragma unroll
    for (int d0 = 0; d0 < 8; ++d0) { const f32x4 g0 = *(const f32x4*)(qgain + d0 * 16 + hi * 8), g1 = *(const f32x4*)(qgain + d0 * 16 + hi * 8 + 4);
      qf[d0][0] *= rms * g0.x; qf[d0][1] *= rms * g0.y; qf[d0][2] *= rms * g0.z; qf[d0][3] *= rms * g0.w; qf[d0][4] *= rms * g1.x; qf[d0][5] *= rms * g1.y; qf[d0][6] *= rms * g1.z; qf[d0][7] *= rms * g1.w; }
    if (t0 >= 0) { const int t = t0 + wid * QBLK + r32;
#pragma unroll
      for (int d0 = 0; d0 < 4; ++d0) { const float* cp = ropc + (long)t * 64 + d0 * 16 + hi * 8; const float* sp = rops + (long)t * 64 + d0 * 16 + hi * 8;
        const f32x4 c0 = *(const f32x4*)cp, c1 = *(const f32x4*)(cp + 4), s0 = *(const f32x4*)sp, s1 = *(const f32x4*)(sp + 4);
        const float cs[8] = {c0.x, c0.y, c0.z, c0.w, c1.x, c1.y, c1.z, c1.w}, sn[8] = {s0.x, s0.y, s0.z, s0.w, s1.x, s1.y, s1.z, s1.w};
#pragma unroll
        for (int j = 0; j < 8; ++j) { const float x1 = qf[d0][j], x2 = qf[d0 + 4][j]; qf[d0][j] = x1 * cs[j] - x2 * sn[j]; qf[d0 + 4][j] = x2 * cs[j] + x1 * sn[j]; } } }
#pragma unroll
    for (int d0 = 0; d0 < 8; ++d0) { u32x4 w = {cvtpk(qf[d0][0], qf[d0][1]), cvtpk(qf[d0][2], qf[d0][3]), cvtpk(qf[d0][4], qf[d0][5]), cvtpk(qf[d0][6], qf[d0][7])}; qr[d0] = __builtin_bit_cast(bf16x8, w); } }
  const int sr = tid >> 4, sc = (tid & 15) * 8, vst0 = v_st(sr, sc), vst1 = v_st(32 + sr, sc);
  const int vb0 = (int)(uintptr_t)V_lds + v_rd_base(lane);
  struct { typename St::T vs0, vs1, ks0, ks1; } sr_[SDEPTH];
#define SLOAD(i, k0) do { sr_[i].vs0 = St::ld8(&Vh[(long)((k0) + sr) * LDK + sc]); sr_[i].vs1 = St::ld8(&Vh[(long)((k0) + 32 + sr) * LDK + sc]); \
    sr_[i].ks0 = St::ld8(&Kh[(long)((k0) + sr) * LDK + sc]); sr_[i].ks1 = St::ld8(&Kh[(long)((k0) + 32 + sr) * LDK + sc]); } while (0)
#define SWRITE(b, i) do { *(bf16x8*)((char*)V_lds + (b) * SHM_V + vst0) = St::tobf(sr_[i].vs0);          \
    *(bf16x8*)((char*)V_lds + (b) * SHM_V + vst1) = St::tobf(sr_[i].vs1); int kc = sc * 2;               \
    *(bf16x8*)((char*)K_lds + (b) * SHM_K + KSWZ(sr, kc)) = St::tobf(sr_[i].ks0);                       \
    *(bf16x8*)((char*)K_lds + (b) * SHM_K + KSWZ(32 + sr, kc)) = St::tobf(sr_[i].ks1); } while (0)
#define SWAIT() do { if constexpr (SDEPTH == 2) asm volatile("s_waitcnt vmcnt(4)" ::: "memory"); else asm volatile("s_waitcnt vmcnt(0)" ::: "memory"); } while (0)
#define RESC(a) do { if (__any((a) < 1.f)) { if (hi == 0) al_l[r32] = (a); asm volatile("s_waitcnt lgkmcnt(0)" ::: "memory"); \
    for (int d = 0; d < 4; ++d) for (int r = 0; r < 16; ++r) o[d][r] *= al_l[crow(r, hi)]; } } while (0)
  f32x16 pA0, pA1, pB0, pB1; float mnA, mnB, alA, alB; bf16x8 pa0, pa1, pa2, pa3; const int NT = seq / KVBLK;
  constexpr int SE = 0, SO = SDEPTH - 1;
  SLOAD(SE, 0); asm volatile("s_waitcnt vmcnt(0)" ::: "memory"); SWRITE(0, SE); __syncthreads();
  qkt(pA0, pA1, K_lds, qr, r32, hi); partialSM(pA0, pA1, m_reg, mnA, alA);
  SLOAD(SO, KVBLK); if constexpr (SDEPTH == 2) { if (2 < NT) SLOAD(SE, 2 * KVBLK); }
  SWAIT(); SWRITE(1, SO); __syncthreads();
  for (int j = 1; j + 1 < NT; j += 2) {
    SBAR(); qkt(pB0, pB1, (bf16*)((char*)K_lds + SHM_K), qr, r32, hi);
    finishSM(pA0, pA1, alA, l_reg, pa0, pa1, pa2, pa3); SBAR();
    SLOAD(SO, (j + SDEPTH) * KVBLK); SBAR();
    pv_d0(o, vb0, pa0, pa1, pa2, pa3); partialSM(pB0, pB1, m_reg, mnB, alB);
    __syncthreads(); SWAIT(); SWRITE(0, SE);
    RESC(alB); __syncthreads();
    SBAR(); qkt(pA0, pA1, K_lds, qr, r32, hi);
    finishSM(pB0, pB1, alB, l_reg, pa0, pa1, pa2, pa3); SBAR();
    if (SDEPTH == 1 || j + 3 < NT) SLOAD(SE, (j + 1 + SDEPTH) * KVBLK); SBAR();
    pv_d0(o, vb0 + (int)SHM_V, pa0, pa1, pa2, pa3); partialSM(pA0, pA1, m_reg, mnA, alA);
    __syncthreads(); SWAIT(); SWRITE(1, SO);
    RESC(alA); __syncthreads();
  }
  SBAR(); qkt(pB0, pB1, (bf16*)((char*)K_lds + SHM_K), qr, r32, hi);
  finishSM(pA0, pA1, alA, l_reg, pa0, pa1, pa2, pa3); SBAR();
  pv_d0(o, vb0, pa0, pa1, pa2, pa3); partialSM(pB0, pB1, m_reg, mnB, alB);
  __syncthreads(); RESC(alB);
  finishSM(pB0, pB1, alB, l_reg, pa0, pa1, pa2, pa3); SBAR();
  pv_d0(o, vb0 + (int)SHM_V, pa0, pa1, pa2, pa3);
  if (hi == 0) li_l[r32] = l_reg; asm volatile("s_waitcnt lgkmcnt(0)" ::: "memory");
  float rli[16];
#pragma unroll
  for (int r = 0; r < 16; ++r) rli[r] = __builtin_amdgcn_rcpf(li_l[crow(r, hi)]);
  bf16* Ow = Ob + (long)(wid * QBLK) * LDO;
#pragma unroll
  for (int r = 0; r < 16; ++r) { int orow = crow(r, hi);
#pragma unroll
    for (int d0 = 0; d0 < 4; ++d0) Ow[(long)orow * LDO + d0 * 32 + r32] = f2bf(o[d0][r] * rli[r]); }
  __syncthreads();
#undef SLOAD
#undef SWRITE
#undef SWAIT
#undef RESC
}
}
struct Args { const float* in[N_IN]; float* out; unsigned char* ws; int lo, hi; };
struct Frame {
    LAS unsigned char* lds; unsigned char* lds_gen;
    int tid, lane, wave, G, bid;
    const float* const* in; float* out; unsigned char* ws;
};
__device__ __forceinline__ const float* fin_ptr(const float* const* tab, int i) {
    const unsigned long long p = (unsigned long long)tab[i];
    const unsigned lo = __builtin_amdgcn_readfirstlane((unsigned)p), hi = __builtin_amdgcn_readfirstlane((unsigned)(p >> 32));
    return (const float*)(const GAS float*)(((unsigned long long)hi << 32) | lo);
}
#define FIN(i) fin_ptr(F.in, (i))
__device__ __forceinline__ float* hrow_ptr(const Frame& F, int chunk, int r) {
    const int bl = r / TOK, pos = r - bl * TOK, b = chunk * BC + bl;
    return pos < CTX ? (float*)(F.ws + WS_HC) + ((size_t)(b * CTX + pos) << 10) : F.out + ((size_t)(b * SEQ + pos - CTX) << 10);
}
__device__ __forceinline__ const float* hrow_src(const float* lat, const float* ctxb, int chunk, int r) {
    const int bl = r / TOK, pos = r - bl * TOK, b = chunk * BC + bl;
    return pos < CTX ? ctxb + ((size_t)(b * CTX + pos) << 10) : lat + ((size_t)(b * SEQ + pos - CTX) << 10);
}
__device__ __forceinline__ int mod_row(int chunk, int r) { const int bl = r / TOK, pos = r - bl * TOK; return pos < CTX ? 16 : chunk * BC + bl; }
__device__ __forceinline__ const float* mod_ptr(const Frame& F, int l, int mrow, int part) { return (const float*)(F.ws + WS_MOD) + ((size_t)(l * 17 + mrow) * 6 + part) * DM; }

__device__ __forceinline__ void p_prologue(const Frame& F, const Args& args) {
#undef FIN
#define FIN(i) (args.in[i])
    if (F.bid == 0 && F.tid < N_IN) { const float* v = nullptr;
#pragma unroll
        for (int i = 0; i < N_IN; ++i) v = (F.tid == i) ? args.in[i] : v;
        ((const float**)(F.ws + WS_TAB))[F.tid] = v; }
    {
        float* ropc = (float*)(F.ws + WS_ROPE); float* rops = ropc + SEQ * 64;
        for (int i = F.bid * 512 + F.tid; i < SEQ * 64; i += F.G * 512) { const int t = i >> 6, pp = i & 63;
            const float inv = exp2f(-(float)(pp & 31) * (13.287712379549449f / 32.0f)), ang = (float)(pp < 32 ? t / GRIDW : t % GRIDW) * inv; float s, c; sincos_rr(ang, s, c);
            ropc[i] = c; rops[i] = s; }
    }
    LAS float* sl = (LAS float*)F.lds; LAS float* red = sl + 17 * DM;
    for (int cbk = F.bid; cbk < (DEPTH * 6 * DM) / 128; cbk += F.G) {
        __syncthreads();
        for (int i = F.tid; i < 17 * DM; i += 512) { const float v = i < 16 * DM ? FIN(I_C)[i] : FIN(I_CCTX)[i - 16 * DM]; sl[i] = silu_f(v); }
        __syncthreads();
        const int kq = F.tid >> 7, cn = F.tid & 127, col = cbk * 128 + cn, l = col / (6 * DM), n = col - l * 6 * DM;
        const float* w = FIN(I_MODW) + (size_t)l * DM * 6 * DM + (size_t)(256 * kq) * 6 * DM + n;
        float acc[17];
#pragma unroll
        for (int j = 0; j < 17; ++j) acc[j] = 0.f;
        for (int k0 = 0; k0 < 256; k0 += 8) { float wv[8];
#pragma unroll
            for (int q = 0; q < 8; ++q) wv[q] = w[(size_t)(k0 + q) * 6 * DM];
#pragma unroll
            for (int q = 0; q < 8; ++q)
#pragma unroll
                for (int j = 0; j < 17; ++j) acc[j] = fmaf(sl[j * DM + 256 * kq + k0 + q], wv[q], acc[j]); }
        if (kq > 0) {
#pragma unroll
            for (int j = 0; j < 17; ++j) red[((kq - 1) * 17 + j) * 128 + cn] = acc[j]; }
        __syncthreads();
        if (kq == 0) { const float bv = FIN(I_MODB)[l * 6 * DM + n]; float* mo = (float*)(F.ws + WS_MOD) + (size_t)l * 17 * 6 * DM + n;
#pragma unroll
            for (int j = 0; j < 17; ++j) mo[(size_t)j * 6 * DM] = acc[j] + red[(0 * 17 + j) * 128 + cn] + red[(1 * 17 + j) * 128 + cn] + red[(2 * 17 + j) * 128 + cn] + bv; }
    }
    __syncthreads();
#undef FIN
#define FIN(i) fin_ptr(F.in, (i))
}

__device__ __forceinline__ void transpose_item(const float* __restrict__ W, int N, int k0, int n0, bf16_t* dst  , int Kd, LAS float* scr, int lane, float wscale = 1.0f) {
    {
        int step = 2 * N; asm volatile("" : "+v"(step));
        const float* wp = W + (size_t)(k0 + (lane >> 5)) * N + n0 + (lane & 31);
        float v[32];
#pragma unroll
        for (int i = 0; i < 32; ++i) { v[i] = __builtin_nontemporal_load(wp); wp += step; }
#pragma unroll
        for (int i = 0; i < 32; ++i) scr[(2 * i + (lane >> 5)) * 33 + (lane & 31)] = v[i] * wscale;
    }
    LDS_WAIT(); asm volatile("" ::: "memory");
    const int c = lane & 7;
#pragma unroll
    for (int j = 0; j < 4; ++j) { const int n = (lane >> 3) + 8 * j; const LAS float* s = scr + (8 * c) * 33 + n;
        u32x4 o; o.x = cvt_pk_bf16_nv(s[0 * 33], s[1 * 33]); o.y = cvt_pk_bf16_nv(s[2 * 33], s[3 * 33]); o.z = cvt_pk_bf16_nv(s[4 * 33], s[5 * 33]); o.w = cvt_pk_bf16_nv(s[6 * 33], s[7 * 33]);
        *(u32x4*)(dst + (size_t)n * Kd + k0 + 8 * c) = o; }
    LDS_WAIT(); asm volatile("" ::: "memory");
}
__device__ __forceinline__ void quant_item(const float* __restrict__ W, int ldw, int n0, signed char* dst, float* sdst, LAS int* scr, int lane) {
    const int cn = lane & 31, hi = lane >> 5;
    const float* wp0 = W + (size_t)hi * ldw + n0 + cn;
    float mx = 0.f;
    for (int kb = 0; kb < 32; ++kb) { float v[16];
#pragma unroll
        for (int i = 0; i < 16; ++i) v[i] = wp0[(size_t)(32 * kb + 2 * i) * ldw];
#pragma unroll
        for (int i = 0; i < 16; ++i) mx = fmaxf(mx, fabsf(v[i])); }
    mx = fmaxf(mx, __shfl_xor(mx, 32));
    const float inv = mx > 0.f ? 127.0f / mx : 0.f;
    if (lane < 32) sdst[lane] = mx * (1.0f / 127.0f);
    for (int kc = 0; kc < 8; ++kc) {
#pragma unroll
        for (int hb = 0; hb < 4; ++hb) { float v[16];
#pragma unroll
            for (int i = 0; i < 16; ++i) v[i] = wp0[(size_t)(128 * kc + 32 * hb + 2 * i) * ldw];
#pragma unroll
            for (int i = 0; i < 16; ++i) scr[(32 * hb + 2 * i + hi) * 33 + cn] = (int)rintf(v[i] * inv); }
        LDS_WAIT(); asm volatile("" ::: "memory");
#pragma unroll
        for (int t = 0; t < 4; ++t) { const int chunk = lane + 64 * t, n = chunk >> 3, c16 = chunk & 7; const LAS int* s = scr + (16 * c16) * 33 + n; unsigned w[4];
#pragma unroll
            for (int q = 0; q < 4; ++q) w[q] = (unsigned)(s[(4 * q) * 33] & 255) | ((unsigned)(s[(4 * q + 1) * 33] & 255) << 8) | ((unsigned)(s[(4 * q + 2) * 33] & 255) << 16) | ((unsigned)(s[(4 * q + 3) * 33] & 255) << 24);
            u32x4 o; o.x = w[0]; o.y = w[1]; o.z = w[2]; o.w = w[3]; *(u32x4*)(dst + (size_t)n * DM + 128 * kc + 16 * c16) = o; }
        LDS_WAIT(); asm volatile("" ::: "memory");
    }
}
__device__ __forceinline__ void quant_item_wg(const Frame& F, const float* __restrict__ W, int ldw, int n0, signed char* dst, float* sdst, int par) {
    LAS int* scr = (LAS int*)(F.lds + F.wave * 16896); LAS float* cmx = (LAS float*)(F.lds + 8 * 16896) + par * 256;
    const int lane = F.lane, cn = lane & 31, hi = lane >> 5;
    int step = 2 * ldw; asm volatile("" : "+v"(step));
    const float* wp = W + (size_t)(128 * F.wave + hi) * ldw + n0 + cn;
    float v[64];
#pragma unroll
    for (int i = 0; i < 64; ++i) { v[i] = __builtin_nontemporal_load(wp); wp += step; }
    float mx = 0.f;
#pragma unroll
    for (int i = 0; i < 64; ++i) mx = fmaxf(mx, fabsf(v[i]));
    mx = fmaxf(mx, __shfl_xor(mx, 32));
    if (lane < 32) cmx[F.wave * 32 + lane] = mx;
    __syncthreads();
    float m = 0.f;
#pragma unroll
    for (int w = 0; w < 8; ++w) m = fmaxf(m, cmx[w * 32 + cn]);
    const float inv = m > 0.f ? 127.0f / m : 0.f;
    if (F.wave == 0 && lane < 32) sdst[lane] = m * (1.0f / 127.0f);
#pragma unroll
    for (int i = 0; i < 64; ++i) scr[(2 * i + hi) * 33 + cn] = (int)rintf(v[i] * inv);
    LDS_WAIT(); asm volatile("" ::: "memory");
#pragma unroll
    for (int t = 0; t < 4; ++t) { const int chunk = lane + 64 * t, n = chunk >> 3, c16 = chunk & 7; const LAS int* s = scr + (16 * c16) * 33 + n; unsigned w[4];
#pragma unroll
        for (int q = 0; q < 4; ++q) w[q] = (unsigned)(s[(4 * q) * 33] & 255) | ((unsigned)(s[(4 * q + 1) * 33] & 255) << 8) | ((unsigned)(s[(4 * q + 2) * 33] & 255) << 16) | ((unsigned)(s[(4 * q + 3) * 33] & 255) << 24);
        u32x4 o; o.x = w[0]; o.y = w[1]; o.z = w[2]; o.w = w[3]; *(u32x4*)(dst + (size_t)n * DM + 128 * F.wave + 16 * c16) = o; }
    LDS_WAIT(); asm volatile("" ::: "memory");
}
__device__ __forceinline__ void filt_unit(const Frame& F, int l, int n, int i0, bf16_t* FR) {
    const int lane = F.lane;
    const float* fw1 = FIN(I_FW1) + (size_t)l * 33 * 64; const float* fb1 = FIN(I_FB1) + l * 64;
    const float* fw2 = FIN(I_FW2) + (size_t)l * 64 * 64; const float* fb2 = FIN(I_FB2) + l * 64;
    const float* fw3 = FIN(I_FW3) + (size_t)l * 64 * 1024; const float* fq = FIN(I_FREQ) + l * 128;
    LAS bf16_t* T = (LAS bf16_t*)F.lds;
    float h2[4], tt[4], w1v[33];
#pragma unroll
    for (int q = 0; q < 33; ++q) w1v[q] = fw1[q * 64 + lane];
    const float b1v = fb1[lane], b2v = fb2[lane], f0v = fq[lane], f1v = fq[64 + lane];
    float w2v[64];
#pragma unroll
    for (int q = 0; q < 64; ++q) w2v[q] = fw2[q * 64 + lane];
    asm volatile("" ::: "memory");
#pragma unroll
    for (int p = 0; p < 4; ++p) { const int i = i0 + 4 * F.wave + p;
        const float t = (float)i / (float)(n - 1), w = (6.283185307179586f / (float)n) * (float)i; tt[p] = t;
        float a = b1v + t * w1v[0];
#pragma unroll
        for (int q = 0; q < 16; ++q) { const float f = 1e-4f + (float)q * ((15.0f - 1e-4f) / 15.0f); float s, c; sincos_rr(f * w, s, c);
            a = fmaf(c, w1v[1 + q], a); a = fmaf(-s, w1v[17 + q], a); }
        float sn, cs; sincos_rr(f0v * a, sn, cs); const float h1 = sn;
        float a2 = b2v;
#pragma unroll
        for (int q = 0; q < 64; ++q) a2 = fmaf(__shfl(h1, q), w2v[q], a2);
        sincos_rr(f1v * a2, sn, cs); h2[p] = sn; }
    float o[4][16];
#pragma unroll
    for (int p = 0; p < 4; ++p)
#pragma unroll
        for (int m = 0; m < 16; ++m) o[p][m] = 0.f;
    for (int q = 0; q < 64; q += 4) { float hq[4][4];
#pragma unroll
        for (int qq = 0; qq < 4; ++qq)
#pragma unroll
            for (int p = 0; p < 4; ++p) hq[qq][p] = __shfl(h2[p], q + qq);
        float wv[4][16];
#pragma unroll
        for (int qq = 0; qq < 4; ++qq)
#pragma unroll
            for (int m = 0; m < 16; ++m) wv[qq][m] = fw3[(q + qq) * 1024 + m * 64 + lane];
        asm volatile("" ::: "memory");
#pragma unroll
        for (int qq = 0; qq < 4; ++qq)
#pragma unroll
            for (int m = 0; m < 16; ++m)
#pragma unroll
                for (int p = 0; p < 4; ++p) o[p][m] = fmaf(hq[qq][p], wv[qq][m], o[p][m]); }
    const float mind = -3.0701134573253945f, maxd = -15.350567286626973f;
    __syncthreads();
#pragma unroll
    for (int m = 0; m < 8; ++m) { const int c = m * 64 + lane; const float dl = mind + (float)c * ((maxd - mind) / 511.0f);
#pragma unroll
        for (int p = 0; p < 4; ++p) { const float dec = __expf(tt[p] * dl);
            T[c * 32 + 4 * F.wave + p] = f2bf(o[p][m] * dec); T[(512 + c) * 32 + 4 * F.wave + p] = f2bf(o[p][m + 8] * dec); } }
    __syncthreads();
    const int CL = 2 * n + 16, pp = F.tid & 31, i = i0 + pp;
    for (int row = F.tid >> 5; row < 1024; row += 16) { const int dir = row >> 9, c = row & 511; float v = bf2f(T[row * 32 + pp]);
        if (i == 0) { if (dir) continue; v += bf2f(T[(512 + c) * 32 + pp]); }
        FR[(size_t)c * CL + (dir ? n + i : n - i)] = f2bf(v); }
}
__device__ __forceinline__ void p_weights(const Frame& F, int l) {
    LAS float* scr = (LAS float*)(F.lds + F.wave * 16896);
    const int gw = F.bid * 8 + F.wave, NGW = F.G * 8;
    constexpr int I_B = 16 * 32, I_C2 = 8 * 32, I_E = 16 * 32;
    constexpr int I_A = 0;
    constexpr int NITEMS = I_A + I_B + 2 * I_C2 + I_E;
    for (int u = F.bid; u < (SEQ + CTX) / 32; u += F.G) {
        if (u < SEQ / 32) filt_unit(F, l, SEQ, 32 * u, (bf16_t*)(F.ws + WS_FRL));
        else filt_unit(F, l, CTX, 32 * (u - SEQ / 32), (bf16_t*)(F.ws + WS_FRC));
    }
    __syncthreads();
    constexpr int NFB = (SEQ + CTX) / 32;
    const int nfw = (F.G > NFB ? NFB : F.G) * 8, now = (F.G > NFB ? F.G - NFB : 0) * 8, nslots = nfw + 3 * now;
    for (int sl0 = (F.bid < NFB ? gw : nfw + 3 * (gw - nfw)), rep3 = 0; rep3 < (F.bid < NFB ? 1 : 3); ++rep3)
    for (int it = sl0 + rep3; it < NITEMS; it += nslots) {
        int r = it;
        if (r < I_A) { const int kb = r / 128, nb = r % 128; transpose_item(FIN(I_WIN) + (size_t)l * DM * IN_TOTAL, IN_TOTAL, 64 * kb, 32 * nb, (bf16_t*)(F.ws + WS_WINB) + (size_t)(32 * nb) * DM, DM, scr, F.lane); continue; } r -= I_A;
        if (r < I_B) { const int kb = r / 32, nb = r % 32; transpose_item(FIN(I_WAO) + (size_t)l * DM * DM, DM, 64 * kb, 32 * nb, (bf16_t*)(F.ws + WS_WA) + (size_t)(32 * nb) * DM, DM, scr, F.lane, 1.0f / 255.0f); continue; } r -= I_B;
        if (r < I_C2) { const int kb = r / 32, nb = r % 32; transpose_item(FIN(I_WHO) + (size_t)l * 512 * DM, DM, 64 * kb, 32 * nb, (bf16_t*)(F.ws + WS_WH) + (size_t)(32 * nb) * 1024, 1024, scr, F.lane, 1.0f / 255.0f); continue; } r -= I_C2;
        if (r < I_C2) { const int kb = r / 32, nb = r % 32; transpose_item(FIN(I_WLO) + (size_t)l * 512 * DM, DM, 64 * kb, 32 * nb, (bf16_t*)(F.ws + WS_WH) + (size_t)(32 * nb) * 1024 + 512, 1024, scr, F.lane, 1.0f / 255.0f); continue; } r -= I_C2;
        { const int kb = r / 32, nb = r % 32; transpose_item(FIN(I_WOUT) + (size_t)l * DM * DM, DM, 64 * kb, 32 * nb, (bf16_t*)(F.ws + WS_WO) + (size_t)(32 * nb) * DM, DM, scr, F.lane); }
    }
    __syncthreads();
    { int par = 0;
      for (int nb = F.G - 1 - F.bid; nb < 224; nb += F.G, par ^= 1)
        quant_item_wg(F, FIN(I_WIN) + (size_t)l * DM * IN_TOTAL, IN_TOTAL, 32 * nb, (signed char*)(F.ws + WS_WIN) + (size_t)(32 * nb) * DM, (float*)(F.ws + WS_SWIN) + 32 * nb, par); }
    __syncthreads();
}
__device__ __forceinline__ void w_filters(const Frame& F, int l, int first) {
    if (F.G <= first) first = 0; if (F.bid < first) return;
    for (int u = F.bid - first; u < (SEQ + CTX) / 32; u += F.G - first) {
        if (u < SEQ / 32) filt_unit(F, l, SEQ, 32 * u, (bf16_t*)(F.ws + WS_FRL));
        else filt_unit(F, l, CTX, 32 * (u - SEQ / 32), (bf16_t*)(F.ws + WS_FRC));
    }
    __syncthreads();
}
__device__ __forceinline__ void w_quant_in(const Frame& F, int l, int first) {
    if (F.G <= first) first = 0; if (F.bid < first) return;
    __syncthreads();
    int par = 0;
    for (int nb = F.bid - first; nb < 224; nb += F.G - first, par ^= 1)
        quant_item_wg(F, FIN(I_WIN) + (size_t)l * DM * IN_TOTAL, IN_TOTAL, 32 * nb, (signed char*)(F.ws + WS_WIN) + (size_t)(32 * nb) * DM, (float*)(F.ws + WS_SWIN) + 32 * nb, par);
    __syncthreads();
}
__device__ __forceinline__ void w_transposes(const Frame& F, int l, int first) {
    if (F.G <= first) first = 0; if (F.bid < first) return;
    LAS float* scr = (LAS float*)(F.lds + F.wave * 16896);
    constexpr int I_B = 16 * 32, I_C2 = 8 * 32, I_E = 16 * 32, NITEMS = I_B + 2 * I_C2 + I_E;
    for (int it = (F.bid - first) * 8 + F.wave; it < NITEMS; it += (F.G - first) * 8) {
        int r = it;
        if (r < I_B) { const int kb = r / 32, nb = r % 32; transpose_item(FIN(I_WAO) + (size_t)l * DM * DM, DM, 64 * kb, 32 * nb, (bf16_t*)(F.ws + WS_WA) + (size_t)(32 * nb) * DM, DM, scr, F.lane, 1.0f / 255.0f); continue; } r -= I_B;
        if (r < I_C2) { const int kb = r / 32, nb = r % 32; transpose_item(FIN(I_WHO) + (size_t)l * 512 * DM, DM, 64 * kb, 32 * nb, (bf16_t*)(F.ws + WS_WH) + (size_t)(32 * nb) * 1024, 1024, scr, F.lane, 1.0f / 255.0f); continue; } r -= I_C2;
        if (r < I_C2) { const int kb = r / 32, nb = r % 32; transpose_item(FIN(I_WLO) + (size_t)l * 512 * DM, DM, 64 * kb, 32 * nb, (bf16_t*)(F.ws + WS_WH) + (size_t)(32 * nb) * 1024 + 512, 1024, scr, F.lane, 1.0f / 255.0f); continue; } r -= I_C2;
        { const int kb = r / 32, nb = r % 32; transpose_item(FIN(I_WOUT) + (size_t)l * DM * DM, DM, 64 * kb, 32 * nb, (bf16_t*)(F.ws + WS_WO) + (size_t)(32 * nb) * DM, DM, scr, F.lane); }
    }
}
__device__ __forceinline__ bool exp_wave(const Frame& F, int l, int& j, int& pw) {
    const int first = (l == DEPTH - 1 || F.G <= 64) ? 0 : 64;
    j = (F.bid - first) * 8 + F.wave; pw = (F.G - first) * 8; return F.bid >= first; }
__device__ __forceinline__ void p_weights_exp13(const Frame& F, int l) {
    int j, pw; if (!exp_wave(F, l, j, pw)) return;
    int par = 0;
    for (int it = j >> 3; it < 2 * NE * 32; it += (pw >> 3), par ^= 1) {
        const int which = it / (NE * 32), e = (it / 32) % NE, nb = it % 32, n0 = 32 * nb, drow = 256 * (n0 >> 7) + 128 * which + (n0 & 127);
        quant_item_wg(F, FIN(which ? I_EW3 : I_EW1) + ((size_t)l * NE + e) * DM * DM, DM, n0, (signed char*)(F.ws + WS_W13) + ((size_t)e * 2048 + drow) * DM, (float*)(F.ws + WS_SW13) + (size_t)e * 2048 + drow, par); }
    __syncthreads();
}
__device__ __forceinline__ void p_weights_exp2(const Frame& F, int l) {
    LAS float* scr = (LAS float*)(F.lds + F.wave * 16896); int j, pw; if (!exp_wave(F, l, j, pw)) return;
    for (int r = j; r < NE * 512; r += pw) { const int e = r / 512, q = r % 512, kb = q / 32, nb = q % 32;
        transpose_item(FIN(I_EW2) + ((size_t)l * NE + e) * DM * DM, DM, 64 * kb, 32 * nb, (bf16_t*)(F.ws + WS_W2) + ((size_t)e * DM + 32 * nb) * DM, DM, scr, F.lane); }
}


template <bool ROUTE, bool COMBINE>
__device__ __forceinline__ void p_norm(const Frame& F, int l, int chunk, const float* gain, int part_shift, int part_scale, bf16_t* U, float* AFF, int lc = 0, const int* INV = nullptr, const bf16_t* YS = nullptr, const float* xsrc = nullptr, const float* csrc = nullptr, const bf16_t* DLT = nullptr, bool dlt_skip_ctx = false, signed char* UQ = nullptr, float* SU = nullptr) {
    bf16_t* HB = (bf16_t*)(F.ws + WS_CH + CH_HRES);
    constexpr int R = ROUTE ? 1 : 2;
    LAS float* rw = (LAS float*)F.lds;
    if (ROUTE) { const float* r = FIN(I_ROUT) + (size_t)l * DM * NE;
        for (int i = F.tid; i < DM * NE; i += 512) { const int col = i >> 4, e = i & 15; rw[e * DM + col] = r[i]; }
        __syncthreads(); }
    const int gw = F.bid * 8 + F.wave, NGW = F.G * 8, lane = F.lane;
    f32x4 gq[4];
#pragma unroll
    for (int j = 0; j < 4; ++j) gq[j] = ((const f32x4*)gain)[lane + 64 * j];
    const bool pf = ROUTE && xsrc == nullptr && DLT != nullptr;
    u32x2 pt[4], pd[4]; f32x4 psh[4], psc[4];
#pragma unroll
    for (int j = 0; j < 4; ++j) { pt[j] = (u32x2){0u, 0u}; pd[j] = (u32x2){0u, 0u}; psh[j] = (f32x4){0.f, 0.f, 0.f, 0.f}; psc[j] = (f32x4){0.f, 0.f, 0.f, 0.f}; }
    if (pf && gw * R < RC) { const u32x2* hb = (const u32x2*)(HB + (size_t)(gw * R) * DM) + lane; const u32x2* dp = (const u32x2*)(DLT + (size_t)(gw * R) * DM) + lane;
        const int mrn = mod_row(chunk, gw * R); const f32x4* shp = (const f32x4*)mod_ptr(F, l, mrn, part_shift) + lane; const f32x4* scp = (const f32x4*)mod_ptr(F, l, mrn, part_scale) + lane;
#pragma unroll
        for (int j = 0; j < 4; ++j) { pt[j] = hb[64 * j]; pd[j] = dp[64 * j]; psh[j] = shp[64 * j]; psc[j] = scp[64 * j]; } }
    const bool pf1 = !ROUTE && COMBINE && xsrc == nullptr;
    u32x2 qt[R][4]; int qx[R];
#pragma unroll
    for (int q = 0; q < R; ++q) { qx[q] = -1;
#pragma unroll
        for (int j = 0; j < 4; ++j) qt[q][j] = (u32x2){0u, 0u}; }
    if (pf1) {
#pragma unroll
        for (int q = 0; q < R; ++q) { const int r = gw * R + q < RC ? gw * R + q : RC - 1; const u32x2* hb = (const u32x2*)(HB + (size_t)r * DM) + lane;
#pragma unroll
            for (int j = 0; j < 4; ++j) qt[q][j] = hb[64 * j];
            qx[q] = INV[(size_t)r * NE + (lane & 15)]; } }
    for (int r0 = gw * R; r0 < RC; r0 += NGW * R) {
        f32x4 v[R][4]; int mr[R];
        u32x2 ct[4], cd[4]; u32x2 c1[R][4]; int cx[R]; f32x4 csh[4], csc[4];
        if (pf1) {
#pragma unroll
            for (int q = 0; q < R; ++q) { cx[q] = qx[q];
#pragma unroll
                for (int j = 0; j < 4; ++j) c1[q][j] = qt[q][j]; } }
        if (pf) {
#pragma unroll
            for (int j = 0; j < 4; ++j) { ct[j] = pt[j]; cd[j] = pd[j]; csh[j] = psh[j]; csc[j] = psc[j]; } }
#pragma unroll
        for (int q = 0; q < R; ++q) { const int r = r0 + q < RC ? r0 + q : RC - 1; mr[q] = mod_row(chunk, r);
            if (xsrc) { const f32x4* hp = (const f32x4*)hrow_src(xsrc, csrc, chunk, r) + lane;
#pragma unroll
                for (int j = 0; j < 4; ++j) v[q][j] = hp[64 * j]; }
            else { const u32x2* hb = (const u32x2*)(HB + (size_t)r * DM) + lane; u32x2 t[4];
                if (pf) {
#pragma unroll
                    for (int j = 0; j < 4; ++j) t[j] = ct[j]; }
                else if (pf1) {
#pragma unroll
                    for (int j = 0; j < 4; ++j) t[j] = c1[q][j]; }
                else {
#pragma unroll
                for (int j = 0; j < 4; ++j) t[j] = hb[64 * j]; }
#pragma unroll
                for (int j = 0; j < 4; ++j) v[q][j] = (f32x4){bflo(t[j].x), bfhi(t[j].x), bflo(t[j].y), bfhi(t[j].y)}; } }
        if (DLT) {
#pragma unroll
            for (int q = 0; q < R; ++q) { const int r = r0 + q; if (r >= RC) break; if (dlt_skip_ctx && mr[q] == 16) continue;
                const u32x2* dp = (const u32x2*)(DLT + (size_t)r * DM) + lane; u32x2 dv[4];
                if (pf) {
#pragma unroll
                    for (int j = 0; j < 4; ++j) dv[j] = cd[j]; }
                else {
#pragma unroll
                for (int j = 0; j < 4; ++j) dv[j] = dp[64 * j]; }
                u32x2* hw = (u32x2*)(HB + (size_t)r * DM) + lane;
#pragma unroll
                for (int j = 0; j < 4; ++j) { v[q][j].x += bflo(dv[j].x); v[q][j].y += bfhi(dv[j].x); v[q][j].z += bflo(dv[j].y); v[q][j].w += bfhi(dv[j].y);
                    u32x2 w; w.x = cvt_pk_bf16_nv(v[q][j].x, v[q][j].y); w.y = cvt_pk_bf16_nv(v[q][j].z, v[q][j].w); hw[64 * j] = w; } }
        }
        if (COMBINE) {
#pragma unroll
            for (int q = 0; q < R; ++q) { const int r = r0 + q; if (r >= RC) break;
                f32x4 acc[4];
#pragma unroll
                for (int j = 0; j < 4; ++j) acc[j] = (f32x4){0.f, 0.f, 0.f, 0.f};
                const int xl = pf1 ? cx[q] : INV[(size_t)r * NE + (lane & 15)];
                unsigned mk = (unsigned)__ballot(xl >= 0) & 0xffffu;
                const bool any = mk != 0u;
                while (mk) {
                    const int e0 = __builtin_ctz(mk); mk &= mk - 1u; const bool two = mk != 0u; const int e1 = two ? __builtin_ctz(mk) : e0; if (two) mk &= mk - 1u;
                    const int x0 = __builtin_amdgcn_readlane(xl, e0), x1 = __builtin_amdgcn_readlane(xl, e1); const float w1 = two ? 1.f : 0.f;
                    const u32x2* y0 = (const u32x2*)(YS + ((size_t)e0 * XROWS + x0) * 1024) + lane; const u32x2* y1 = (const u32x2*)(YS + ((size_t)e1 * XROWS + x1) * 1024) + lane;
                    u32x2 a[4], b[4];
#pragma unroll
                    for (int j = 0; j < 4; ++j) { a[j] = y0[64 * j]; b[j] = y1[64 * j]; }
#pragma unroll
                    for (int j = 0; j < 4; ++j) { acc[j].x += bflo(a[j].x) + w1 * bflo(b[j].x); acc[j].y += bfhi(a[j].x) + w1 * bfhi(b[j].x); acc[j].z += bflo(a[j].y) + w1 * bflo(b[j].y); acc[j].w += bfhi(a[j].y) + w1 * bfhi(b[j].y); }
                }
                if (any) { const f32x4* g2 = (const f32x4*)mod_ptr(F, lc, mr[q], 5) + lane; u32x2* hw = (u32x2*)(HB + (size_t)r * DM) + lane;
#pragma unroll
                    for (int j = 0; j < 4; ++j) { v[q][j] = v[q][j] + g2[64 * j] * acc[j]; u32x2 w; w.x = cvt_pk_bf16_nv(v[q][j].x, v[q][j].y); w.y = cvt_pk_bf16_nv(v[q][j].z, v[q][j].w); hw[64 * j] = w; } }
            }
        }
        float rstd[R]; f32x4 shq[R][4], scq[R][4];
#pragma unroll
        for (int q = 0; q < R; ++q) { float ss = 0.f;
#pragma unroll
            for (int j = 0; j < 4; ++j) ss += (v[q][j].x * v[q][j].x + v[q][j].y * v[q][j].y) + (v[q][j].z * v[q][j].z + v[q][j].w * v[q][j].w);
            rstd[q] = rsqrtf(wave_sum(ss) * (1.f / DM) + NORM_EPS);
            const f32x4* shp = (const f32x4*)mod_ptr(F, l, mr[q], part_shift) + lane; const f32x4* scp = (const f32x4*)mod_ptr(F, l, mr[q], part_scale) + lane;
            if (pf) {
#pragma unroll
                for (int j = 0; j < 4; ++j) { shq[q][j] = csh[j]; scq[q][j] = csc[j]; } }
            else {
#pragma unroll
            for (int j = 0; j < 4; ++j) { shq[q][j] = shp[64 * j]; scq[q][j] = scp[64 * j]; } } }
        if (pf1) { const int rn0 = r0 + NGW * R;
            if (rn0 < RC) {
#pragma unroll
                for (int q = 0; q < R; ++q) { const int r = rn0 + q < RC ? rn0 + q : RC - 1; const u32x2* hb = (const u32x2*)(HB + (size_t)r * DM) + lane;
#pragma unroll
                    for (int j = 0; j < 4; ++j) qt[q][j] = hb[64 * j];
                    qx[q] = INV[(size_t)r * NE + (lane & 15)]; } } }
        if (pf) { const int rn = r0 + NGW * R;
            if (rn < RC) { const u32x2* hb = (const u32x2*)(HB + (size_t)rn * DM) + lane; const u32x2* dp = (const u32x2*)(DLT + (size_t)rn * DM) + lane;
                const int mrn = mod_row(chunk, rn); const f32x4* shp = (const f32x4*)mod_ptr(F, l, mrn, part_shift) + lane; const f32x4* scp = (const f32x4*)mod_ptr(F, l, mrn, part_scale) + lane;
#pragma unroll
                for (int j = 0; j < 4; ++j) { pt[j] = hb[64 * j]; pd[j] = dp[64 * j]; psh[j] = shp[64 * j]; psc[j] = scp[64 * j]; } } }
        asm volatile("" ::: "memory");
        float lg[ROUTE ? R : 1][16]; f32x2 lgp[ROUTE ? R : 1][16];
        unsigned rwo = 0u; if (ROUTE) asm volatile("" : "+v"(rwo));
        if (ROUTE) {
#pragma unroll
            for (int q = 0; q < R; ++q)
#pragma unroll
                for (int e = 0; e < 16; ++e) { lg[q][e] = 0.f; lgp[q][e] = (f32x2){0.f, 0.f}; } }
        float qinv[R]; const bool qout = UQ != nullptr;
        if (qout) {
#pragma unroll
            for (int q = 0; q < R; ++q) { float mx = 0.f;
#pragma unroll
                for (int j = 0; j < 4; ++j) { f32x4 y = v[q][j] * rstd[q] * gq[j]; y = y * (scq[q][j] + 1.0f) + shq[q][j]; mx = fmaxf(mx, fmaxf(fmaxf(fabsf(y.x), fabsf(y.y)), fmaxf(fabsf(y.z), fabsf(y.w)))); }
                mx = fmaxf(mx, dpp_f<0xB1>(mx)); mx = fmaxf(mx, dpp_f<0x4E>(mx)); mx = fmaxf(mx, dpp_f<0x141>(mx)); mx = fmaxf(mx, dpp_f<0x140>(mx));
                mx = fmaxf(mx, __shfl_xor(mx, 16)); mx = fmaxf(mx, __shfl_xor(mx, 32));
                qinv[q] = mx > 0.f ? 127.0f / mx : 0.f;
                if (lane == 0 && r0 + q < RC) SU[r0 + q] = mx * (1.0f / 127.0f); } }
#pragma unroll
        for (int j = 0; j < 4; ++j) { f32x4 y[R];
#pragma unroll
            for (int q = 0; q < R; ++q) { y[q] = v[q][j] * rstd[q] * gq[j]; y[q] = y[q] * (scq[q][j] + 1.0f) + shq[q][j];
                if (r0 + q < RC) {
                    if (U) { u32x2 w; w.x = cvt_pk_bf16_nv(y[q].x, y[q].y); w.y = cvt_pk_bf16_nv(y[q].z, y[q].w); ((u32x2*)(U + (size_t)(r0 + q) * DM))[lane + 64 * j] = w; }
                    if (qout) { const int a0 = (int)rintf(y[q].x * qinv[q]), a1 = (int)rintf(y[q].y * qinv[q]), a2 = (int)rintf(y[q].z * qinv[q]), a3 = (int)rintf(y[q].w * qinv[q]);
                        ((unsigned*)(UQ + (size_t)(r0 + q) * DM))[lane + 64 * j] = (unsigned)(a0 & 255) | ((unsigned)(a1 & 255) << 8) | ((unsigned)(a2 & 255) << 16) | ((unsigned)(a3 & 255) << 24); }
                } }
            if (ROUTE) {
#pragma unroll
                for (int e = 0; e < 16; ++e) { const f32x4 wv = *(const LAS f32x4*)(rw + rwo + e * DM + 256 * j + 4 * lane);
#pragma unroll
                    for (int q = 0; q < R; ++q) { lgp[q][e] = __builtin_elementwise_fma((f32x2){y[q].x, y[q].y}, (f32x2){wv.x, wv.y}, lgp[q][e]); lgp[q][e] = __builtin_elementwise_fma((f32x2){y[q].z, y[q].w}, (f32x2){wv.z, wv.w}, lgp[q][e]); }
                    if ((e & 7) == 7) asm volatile("" ::: "memory"); } } }
        if (ROUTE) {
#pragma unroll
            for (int q = 0; q < R; ++q)
#pragma unroll
                for (int e = 0; e < 16; ++e) lg[q][e] = lgp[q][e].x + lgp[q][e].y;
#pragma unroll
            for (int q = 0; q < R; ++q) {
                float t8[8], t4[4], t2[2], t1;
                { const bool up = (lane & 32) != 0;
#pragma unroll
                  for (int k = 0; k < 8; ++k) { const float send = up ? lg[q][k] : lg[q][k + 8], keep = up ? lg[q][k + 8] : lg[q][k]; t8[k] = keep + __shfl_xor(send, 32); } }
                { const bool up = (lane & 16) != 0;
#pragma unroll
                  for (int k = 0; k < 4; ++k) { const float send = up ? t8[k] : t8[k + 4], keep = up ? t8[k + 4] : t8[k]; t4[k] = keep + __shfl_xor(send, 16); } }
                { const bool up = (lane & 8) != 0;
#pragma unroll
                  for (int k = 0; k < 2; ++k) { const float send = up ? t4[k] : t4[k + 2], keep = up ? t4[k + 2] : t4[k]; t2[k] = keep + __shfl_xor(send, 8); } }
                { const bool up = (lane & 4) != 0; const float send = up ? t2[0] : t2[1], keep = up ? t2[1] : t2[0]; t1 = keep + __shfl_xor(send, 4); }
                t1 += __shfl_xor(t1, 2); t1 += __shfl_xor(t1, 1);
                float mx = t1; mx = fmaxf(mx, __shfl_xor(mx, 4)); mx = fmaxf(mx, __shfl_xor(mx, 8)); mx = fmaxf(mx, __shfl_xor(mx, 16)); mx = fmaxf(mx, __shfl_xor(mx, 32));
                const float ex = __expf(t1 - mx); float den = ex; den += __shfl_xor(den, 4); den += __shfl_xor(den, 8); den += __shfl_xor(den, 16); den += __shfl_xor(den, 32);
                const int e = ((lane >> 5) & 1) * 8 + ((lane >> 4) & 1) * 4 + ((lane >> 3) & 1) * 2 + ((lane >> 2) & 1);
                if ((lane & 3) == 0 && r0 + q < RC) AFF[(size_t)(r0 + q) * NE + e] = ex * __builtin_amdgcn_rcpf(den);
            }
        }
    }
    if (ROUTE) __syncthreads();
}

__device__ __forceinline__ int win_tile(int t, int sel) { return sel == 1 ? (t < 6 ? t : t + 6) : sel == 2 ? (t < 6 ? t + 6 : t + 8) : t; }
struct GemmPlain { static constexpr int NSEG = 1; const bf16_t* A; const bf16_t* Bt; int K; int tsel = 0; static constexpr bool GATHER = false; static constexpr int ESZ = 2;
    __device__ __forceinline__ const char* a_tile(const pg8::Unit& u) const { return (const char*)A + (size_t)u.pm * 256 * K * 2; }
    __device__ __forceinline__ const char* b_tile(const pg8::Unit& u) const { return (const char*)Bt + (size_t)win_tile(u.pn, tsel) * 256 * K * 2; } };
constexpr int XPAN = XROWS / 256;
struct GemmExpert { static constexpr int NSEG = 1; const bf16_t* A; const bf16_t* Bt; int K; int nrows_b; static constexpr bool GATHER = false; static constexpr int ESZ = 2;
    __device__ __forceinline__ const char* a_tile(const pg8::Unit& u) const { return (const char*)A + (size_t)u.pm * 256 * K * 2; }
    __device__ __forceinline__ const char* b_tile(const pg8::Unit& u) const { const int e = u.pm / XPAN; return (const char*)Bt + ((size_t)e * nrows_b + (size_t)u.pn * 256) * K * 2; } };
struct GemmExpertGather { static constexpr int NSEG = 1; const bf16_t* A; const int* rowsrc; const bf16_t* Bt; int K; int nrows_b; static constexpr bool GATHER = true; static constexpr int ESZ = 2;
    __device__ __forceinline__ const char* a_tile(const pg8::Unit&) const { return (const char*)A; }
    __device__ __forceinline__ int a_row(const pg8::Unit& u, int r) const { return rowsrc[u.pm * 256 + r]; }
    __device__ __forceinline__ const char* b_tile(const pg8::Unit& u) const { const int e = u.pm / XPAN; return (const char*)Bt + ((size_t)e * nrows_b + (size_t)u.pn * 256) * K * 2; } };

struct GemmPlainQ { static constexpr int NSEG = 1; const signed char* A; const signed char* Bt; int K; int tsel = 0; static constexpr bool GATHER = false; static constexpr int ESZ = 1;
    __device__ __forceinline__ const char* a_tile(const pg8::Unit& u) const { return (const char*)A + (size_t)u.pm * 256 * K; }
    __device__ __forceinline__ const char* b_tile(const pg8::Unit& u) const { return (const char*)Bt + (size_t)win_tile(u.pn, tsel) * 256 * K; } };
struct GemmExpertGatherQ { static constexpr int NSEG = 1; const signed char* A; const int* rowsrc; const signed char* Bt; int K; int nrows_b; static constexpr bool GATHER = true; static constexpr int ESZ = 1;
    __device__ __forceinline__ const char* a_tile(const pg8::Unit&) const { return (const char*)A; }
    __device__ __forceinline__ int a_row(const pg8::Unit& u, int r) const { return rowsrc[u.pm * 256 + r]; }
    __device__ __forceinline__ const char* b_tile(const pg8::Unit& u) const { const int e = u.pm / XPAN; return (const char*)Bt + ((size_t)e * nrows_b + (size_t)u.pn * 256) * K; } };

struct EpiIn {
    static constexpr bool PERM = true, AFTER_DRAIN = false;
    unsigned char* ch; int pn_off; const float* su; const float* sw; int tsel = 0;
    __device__ __forceinline__ void operator()(const f32x4 (&acc)[2][2][4][2], const pg8::Unit& u, int wr, int wc, int fr, int fq) const {
        const int pn = win_tile(u.pn, tsel) + pn_off; bf16_t* base; int ld, ct, act = 0;
        if (pn < 4) { base = (bf16_t*)(ch + CH_Q); ld = 1024; ct = pn; }
        else if (pn == 4) { base = (bf16_t*)(ch + CH_K); ld = 256; ct = 0; }
        else if (pn == 5) { base = (bf16_t*)(ch + CH_V); ld = 256; ct = 0; }
        else if (pn < 12) { base = (bf16_t*)(ch + CH_HY); ld = 1536; ct = pn - 6; }
        else if (pn < 14) { base = (bf16_t*)(ch + CH_RX); ld = 512; ct = pn - 12; }
        else if (pn < 16) { base = (bf16_t*)(ch + CH_RG); ld = 512; ct = pn - 14; act = 1; }
        else { base = (bf16_t*)(ch + CH_GATE); ld = 3072; ct = pn - 16; act = 2; }
        const f32x4 one4 = {1.f, 1.f, 1.f, 1.f}; f32x4 sw0a = one4, sw0b = one4, sw1a = one4, sw1b = one4; float sxr[2][4];
        if (su) { const float* swp = sw + pn * 256 + wc * 32 + 8 * fq; sw0a = *(const f32x4*)swp; sw0b = *(const f32x4*)(swp + 4); sw1a = *(const f32x4*)(swp + 128); sw1b = *(const f32x4*)(swp + 132); }
#pragma unroll
        for (int ai = 0; ai < 2; ++ai)
#pragma unroll
            for (int m = 0; m < 4; ++m) sxr[ai][m] = su ? su[u.pm * 256 + wr * 64 + fr + ai * 128 + m * 16] : 1.f;
        const bool tiled = pn >= 16;
        const int etid = ((wr * 4 + wc) * 64) + fq * 16 + fr;
        int rl = wr * 64 + fr, cl = wc * 32 + 8 * fq; asm volatile("" : "+v"(rl), "+v"(cl));
        const int row0 = u.pm * 256 + rl, col0 = ct * 256 + cl;
#pragma unroll
        for (int ai = 0; ai < 2; ++ai)
#pragma unroll
            for (int m = 0; m < 4; ++m) { bf16_t* rowp = base + (size_t)(row0 + ai * 128 + m * 16) * ld + col0; u32x4 gpk = {0u, 0u, 0u, 0u};
#pragma unroll
                for (int bj = 0; bj < 2; ++bj) { f32x4 v0 = acc[ai][bj][m][0] * (bj ? sw1a : sw0a) * sxr[ai][m], v1 = acc[ai][bj][m][1] * (bj ? sw1b : sw0b) * sxr[ai][m];
                    if (act == 1) {
#pragma unroll
                        for (int j = 0; j < 4; ++j) { v0[j] = gelu_tanh_f(v0[j]); v1[j] = gelu_tanh_f(v1[j]); } }
                    else if (act == 2) {
#pragma unroll
                        for (int j = 0; j < 4; ++j) { v0[j] = sigmoid_f(v0[j]); v1[j] = sigmoid_f(v1[j]); } }
                    if (tiled) { unsigned lo = 0u, hi = 0u;
#pragma unroll
                        for (int j = 0; j < 4; ++j) { lo |= (unsigned)fmaxf(fmaf(255.0f, v0[j], 0.5f), 1.0f) << (8 * j); hi |= (unsigned)fmaxf(fmaf(255.0f, v1[j], 0.5f), 1.0f) << (8 * j); }
                        if (bj == 0) { gpk.x = lo; gpk.y = hi; } else { gpk.z = lo; gpk.w = hi; } }
                    else { u32x4 w; w.x = cvt_pk_bf16_nv(v0[0], v0[1]); w.y = cvt_pk_bf16_nv(v0[2], v0[3]); w.z = cvt_pk_bf16_nv(v1[0], v1[1]); w.w = cvt_pk_bf16_nv(v1[2], v1[3]);
                        *(u32x4*)(rowp + bj * 128) = w; } }
                if (tiled) *(u32x4*)((unsigned char*)base + ((((size_t)(u.pm * 12 + ct) * 8 + (ai * 4 + m)) * 512 + etid) << 4)) = gpk; }
    }
};
struct EpiPlain {
    static constexpr bool PERM = true, AFTER_DRAIN = false;
    bf16_t* O;
    __device__ __forceinline__ void operator()(const f32x4 (&acc)[2][2][4][2], const pg8::Unit& u, int wr, int wc, int fr, int fq) const {
        int rl = wr * 64 + fr, cl = wc * 32 + 8 * fq; asm volatile("" : "+v"(rl), "+v"(cl));
        const int row0 = u.pm * 256 + rl, col0 = u.pn * 256 + cl;
#pragma unroll
        for (int ai = 0; ai < 2; ++ai)
#pragma unroll
            for (int m = 0; m < 4; ++m)
#pragma unroll
                for (int bj = 0; bj < 2; ++bj) { const f32x4 v0 = acc[ai][bj][m][0], v1 = acc[ai][bj][m][1];
                    u32x4 w; w.x = cvt_pk_bf16_nv(v0[0], v0[1]); w.y = cvt_pk_bf16_nv(v0[2], v0[3]); w.z = cvt_pk_bf16_nv(v1[0], v1[1]); w.w = cvt_pk_bf16_nv(v1[2], v1[3]);
                    *(u32x4*)(O + (size_t)(row0 + ai * 128 + m * 16) * 1024 + col0 + bj * 128) = w; }
    }
};
template <bool ACCUM, bool FINAL> struct EpiMerge {
    static constexpr bool PERM = true, AFTER_DRAIN = false;
    bf16_t* Y; bf16_t* Yt; const unsigned char* gate; int sub;
    __device__ __forceinline__ void operator()(const f32x4 (&acc)[2][2][4][2], const pg8::Unit& u, int wr, int wc, int fr, int fq) const {
        int rl = wr * 64 + fr, cl = wc * 32 + 8 * fq, et = ((wr * 4 + wc) * 64) + fq * 16 + fr; asm volatile("" : "+v"(rl), "+v"(cl), "+v"(et));
        const int row0 = u.pm * 256 + rl, col0 = u.pn * 256 + cl;
        const unsigned char* gt = gate + (((size_t)(u.pm * 12 + 4 * sub + u.pn) * 8 * 512 + et) << 4); bf16_t* yt = Yt + (((size_t)(u.pm * 4 + u.pn) * 16 * 512 + et) << 3);
#pragma unroll
        for (int ai = 0; ai < 2; ++ai) {
            u32x4 gv[4], yv[4][2];
#pragma unroll
            for (int m = 0; m < 4; ++m) { gv[m] = *(const u32x4*)(gt + ((size_t)(ai * 4 + m) * 512 << 4));
#pragma unroll
                for (int bj = 0; bj < 2; ++bj) { const int k = ai * 8 + m * 2 + bj; if (ACCUM) yv[m][bj] = *(const u32x4*)(yt + ((size_t)k * 512 << 3)); } }
            asm volatile("" ::: "memory");
#pragma unroll
            for (int m = 0; m < 4; ++m)
#pragma unroll
                for (int bj = 0; bj < 2; ++bj) { const int k = ai * 8 + m * 2 + bj; const unsigned g0 = bj ? gv[m].z : gv[m].x, g1 = bj ? gv[m].w : gv[m].y;
                    f32x4 v0 = acc[ai][bj][m][0], v1 = acc[ai][bj][m][1];
                    v0[0] *= (float)(g0 & 255u); v0[1] *= (float)((g0 >> 8) & 255u); v0[2] *= (float)((g0 >> 16) & 255u); v0[3] *= (float)(g0 >> 24);
                    v1[0] *= (float)(g1 & 255u); v1[1] *= (float)((g1 >> 8) & 255u); v1[2] *= (float)((g1 >> 16) & 255u); v1[3] *= (float)(g1 >> 24);
                    if (ACCUM) { const u32x4 o = yv[m][bj]; v0[0] += bflo(o.x); v0[1] += bfhi(o.x); v0[2] += bflo(o.y); v0[3] += bfhi(o.y); v1[0] += bflo(o.z); v1[1] += bfhi(o.z); v1[2] += bflo(o.w); v1[3] += bfhi(o.w); }
                    u32x4 w; w.x = cvt_pk_bf16_nv(v0[0], v0[1]); w.y = cvt_pk_bf16_nv(v0[2], v0[3]); w.z = cvt_pk_bf16_nv(v1[0], v1[1]); w.w = cvt_pk_bf16_nv(v1[2], v1[3]);
                    if (FINAL) *(u32x4*)(Y + (size_t)(row0 + ai * 128 + m * 16) * 1024 + col0 + bj * 128) = w; else *(u32x4*)(yt + ((size_t)k * 512 << 3)) = w; }
            asm volatile("" ::: "memory");
        }
    }
};
struct GemmMerge { const bf16_t* A; const bf16_t* Bt; const bf16_t* A2; const bf16_t* Bt2; int K; static constexpr bool GATHER = false; static constexpr int ESZ = 2; static constexpr int NSEG = 2;
    __device__ __forceinline__ const char* a_tile(const pg8::Unit& u) const { return (const char*)A + (size_t)u.pm * 256 * K * 2; }
    __device__ __forceinline__ const char* b_tile(const pg8::Unit& u) const { return (const char*)Bt + (size_t)u.pn * 256 * K * 2; }
    __device__ __forceinline__ long seg_delta_a() const { return (long)((const char*)A2 - (const char*)A); }
    __device__ __forceinline__ long seg_delta_b() const { return (long)((const char*)Bt2 - (const char*)Bt); } };
struct EpiMergeFused {
    static constexpr bool PERM = true, AFTER_DRAIN = false;
    bf16_t* Y; const unsigned char* gate;
    __device__ __forceinline__ void mid(f32x4 (&acc)[2][2][4][2], const pg8::Unit& u, int stage, int wr, int wc, int fr, int fq) const {
        int et = ((wr * 4 + wc) * 64) + fq * 16 + fr; asm volatile("" : "+v"(et));
        const unsigned char* gn = gate + (((size_t)(u.pm * 12 + 4 * stage + u.pn) * 8 * 512 + et) << 4); const unsigned char* gd = gn + ((size_t)4 * 8 * 512 << 4);
        u32x4 nv[2][4], dv[2][4];
#pragma unroll
        for (int ai = 0; ai < 2; ++ai)
#pragma unroll
            for (int m = 0; m < 4; ++m) { nv[ai][m] = *(const u32x4*)(gn + ((size_t)(ai * 4 + m) * 512 << 4)); dv[ai][m] = *(const u32x4*)(gd + ((size_t)(ai * 4 + m) * 512 << 4)); }
        asm volatile("" ::: "memory");
#pragma unroll
        for (int ai = 0; ai < 2; ++ai)
#pragma unroll
            for (int m = 0; m < 4; ++m)
#pragma unroll
                for (int bj = 0; bj < 2; ++bj) { const unsigned n0 = bj ? nv[ai][m].z : nv[ai][m].x, n1 = bj ? nv[ai][m].w : nv[ai][m].y, d0 = bj ? dv[ai][m].z : dv[ai][m].x, d1 = bj ? dv[ai][m].w : dv[ai][m].y;
#pragma unroll
                    for (int j = 0; j < 4; ++j) { acc[ai][bj][m][0][j] *= (float)((n0 >> (8 * j)) & 255u) * __builtin_amdgcn_rcpf((float)((d0 >> (8 * j)) & 255u));
                                                  acc[ai][bj][m][1][j] *= (float)((n1 >> (8 * j)) & 255u) * __builtin_amdgcn_rcpf((float)((d1 >> (8 * j)) & 255u)); }
                    __builtin_amdgcn_sched_barrier(0); }
        asm volatile("" ::: "memory");
    }
    __device__ __forceinline__ void operator()(const f32x4 (&acc)[2][2][4][2], const pg8::Unit& u, int wr, int wc, int fr, int fq) const {
        int rl = wr * 64 + fr, cl = wc * 32 + 8 * fq, et = ((wr * 4 + wc) * 64) + fq * 16 + fr; asm volatile("" : "+v"(rl), "+v"(cl), "+v"(et));
        const int row0 = u.pm * 256 + rl, col0 = u.pn * 256 + cl;
        const unsigned char* gt = gate + (((size_t)(u.pm * 12 + 8 + u.pn) * 8 * 512 + et) << 4);
#pragma unroll
        for (int ai = 0; ai < 2; ++ai) { u32x4 gv[4];
#pragma unroll
            for (int m = 0; m < 4; ++m) gv[m] = *(const u32x4*)(gt + ((size_t)(ai * 4 + m) * 512 << 4));
            asm volatile("" ::: "memory");
#pragma unroll
            for (int m = 0; m < 4; ++m)
#pragma unroll
                for (int bj = 0; bj < 2; ++bj) { const unsigned g0 = bj ? gv[m].z : gv[m].x, g1 = bj ? gv[m].w : gv[m].y;
                    f32x4 v0 = acc[ai][bj][m][0], v1 = acc[ai][bj][m][1];
                    v0[0] *= (float)(g0 & 255u); v0[1] *= (float)((g0 >> 8) & 255u); v0[2] *= (float)((g0 >> 16) & 255u); v0[3] *= (float)(g0 >> 24);
                    v1[0] *= (float)(g1 & 255u); v1[1] *= (float)((g1 >> 8) & 255u); v1[2] *= (float)((g1 >> 16) & 255u); v1[3] *= (float)(g1 >> 24);
                    u32x4 w; w.x = cvt_pk_bf16_nv(v0[0], v0[1]); w.y = cvt_pk_bf16_nv(v0[2], v0[3]); w.z = cvt_pk_bf16_nv(v1[0], v1[1]); w.w = cvt_pk_bf16_nv(v1[2], v1[3]);
                    *(u32x4*)(Y + (size_t)(row0 + ai * 128 + m * 16) * 1024 + col0 + bj * 128) = w; }
            asm volatile("" ::: "memory");
        }
    }
};
struct EpiDelta {
    static constexpr bool PERM = true, AFTER_DRAIN = false;
    bf16_t* DLT; const float* modl; int chunk;
    __device__ __forceinline__ void operator()(const f32x4 (&acc)[2][2][4][2], const pg8::Unit& u, int wr, int wc, int fr, int fq) const {
        const int bl = u.pm / 17, p = u.pm - bl * 17, b = chunk * BC + bl;
        const float* g1 = modl + ((size_t)(p == 0 ? 16 : b) * 6 + 2) * DM;
        int rl = wr * 64 + fr, cl = wc * 32 + 8 * fq; asm volatile("" : "+v"(rl), "+v"(cl));
        const int row0 = u.pm * 256 + rl, col0 = u.pn * 256 + cl;
        f32x4 gv[2][2];
#pragma unroll
        for (int bj = 0; bj < 2; ++bj)
#pragma unroll
            for (int n = 0; n < 2; ++n) gv[bj][n] = *(const f32x4*)(g1 + col0 + bj * 128 + 4 * n);
#pragma unroll
        for (int ai = 0; ai < 2; ++ai)
#pragma unroll
            for (int m = 0; m < 4; ++m) { bf16_t* rowp = DLT + (size_t)(row0 + ai * 128 + m * 16) * 1024 + col0;
#pragma unroll
                for (int bj = 0; bj < 2; ++bj) { const f32x4 v0 = acc[ai][bj][m][0] * gv[bj][0], v1 = acc[ai][bj][m][1] * gv[bj][1];
                    u32x4 w; w.x = cvt_pk_bf16_nv(v0[0], v0[1]); w.y = cvt_pk_bf16_nv(v0[2], v0[3]); w.z = cvt_pk_bf16_nv(v1[0], v1[1]); w.w = cvt_pk_bf16_nv(v1[2], v1[3]);
                    *(u32x4*)(rowp + bj * 128) = w; } }
    }
};
struct EpiResid {
    static constexpr bool PERM = false, AFTER_DRAIN = false;
    float* out; float* hc; const float* modl; int chunk; const float* rin; const float* rinc;
    __device__ __forceinline__ void operator()(const f32x4 (&acc)[2][2][4][2], const pg8::Unit& u, int wr, int wc, int fr, int fq) const {
        const int bl = u.pm / 17, p = u.pm - bl * 17, b = chunk * BC + bl;
        float* tb = p == 0 ? hc + ((size_t)(b * CTX) << 10) : out + ((size_t)(b * SEQ + (p - 1) * 256) << 10);
        const float* tr = p == 0 ? rinc + ((size_t)(b * CTX) << 10) : rin + ((size_t)(b * SEQ + (p - 1) * 256) << 10);
        const float* g1 = modl + ((size_t)(p == 0 ? 16 : b) * 6 + 2) * DM;
        int rl = wr * 64 + fr, cl = wc * 32 + 4 * fq; asm volatile("" : "+v"(rl), "+v"(cl));
        const int row0 = rl, col0 = u.pn * 256 + cl;
        f32x4 gv[2][2];
#pragma unroll
        for (int bj = 0; bj < 2; ++bj)
#pragma unroll
            for (int n = 0; n < 2; ++n) gv[bj][n] = *(const f32x4*)(g1 + col0 + bj * 128 + n * 16);
#pragma unroll
        for (int ai = 0; ai < 2; ++ai) {
            f32x4 hv[4][2][2];
#pragma unroll
            for (int m = 0; m < 4; ++m)
#pragma unroll
                for (int bj = 0; bj < 2; ++bj)
#pragma unroll
                    for (int n = 0; n < 2; ++n) hv[m][bj][n] = *(const f32x4*)(tr + (size_t)(row0 + ai * 128 + m * 16) * DM + col0 + bj * 128 + n * 16);
            asm volatile("" ::: "memory");
#pragma unroll
            for (int m = 0; m < 4; ++m)
#pragma unroll
                for (int bj = 0; bj < 2; ++bj)
#pragma unroll
                    for (int n = 0; n < 2; ++n) *(f32x4*)(tb + (size_t)(row0 + ai * 128 + m * 16) * DM + col0 + bj * 128 + n * 16) = hv[m][bj][n] + gv[bj][n] * acc[ai][bj][m][n];
            asm volatile("" ::: "memory");
        }
    }
};
struct EpiSwiglu {
    static constexpr bool PERM = true, AFTER_DRAIN = false;
    bf16_t* HID;
    __device__ __forceinline__ void operator()(const f32x4 (&acc)[2][2][4][2], const pg8::Unit& u, int wr, int wc, int fr, int fq) const {
        int rl = wr * 64 + fr, cl = wc * 32 + 8 * fq; asm volatile("" : "+v"(rl), "+v"(cl));
        const int row0 = u.pm * 256 + rl, col0 = u.pn * 128 + cl;
#pragma unroll
        for (int ai = 0; ai < 2; ++ai)
#pragma unroll
            for (int m = 0; m < 4; ++m) { f32x4 v0, v1;
#pragma unroll
                for (int j = 0; j < 4; ++j) { v0[j] = silu_f(acc[ai][0][m][0][j]) * acc[ai][1][m][0][j]; v1[j] = silu_f(acc[ai][0][m][1][j]) * acc[ai][1][m][1][j]; }
                u32x4 w; w.x = cvt_pk_bf16_nv(v0[0], v0[1]); w.y = cvt_pk_bf16_nv(v0[2], v0[3]); w.z = cvt_pk_bf16_nv(v1[0], v1[1]); w.w = cvt_pk_bf16_nv(v1[2], v1[3]);
                *(u32x4*)(HID + (size_t)(row0 + ai * 128 + m * 16) * 1024 + col0) = w; }
    }
};
struct EpiSwigluQ {
    static constexpr bool PERM = true, AFTER_DRAIN = false;
    bf16_t* HID; const float* xscl; const float* sw13;
    __device__ __forceinline__ void operator()(const f32x4 (&acc)[2][2][4][2], const pg8::Unit& u, int wr, int wc, int fr, int fq) const {
        int rl = wr * 64 + fr, cl = wc * 32 + 8 * fq; asm volatile("" : "+v"(rl), "+v"(cl));
        const int row0 = u.pm * 256 + rl, col0 = u.pn * 128 + cl; const int e = u.pm / XPAN;
        const float* swp = sw13 + (size_t)e * 2048 + u.pn * 256 + cl;
        const f32x4 s1a = *(const f32x4*)swp, s1b = *(const f32x4*)(swp + 4), s3a = *(const f32x4*)(swp + 128), s3b = *(const f32x4*)(swp + 132);
        float sx[2][4];
#pragma unroll
        for (int ai = 0; ai < 2; ++ai)
#pragma unroll
            for (int m = 0; m < 4; ++m) sx[ai][m] = xscl[row0 + ai * 128 + m * 16];
        asm volatile("" ::: "memory");
#pragma unroll
        for (int ai = 0; ai < 2; ++ai)
#pragma unroll
            for (int m = 0; m < 4; ++m) { const float s = sx[ai][m]; f32x4 v0, v1;
#pragma unroll
                for (int j = 0; j < 4; ++j) { v0[j] = silu_f(acc[ai][0][m][0][j] * (s * s1a[j])) * (acc[ai][1][m][0][j] * (s * s3a[j])); v1[j] = silu_f(acc[ai][0][m][1][j] * (s * s1b[j])) * (acc[ai][1][m][1][j] * (s * s3b[j])); }
                u32x4 w; w.x = cvt_pk_bf16_nv(v0[0], v0[1]); w.y = cvt_pk_bf16_nv(v0[2], v0[3]); w.z = cvt_pk_bf16_nv(v1[0], v1[1]); w.w = cvt_pk_bf16_nv(v1[2], v1[3]);
                *(u32x4*)(HID + (size_t)(row0 + ai * 128 + m * 16) * 1024 + col0) = w; }
    }
};
struct EpiDown {
    static constexpr bool PERM = true, AFTER_DRAIN = false;
    bf16_t* YS; const float* gatev;
    __device__ __forceinline__ void operator()(const f32x4 (&acc)[2][2][4][2], const pg8::Unit& u, int wr, int wc, int fr, int fq) const {
        int rl = wr * 64 + fr, cl = wc * 32 + 8 * fq; asm volatile("" : "+v"(rl), "+v"(cl));
        const int row0 = u.pm * 256 + rl, col0 = u.pn * 256 + cl;
        float gq[2][4];
#pragma unroll
        for (int ai = 0; ai < 2; ++ai)
#pragma unroll
            for (int m = 0; m < 4; ++m) gq[ai][m] = gatev[row0 + ai * 128 + m * 16];
        asm volatile("" ::: "memory");
#pragma unroll
        for (int ai = 0; ai < 2; ++ai)
#pragma unroll
            for (int m = 0; m < 4; ++m) { const int row = row0 + ai * 128 + m * 16; const float g = gq[ai][m];
#pragma unroll
                for (int bj = 0; bj < 2; ++bj) { const f32x4 v0 = acc[ai][bj][m][0] * g, v1 = acc[ai][bj][m][1] * g;
                    u32x4 w; w.x = cvt_pk_bf16_nv(v0[0], v0[1]); w.y = cvt_pk_bf16_nv(v0[2], v0[3]); w.z = cvt_pk_bf16_nv(v1[0], v1[1]); w.w = cvt_pk_bf16_nv(v1[2], v1[3]);
                    *(u32x4*)(YS + (size_t)row * 1024 + col0 + bj * 128) = w; } }
    }
};

__device__ __forceinline__ u32x4 qk_head8(u32x4 raw, const float (&g)[8], const float (&cs)[8], const float (&sn)[8], bool second) {
    float x[8] = {bflo(raw.x), bfhi(raw.x), bflo(raw.y), bfhi(raw.y), bflo(raw.z), bfhi(raw.z), bflo(raw.w), bfhi(raw.w)};
    float ss = 0.f;
#pragma unroll
    for (int k = 0; k < 8; ++k) ss = fmaf(x[k], x[k], ss);
    ss = row16_sum(ss);
    const float rms = rsqrtf(ss * (1.f / 128.f) + NORM_EPS);
    float o[8];
#pragma unroll
    for (int k = 0; k < 8; ++k) { const float y = x[k] * rms * g[k], pr = row16_xor8(y); o[k] = second ? fmaf(pr, sn[k], y * cs[k]) : fmaf(-pr, sn[k], y * cs[k]); }
    u32x4 w; w.x = cvt_pk_bf16_nv(o[0], o[1]); w.y = cvt_pk_bf16_nv(o[2], o[3]); w.z = cvt_pk_bf16_nv(o[4], o[5]); w.w = cvt_pk_bf16_nv(o[6], o[7]); return w;
}
__device__ __forceinline__ void p_qknorm(const Frame& F, int l, unsigned char* ch) {
    const int gw = F.bid * 8 + F.wave, NGW = F.G * 8, lane = F.lane, rsel = lane >> 5, hk = (lane >> 4) & 1, l16 = lane & 15, pi = (l16 & 7) * 8; const bool second = l16 >= 8;
    const float* ropc = (const float*)(F.ws + WS_ROPE); const float* rops = ropc + SEQ * 64;
    float gk[8];
    { const float* kg = FIN(I_KNG) + l * 128 + (second ? 64 : 0) + pi;
#pragma unroll
      for (int k = 0; k < 8; ++k) gk[k] = kg[k]; }
    for (int r0 = gw * 2; r0 < RC; r0 += 4 * NGW) {
        const int ra = r0 + rsel, rbq = r0 + 2 * NGW + rsel; const bool twob = r0 + 2 * NGW < RC; const int rb = twob ? rbq : ra;
        bf16_t* kpa = (bf16_t*)(ch + CH_K) + (size_t)ra * 256 + hk * 128 + l16 * 8; bf16_t* kpb = (bf16_t*)(ch + CH_K) + (size_t)rb * 256 + hk * 128 + l16 * 8;
        const u32x4 a2 = *(const u32x4*)kpa, b2 = *(const u32x4*)kpb;
        const int posa = ra % TOK, posb = rb % TOK; float csa[8], sna[8], csb[8], snb[8];
#pragma unroll
        for (int k = 0; k < 8; ++k) { csa[k] = 1.f; sna[k] = 0.f; csb[k] = 1.f; snb[k] = 0.f; }
        if (posa >= CTX) { const f32x4* cp = (const f32x4*)(ropc + (size_t)(posa - CTX) * 64 + pi); const f32x4* sp = (const f32x4*)(rops + (size_t)(posa - CTX) * 64 + pi);
            const f32x4 c0 = cp[0], c1 = cp[1], s0 = sp[0], s1 = sp[1];
            csa[0] = c0.x; csa[1] = c0.y; csa[2] = c0.z; csa[3] = c0.w; csa[4] = c1.x; csa[5] = c1.y; csa[6] = c1.z; csa[7] = c1.w;
            sna[0] = s0.x; sna[1] = s0.y; sna[2] = s0.z; sna[3] = s0.w; sna[4] = s1.x; sna[5] = s1.y; sna[6] = s1.z; sna[7] = s1.w; }
        if (posb >= CTX) { const f32x4* cp = (const f32x4*)(ropc + (size_t)(posb - CTX) * 64 + pi); const f32x4* sp = (const f32x4*)(rops + (size_t)(posb - CTX) * 64 + pi);
            const f32x4 c0 = cp[0], c1 = cp[1], s0 = sp[0], s1 = sp[1];
            csb[0] = c0.x; csb[1] = c0.y; csb[2] = c0.z; csb[3] = c0.w; csb[4] = c1.x; csb[5] = c1.y; csb[6] = c1.z; csb[7] = c1.w;
            snb[0] = s0.x; snb[1] = s0.y; snb[2] = s0.z; snb[3] = s0.w; snb[4] = s1.x; snb[5] = s1.y; snb[6] = s1.z; snb[7] = s1.w; }
        asm volatile("" ::: "memory");
        const u32x4 wa2 = qk_head8(a2, gk, csa, sna, second), wb2 = qk_head8(b2, gk, csb, snb, second);
        *(u32x4*)kpa = wa2; if (twob) *(u32x4*)kpb = wb2;
    }
}
struct Rows3 { u32x4 a, b, c; };
__device__ __forceinline__ Rows3 conv3_load(const bf16_t* hy, size_t rowoff, int ch0, bool hasl, bool hasr) {
    const u32x4 z = {0u, 0u, 0u, 0u}; Rows3 r;
    r.a = hasl ? *(const u32x4*)(hy + rowoff - 1536 + ch0) : z; r.b = *(const u32x4*)(hy + rowoff + ch0); r.c = hasr ? *(const u32x4*)(hy + rowoff + 1536 + ch0) : z; return r;
}
__device__ __forceinline__ void conv3_calc(const Rows3& r, const LAS float* WT, int cl, float (&o)[8]) {
    const unsigned aw[4] = {r.a.x, r.a.y, r.a.z, r.a.w}, bw[4] = {r.b.x, r.b.y, r.b.z, r.b.w}, cw[4] = {r.c.x, r.c.y, r.c.z, r.c.w};
    const LAS f32x4* w0 = (const LAS f32x4*)(WT + cl); const LAS f32x4* w1 = (const LAS f32x4*)(WT + 128 + cl); const LAS f32x4* w2 = (const LAS f32x4*)(WT + 256 + cl); const LAS f32x4* b4 = (const LAS f32x4*)(WT + 384 + cl);
#pragma unroll
    for (int h = 0; h < 2; ++h) { const f32x4 wa = w0[h], wb = w1[h], wc = w2[h], bv = b4[h];
#pragma unroll
        for (int q = 0; q < 2; ++q) { const int j = 2 * h + q;
            o[2 * j] = bv[2 * q] + wa[2 * q] * bflo(aw[j]) + wb[2 * q] * bflo(bw[j]) + wc[2 * q] * bflo(cw[j]);
            o[2 * j + 1] = bv[2 * q + 1] + wa[2 * q + 1] * bfhi(aw[j]) + wb[2 * q + 1] * bfhi(bw[j]) + wc[2 * q + 1] * bfhi(cw[j]); } }
}
__device__ __forceinline__ void p_hyena_pre(const Frame& F, int l, unsigned char* ch) {
    const bf16_t* hy = (const bf16_t*)(ch + CH_HY); bf16_t* X0 = (bf16_t*)(ch + CH_X0); bf16_t* PT = (bf16_t*)(ch + CH_P);
    const float* w = FIN(I_HYCW) + (size_t)l * 3 * 1536; const float* bb = FIN(I_HYCB) + l * 1536;
    LAS bf16_t* T = (LAS bf16_t*)F.lds;
    LAS float* WT = (LAS float*)(F.lds + 32768);
    const int rr = F.tid >> 3, cs = F.tid & 7, cc = F.tid >> 2, pc = F.tid & 3;
    int cb_loaded = -1;
    for (int u = F.bid; u < (RC / 64) * 4; u += F.G) {
        const int rb = u >> 2, cb = u & 3, r = rb * 64 + rr, pos = r % TOK, c0 = cb * 128 + cs * 16;
        if (cb != cb_loaded) { __syncthreads();
            for (int i = F.tid; i < 3 * 4 * 128; i += 512) { const int gq = i / 512, j = (i >> 7) & 3, c = i & 127, chn = gq * 512 + cb * 128 + c; WT[i] = j < 3 ? w[j * 1536 + chn] : bb[chn]; }
            cb_loaded = cb; }
        const bool hasl = pos != 0 && pos != CTX, hasr = pos != CTX - 1 && pos != TOK - 1;
        __syncthreads();
        Rows3 ld[2][3];
#pragma unroll
        for (int h = 0; h < 2; ++h)
#pragma unroll
            for (int gq = 0; gq < 3; ++gq) ld[h][gq] = conv3_load(hy, (size_t)r * 1536, gq * 512 + c0 + 8 * h, hasl, hasr);
        asm volatile("" ::: "memory");
#pragma unroll
        for (int h = 0; h < 2; ++h) { const int c8 = c0 + 8 * h, cl = cs * 16 + 8 * h; float x0[8], x1[8], v[8];
            conv3_calc(ld[h][0], WT, cl, x0); conv3_calc(ld[h][1], WT + 512, cl, x1); conv3_calc(ld[h][2], WT + 1024, cl, v);
            u32x4 a; a.x = cvt_pk_bf16_nv(x0[0], x0[1]); a.y = cvt_pk_bf16_nv(x0[2], x0[3]); a.z = cvt_pk_bf16_nv(x0[4], x0[5]); a.w = cvt_pk_bf16_nv(x0[6], x0[7]);
            *(u32x4*)(X0 + (size_t)r * 512 + c8) = a;
#pragma unroll
            for (int k = 0; k < 8; ++k) T[(cs * 16 + 8 * h + k) * 72 + rr] = f2bf(v[k] * x1[k]);
            asm volatile("" ::: "memory"); }
        __syncthreads();
        const int r0 = rb * 64, bl = r0 / TOK, pos0 = r0 - bl * TOK, c = cb * 128 + cc;
        const u32x4 t0 = *(const LAS u32x4*)(T + cc * 72 + 16 * pc), t1 = *(const LAS u32x4*)(T + cc * 72 + 16 * pc + 8);
        u32x4* dst = (u32x4*)(PT + ((size_t)c * BC + bl) * TOK + pos0 + 16 * pc); dst[0] = t0; dst[1] = t1;
    }
    __syncthreads();
}
__device__ __forceinline__ void p_hyena_post(const Frame& F, unsigned char* ch) {
    const bf16_t* X0 = (const bf16_t*)(ch + CH_X0); const bf16_t* YT = (const bf16_t*)(ch + CH_YT); bf16_t* HYO = (bf16_t*)(ch + CH_HL);
    LAS bf16_t* T = (LAS bf16_t*)F.lds;
    const int rr = F.tid >> 3, cs = F.tid & 7, cc = F.tid >> 2, pc = F.tid & 3;
    for (int u = F.bid; u < (RC / 64) * 4; u += F.G) {
        const int rb = u >> 2, cb = u & 3, r0 = rb * 64, bl = r0 / TOK, pos0 = r0 - bl * TOK, c = cb * 128 + cc;
        __syncthreads();
        const u32x4* src = (const u32x4*)(YT + ((size_t)c * BC + bl) * TOK + pos0 + 16 * pc);
        const int r = r0 + rr, c0 = cb * 128 + cs * 16;
        const u32x4 y0 = src[0], y1 = src[1], xa = *(const u32x4*)(X0 + (size_t)r * 512 + c0), xb = *(const u32x4*)(X0 + (size_t)r * 512 + c0 + 8);
        *(LAS u32x4*)(T + cc * 72 + 16 * pc) = y0; *(LAS u32x4*)(T + cc * 72 + 16 * pc + 8) = y1;
        __syncthreads();
#pragma unroll
        for (int h = 0; h < 2; ++h) { const int c8 = c0 + 8 * h; const u32x4 x = h ? xb : xa; const unsigned xw[4] = {x.x, x.y, x.z, x.w}; unsigned ow[4];
#pragma unroll
            for (int k = 0; k < 4; ++k) { const float y0f = bf2f(T[(cs * 16 + 8 * h + 2 * k) * 72 + rr]), y1f = bf2f(T[(cs * 16 + 8 * h + 2 * k + 1) * 72 + rr]); ow[k] = cvt_pk_bf16_nv(bflo(xw[k]) * y0f, bfhi(xw[k]) * y1f); }
            u32x4 o; o.x = ow[0]; o.y = ow[1]; o.z = ow[2]; o.w = ow[3]; *(u32x4*)(HYO + (size_t)r * 1024 + c8) = o; }
    }
    __syncthreads();
}
__device__ __forceinline__ void p_lru_conv(const Frame& F, int l, unsigned char* ch) {
    const bf16_t* rx = (const bf16_t*)(ch + CH_RX); bf16_t* XC = (bf16_t*)(ch + CH_XC);
    const float* w = FIN(I_LCW) + (size_t)l * 4 * 512; const float* bb = FIN(I_LCB) + l * 512;
    const size_t total = (size_t)RC * 64, stride = (size_t)F.G * 512;
    const int cfix = (F.tid & 63) * 8;
    float wq[4][8], bq8[8];
    { const f32x4 b0 = *(const f32x4*)(bb + cfix), b1 = *(const f32x4*)(bb + cfix + 4); bq8[0] = b0.x; bq8[1] = b0.y; bq8[2] = b0.z; bq8[3] = b0.w; bq8[4] = b1.x; bq8[5] = b1.y; bq8[6] = b1.z; bq8[7] = b1.w;
#pragma unroll
      for (int j = 0; j < 4; ++j) { const f32x4 w0 = *(const f32x4*)(w + j * 512 + cfix), w1 = *(const f32x4*)(w + j * 512 + cfix + 4);
          wq[j][0] = w0.x; wq[j][1] = w0.y; wq[j][2] = w0.z; wq[j][3] = w0.w; wq[j][4] = w1.x; wq[j][5] = w1.y; wq[j][6] = w1.z; wq[j][7] = w1.w; } }
    for (size_t i0 = (size_t)F.bid * 512 + F.tid; i0 < total; i0 += 2 * stride) {
        u32x4 xv[2][4]; int rr[2], cc[2]; bool val[2][4];
#pragma unroll
        for (int t = 0; t < 2; ++t) { const size_t i = i0 + t * stride < total ? i0 + t * stride : i0; const int r = (int)(i >> 6), c0 = (int)(i & 63) * 8, pos = r % TOK;
            const int lo = pos < CTX ? 0 : CTX, hi = pos < CTX ? CTX : TOK; rr[t] = r; cc[t] = c0;
#pragma unroll
            for (int j = 0; j < 4; ++j) { const int pp = pos - 2 + j; val[t][j] = pp >= lo && pp < hi; xv[t][j] = val[t][j] ? *(const u32x4*)(rx + (size_t)(r - 2 + j) * 512 + c0) : (u32x4){0u, 0u, 0u, 0u}; } }
        asm volatile("" ::: "memory");
#pragma unroll
        for (int t = 0; t < 2; ++t) { if (t == 1 && i0 + stride >= total) break; const int r = rr[t], c0 = cc[t];
            float o[8];
#pragma unroll
            for (int q = 0; q < 8; ++q) o[q] = bq8[q];
#pragma unroll
            for (int j = 0; j < 4; ++j) { const u32x4 x = xv[t][j]; const unsigned xw[4] = {x.x, x.y, x.z, x.w};
#pragma unroll
                for (int q = 0; q < 4; ++q) { o[2 * q] += wq[j][2 * q] * bflo(xw[q]); o[2 * q + 1] += wq[j][2 * q + 1] * bfhi(xw[q]); } }
            u32x4 a; a.x = cvt_pk_bf16_nv(o[0], o[1]); a.y = cvt_pk_bf16_nv(o[2], o[3]); a.z = cvt_pk_bf16_nv(o[4], o[5]); a.w = cvt_pk_bf16_nv(o[6], o[7]);
            *(u32x4*)(XC + (size_t)r * 512 + c0) = a; }
    }
}

__device__ __forceinline__ void p_attention(const Frame& F, int l, unsigned char* ch, bool with_ctx, bf16_t* O) {
    bf16_t* Q = (bf16_t*)(ch + CH_Q); const bf16_t* K = (const bf16_t*)(ch + CH_K); const bf16_t* V = (const bf16_t*)(ch + CH_V);
    const float* qgain = FIN(I_QNG) + l * 128; const float* ropc = (const float*)(F.ws + WS_ROPE); const float* rops = ropc + SEQ * 64;
    const int nunits = BC * 8 * 16 + (with_ctx ? BC * 8 : 0);
    const bool xmap = false;
    for (int u = F.bid; u < nunits; u += F.G) {
        int bl, h, qrow0, seq;
        if (u < BC * 8 * 16) { int qb;
            if (xmap) { const int i = u >> 8, x = F.bid & 7, j = F.bid >> 3, grp = i * 4 + (x >> 1), w = (x & 1) * 32 + j; bl = grp >> 1; h = (grp & 1) * 4 + (w >> 4); qb = w & 15; }
            else { qb = u & 15; h = (u >> 4) & 7; bl = u >> 7; }
            qrow0 = bl * TOK + CTX + qb * 256; seq = TOK; }
        else { const int uu = u - BC * 8 * 16; h = uu & 7; bl = uu >> 3; qrow0 = bl * TOK; seq = CTX; }
        const size_t q0 = (size_t)qrow0 * 1024 + h * 128, k0 = (size_t)(bl * TOK) * 256 + (h >> 2) * 128;
        att::attn_dense_body(Q + q0, K + k0, V + k0, O + q0, seq, (char*)F.lds_gen, F.tid, qgain, ropc, rops, seq == TOK ? qrow0 - bl * TOK - CTX : -1);
    }
}
template <int J, int NSEG>
__device__ __forceinline__ void conv_task(const LAS unsigned char* cop, const bf16_t* PTc, bf16_t* YTc, float bias, int q, int par, int lane) {
    constexpr int CL = 2 * NSEG + 16, NSTEP = NSEG / 32;
    const int i = lane & 15, g = lane >> 4, il = i & 7, ih = i >> 3, A0 = J * q;
    const int abase = (il * CL + NSEG - 16 * par + 8 * g - 8 * ih) * 2;
    bf16x8 fw[J]; f32x4 acc[J];
#pragma unroll
    for (int j = 0; j < J; ++j) { acc[j] = (f32x4){0.f, 0.f, 0.f, 0.f}; fw[j] = (bf16x8){0, 0, 0, 0, 0, 0, 0, 0}; }
#pragma unroll
    for (int j = 1; j < J; ++j) fw[j] = *(const LAS bf16x8*)(cop + abase - 64 * (A0 + j));
    const bool bval = i < BC;
    const bf16_t* bp = PTc + (size_t)(i % BC) * TOK + 8 * g;
    const bf16x8 zero8 = (bf16x8){0, 0, 0, 0, 0, 0, 0, 0};
    bf16x8 bq[4];
#pragma unroll
    for (int s = 0; s < 4; ++s) bq[s] = (bval && s < NSTEP) ? *(const bf16x8*)(bp + 32 * s) : zero8;
    for (int bb0 = 0; bb0 < NSTEP; bb0 += J) {
#pragma unroll
        for (int bb = 0; bb < J; ++bb) {
            const int b = bb0 + bb;
            fw[(J - bb) % J] = *(const LAS bf16x8*)(cop + abase - 64 * (A0 - b));
            const bf16x8 bcur = bq[bb & 3];
            bq[bb & 3] = (bval && b + 4 < NSTEP) ? *(const bf16x8*)(bp + 32 * (b + 4)) : zero8;
            asm volatile("" ::: "memory");
#pragma unroll
            for (int j = 1; j < J; ++j) acc[j] = __builtin_amdgcn_mfma_f32_16x16x32_bf16(fw[(j - bb + J) % J], bcur, acc[j], 0, 0, 0);
            acc[0] = __builtin_amdgcn_mfma_f32_16x16x32_bf16(fw[(J - bb) % J], bcur, acc[0], 0, 0, 0);
        }
    }
    if (bval) {
        u32x2 pvv[J];
#pragma unroll
        for (int j = 0; j < J; ++j) pvv[j] = *(const u32x2*)(PTc + (size_t)i * TOK + 16 * (2 * J * q + par + 2 * j) + 4 * g);
        asm volatile("" ::: "memory");
#pragma unroll
        for (int j = 0; j < J; ++j) { const size_t idx = (size_t)i * TOK + 16 * (2 * J * q + par + 2 * j) + 4 * g; const u32x2 pv = pvv[j]; u32x2 o;
            o.x = cvt_pk_bf16_nv(acc[j][0] + bias * bflo(pv.x), acc[j][1] + bias * bfhi(pv.x)); o.y = cvt_pk_bf16_nv(acc[j][2] + bias * bflo(pv.y), acc[j][3] + bias * bfhi(pv.y));
            *(u32x2*)(YTc + idx) = o; }
    }
}
template <int NSEG>
__device__ __forceinline__ void conv_build_copies(const Frame& F, const bf16_t* FRc) {
    constexpr int CL = 2 * NSEG + 16, NCK = CL / 8;
    LAS bf16_t* C = (LAS bf16_t*)F.lds;
    for (int k = F.tid; k < NCK; k += 512) *(LAS u32x4*)(C + 8 * k) = *(const u32x4*)(FRc + 8 * k);
    __syncthreads();
    for (int id = F.tid; id < 7 * NCK; id += 512) { const int a = 1 + id / NCK, k = id - (a - 1) * NCK; unsigned w[4];
#pragma unroll
        for (int e = 0; e < 4; ++e) { const int x0 = 8 * k + 2 * e - a, x1 = x0 + 1; const unsigned lo = x0 >= 0 ? C[x0] : 0u, hi = x1 >= 0 ? C[x1] : 0u; w[e] = lo | (hi << 16); }
        u32x4 o; o.x = w[0]; o.y = w[1]; o.z = w[2]; o.w = w[3]; *(LAS u32x4*)(C + a * CL + 8 * k) = o; }
    __syncthreads();
}
__device__ __forceinline__ void p_hyena_conv(const Frame& F, int l, unsigned char* ch) {
    const bf16_t* PT = (const bf16_t*)(ch + CH_P); bf16_t* YT = (bf16_t*)(ch + CH_YT);
    const float* bias = FIN(I_HYBIAS) + l * 512;
    for (int u = F.bid; u < 1024; u += F.G) {
        const int c = u & 511, seg = u >> 9;
        __syncthreads();
        if (seg == 0) { conv_build_copies<SEQ>(F, (const bf16_t*)(F.ws + WS_FRL) + (size_t)c * (2 * SEQ + 16));
            const float bc = bias[c];
#pragma unroll 1
            for (int task = F.wave; task < 16; task += 8)
                conv_task<16, SEQ>((const LAS unsigned char*)F.lds, PT + (size_t)c * BC * TOK + CTX, YT + (size_t)c * BC * TOK + CTX, bc, task & 7, task >> 3, F.lane); }
        else { conv_build_copies<CTX>(F, (const bf16_t*)(F.ws + WS_FRC) + (size_t)c * (2 * CTX + 16));
            if (F.wave < 2) conv_task<8, CTX>((const LAS unsigned char*)F.lds, PT + (size_t)c * BC * TOK, YT + (size_t)c * BC * TOK, bias[c], 0, F.wave, F.lane); }
    }
    __syncthreads();
}
__device__ __forceinline__ int lru_pos(int d, int tau) { return d == 0 ? tau : (tau < CTX ? CTX - 1 - tau : TOK + CTX - 1 - tau); }
__device__ __forceinline__ void p_lru_scan(const Frame& F, int l, unsigned char* ch) {
    LAS float* ab = (LAS float*)(F.lds + F.wave * 16384);
    LAS float* agg = (LAS float*)(F.lds + 131072);
    const int lane = F.lane, n = lane & 15, g = lane >> 4, wave = F.wave;
    for (int u = F.bid; u < BC * 8 * 2; u += F.G)
    for (int d = 0; d < 2; ++d) {
        const int half = u & 1, nb = (u >> 1) & 7, bl = u >> 4;
        const float* wa = FIN(I_LWA) + ((size_t)(l * 2 + d) * 8 + nb) * 4096; const float* wx = FIN(I_LWX) + ((size_t)(l * 2 + d) * 8 + nb) * 4096;
        bf16x8 Bwa[2][2], Bwx[2][2]; float ba[2], bx[2], sp8[2];
#pragma unroll
        for (int kh = 0; kh < 2; ++kh)
#pragma unroll
            for (int nh = 0; nh < 2; ++nh) { const int col = half * 32 + nh * 16 + n, k0 = 32 * kh + 8 * g; float wf[8], xf[8];
#pragma unroll
                for (int e = 0; e < 8; ++e) { wf[e] = wa[(k0 + e) * 64 + col]; xf[e] = wx[(k0 + e) * 64 + col]; }
                asm volatile("" ::: "memory");
                u32x4 t; t.x = cvt_pk_bf16_nv(wf[0], wf[1]); t.y = cvt_pk_bf16_nv(wf[2], wf[3]); t.z = cvt_pk_bf16_nv(wf[4], wf[5]); t.w = cvt_pk_bf16_nv(wf[6], wf[7]); Bwa[kh][nh] = __builtin_bit_cast(bf16x8, t);
                t.x = cvt_pk_bf16_nv(xf[0], xf[1]); t.y = cvt_pk_bf16_nv(xf[2], xf[3]); t.z = cvt_pk_bf16_nv(xf[4], xf[5]); t.w = cvt_pk_bf16_nv(xf[6], xf[7]); Bwx[kh][nh] = __builtin_bit_cast(bf16x8, t); }
#pragma unroll
        for (int nh = 0; nh < 2; ++nh) { const int chj = nb * 64 + half * 32 + nh * 16 + n, o = (l * 2 + d) * 512 + chj;
            ba[nh] = FIN(I_LBA)[o]; bx[nh] = FIN(I_LBX)[o]; sp8[nh] = -8.0f * log1pf(__expf(-FIN(I_LLAM)[o])); }
        const bf16_t* XCb = (const bf16_t*)(ch + CH_XC) + (size_t)bl * TOK * 512; const int ldo = d ? 1024 : 512; bf16_t* HOb = d ? (bf16_t*)(ch + CH_HL) + (size_t)bl * TOK * 1024 + 512 : (bf16_t*)(ch + CH_HF) + (size_t)bl * TOK * 512;
        const bf16_t* HFb = (const bf16_t*)(ch + CH_HF) + (size_t)bl * TOK * 512; const bf16_t* RGb = (const bf16_t*)(ch + CH_RG) + (size_t)bl * TOK * 512;
        const int chj0 = nb * 64 + half * 32 + n;
        float H[2] = {0.f, 0.f};
        __syncthreads();
        for (int sc = 0; sc < 9; ++sc) {
            float As[2] = {1.f, 1.f}, Bs[2] = {0.f, 0.f};
            bf16x8 A0q[4], A1q[4]; bf16_t xrq[4][2][4];
#pragma unroll
            for (int tt = 0; tt < 4; ++tt) { const int tau0 = sc * 512 + wave * 64 + tt * 16; const bool live = tau0 < TOK;
                const bf16_t* ap = XCb + (size_t)lru_pos(d, live ? tau0 + n : 0) * 512 + nb * 64 + 8 * g; A0q[tt] = *(const bf16x8*)ap; A1q[tt] = *(const bf16x8*)(ap + 32);
#pragma unroll
                for (int r = 0; r < 4; ++r) { const int pr = lru_pos(d, live ? tau0 + 4 * g + r : 0); xrq[tt][0][r] = XCb[(size_t)pr * 512 + chj0]; xrq[tt][1][r] = XCb[(size_t)pr * 512 + chj0 + 16]; } }
            asm volatile("" ::: "memory");
#pragma unroll
            for (int tt = 0; tt < 4; ++tt) {
                const int tau0 = sc * 512 + wave * 64 + tt * 16; const bool live = tau0 < TOK;
                const bf16x8 A0 = A0q[tt], A1 = A1q[tt];
                bf16_t xr[2][4];
#pragma unroll
                for (int r = 0; r < 4; ++r) { xr[0][r] = xrq[tt][0][r]; xr[1][r] = xrq[tt][1][r]; }
#pragma unroll
                for (int nh = 0; nh < 2; ++nh) {
                    f32x4 ra = (f32x4){0.f, 0.f, 0.f, 0.f}, ri = ra;
                    ra = __builtin_amdgcn_mfma_f32_16x16x32_bf16(A0, Bwa[0][nh], ra, 0, 0, 0); ra = __builtin_amdgcn_mfma_f32_16x16x32_bf16(A1, Bwa[1][nh], ra, 0, 0, 0);
                    ri = __builtin_amdgcn_mfma_f32_16x16x32_bf16(A0, Bwx[0][nh], ri, 0, 0, 0); ri = __builtin_amdgcn_mfma_f32_16x16x32_bf16(A1, Bwx[1][nh], ri, 0, 0, 0);
                    float a[4], b[4];
#pragma unroll
                    for (int r = 0; r < 4; ++r) { const float xj = bf2f(xr[nh][r]);
                        const float la = sp8[nh] * sigmoid_f(ra[r] + ba[nh]), x2 = 2.0f * la;
                        float em1 = x2 * (1.0f + x2 * (0.5f + x2 * (0.16666667f + x2 * (0.041666668f + x2 * 0.0083333338f))));
                        if (x2 < -0.25f) em1 = __expf(x2) - 1.0f;
                        a[r] = live ? __expf(la) : 1.f; b[r] = live ? __builtin_amdgcn_sqrtf(fmaxf(-em1, 0.f)) * sigmoid_f(ri[r] + bx[nh]) * xj : 0.f;
                        *(LAS f32x2*)(ab + ((((tt * 2 + nh) * 4 + r) * 64 + lane) << 1)) = (f32x2){a[r], b[r]}; }
                    float A = a[0], B = b[0];
#pragma unroll
                    for (int r = 1; r < 4; ++r) { B = fmaf(B, a[r], b[r]); A *= a[r]; }
                    float Ai = A, Bi = B;
                    { const float Ap = __shfl_up(Ai, 16), Bp = __shfl_up(Bi, 16); if (g >= 1) { Bi = fmaf(Bp, Ai, Bi); Ai *= Ap; } }
                    { const float Ap = __shfl_up(Ai, 32), Bp = __shfl_up(Bi, 32); if (g >= 2) { Bi = fmaf(Bp, Ai, Bi); Ai *= Ap; } }
                    Bs[nh] = fmaf(Bs[nh], Ai, Bi); As[nh] *= Ai;
                }
            }
            LAS float* ag = agg + (sc & 1) * (8 * 2 * 16 * 2);
            if (g == 3) {
#pragma unroll
                for (int nh = 0; nh < 2; ++nh) { ag[((wave * 2 + nh) * 16 + n) * 2] = As[nh]; ag[((wave * 2 + nh) * 16 + n) * 2 + 1] = Bs[nh]; } }
            __syncthreads();
            float hst[2];
#pragma unroll
            for (int nh = 0; nh < 2; ++nh) { float h = H[nh], hin = H[nh];
#pragma unroll
                for (int w = 0; w < 8; ++w) { if (w == wave) hin = h; h = fmaf(ag[((w * 2 + nh) * 16 + n) * 2], h, ag[((w * 2 + nh) * 16 + n) * 2 + 1]); }
                hst[nh] = hin; H[nh] = h; }
#pragma unroll 1
            for (int tt = 0; tt < 4; ++tt) {
                const int tau0 = sc * 512 + wave * 64 + tt * 16; if (tau0 >= TOK) break;
                int posr[4];
#pragma unroll
                for (int r = 0; r < 4; ++r) posr[r] = lru_pos(d, tau0 + 4 * g + r);
                bf16_t hfq[2][4], rgq[2][4];
                if (d) {
#pragma unroll
                    for (int nh = 0; nh < 2; ++nh)
#pragma unroll
                        for (int r = 0; r < 4; ++r) { const size_t ix = (size_t)posr[r] * 512 + chj0 + 16 * nh; hfq[nh][r] = HFb[ix]; rgq[nh][r] = RGb[ix]; } }
#pragma unroll
                for (int nh = 0; nh < 2; ++nh) { float a[4], b[4];
#pragma unroll
                    for (int r = 0; r < 4; ++r) { const f32x2 t2 = *(const LAS f32x2*)(ab + ((((tt * 2 + nh) * 4 + r) * 64 + lane) << 1)); a[r] = t2.x; b[r] = t2.y; }
                    float A = a[0], B = b[0];
#pragma unroll
                    for (int r = 1; r < 4; ++r) { B = fmaf(B, a[r], b[r]); A *= a[r]; }
                    float Ai = A, Bi = B;
                    { const float Ap = __shfl_up(Ai, 16), Bp = __shfl_up(Bi, 16); if (g >= 1) { Bi = fmaf(Bp, Ai, Bi); Ai *= Ap; } }
                    { const float Ap = __shfl_up(Ai, 32), Bp = __shfl_up(Bi, 32); if (g >= 2) { Bi = fmaf(Bp, Ai, Bi); Ai *= Ap; } }
                    float Ae = __shfl_up(Ai, 16), Be = __shfl_up(Bi, 16); if (g == 0) { Ae = 1.f; Be = 0.f; }
                    float h = fmaf(Ae, hst[nh], Be);
                    bf16_t* hop = HOb + chj0 + 16 * nh;
#pragma unroll
                    for (int r = 0; r < 4; ++r) { h = fmaf(a[r], h, b[r]); hop[(size_t)posr[r] * ldo] = f2bf(d ? (bf2f(hfq[nh][r]) + h) * bf2f(rgq[nh][r]) : h); }
                    hst[nh] = __shfl(h, 48 + n);
                }
            }
        }
    }
    __syncthreads();
}
__device__ __forceinline__ void p_lru_post(const Frame& F, unsigned char* ch) {
    const u32x4* hf = (const u32x4*)(ch + CH_HF); const u32x4* hb = (const u32x4*)(ch + CH_HB); const u32x4* rg = (const u32x4*)(ch + CH_RG); u32x4* o = (u32x4*)(ch + CH_LRUO);
    const size_t total = (size_t)RC * 64, stride = (size_t)F.G * 512;
    for (size_t i = (size_t)F.bid * 512 + F.tid; i < total; i += 2 * stride) {
        const size_t i2 = i + stride; const bool two = i2 < total;
        const u32x4 a = hf[i], b = hb[i], g = rg[i]; u32x4 a2 = a, b2 = b, g2 = g; if (two) { a2 = hf[i2]; b2 = hb[i2]; g2 = rg[i2]; }
        u32x4 w, w2;
        w.x = cvt_pk_bf16_nv((bflo(a.x) + bflo(b.x)) * bflo(g.x), (bfhi(a.x) + bfhi(b.x)) * bfhi(g.x));
        w.y = cvt_pk_bf16_nv((bflo(a.y) + bflo(b.y)) * bflo(g.y), (bfhi(a.y) + bfhi(b.y)) * bfhi(g.y));
        w.z = cvt_pk_bf16_nv((bflo(a.z) + bflo(b.z)) * bflo(g.z), (bfhi(a.z) + bfhi(b.z)) * bfhi(g.z));
        w.w = cvt_pk_bf16_nv((bflo(a.w) + bflo(b.w)) * bflo(g.w), (bfhi(a.w) + bfhi(b.w)) * bfhi(g.w));
        w2.x = cvt_pk_bf16_nv((bflo(a2.x) + bflo(b2.x)) * bflo(g2.x), (bfhi(a2.x) + bfhi(b2.x)) * bfhi(g2.x));
        w2.y = cvt_pk_bf16_nv((bflo(a2.y) + bflo(b2.y)) * bflo(g2.y), (bfhi(a2.y) + bfhi(b2.y)) * bfhi(g2.y));
        w2.z = cvt_pk_bf16_nv((bflo(a2.z) + bflo(b2.z)) * bflo(g2.z), (bfhi(a2.z) + bfhi(b2.z)) * bfhi(g2.z));
        w2.w = cvt_pk_bf16_nv((bflo(a2.w) + bflo(b2.w)) * bflo(g2.w), (bfhi(a2.w) + bfhi(b2.w)) * bfhi(g2.w));
        o[i] = w; if (two) o[i2] = w2;
    }
}

__device__ __forceinline__ void p_topk(const Frame& F, unsigned char* ch) {
    const float* AFF = (const float*)(ch + CH_AFF); int* ROWSRC = (int*)(ch + CH_ROWSRC); float* GATEV = (float*)(ch + CH_GATEV); int* INV = (int*)(ch + CH_INV);
    const float* SU = (const float*)(ch + CH_SU); float* XSCL = (float*)(ch + CH_XSCL);
    LAS unsigned* sh = (LAS unsigned*)F.lds;
    const int tid = F.tid, lane = F.lane, wave = F.wave;
    for (int u = F.bid; u < BC * NE * 2; u += F.G) {
        const int set = u / (BC * NE), e = u % NE, bl = (u / NE) % BC;
        const int n = set ? CTX : SEQ, cap = set ? CAP_C : CAP_L, r0 = bl * TOK + (set ? 0 : CTX);
        unsigned key[8];
#pragma unroll
        for (int k = 0; k < 8; ++k) { const int i = tid * 8 + k; key[k] = i < n ? __float_as_uint(AFF[(size_t)(r0 + i) * NE + e]) : 0u; }
        __syncthreads();
        unsigned T = 0u;
#pragma unroll 1
        for (int b = 30; b >= 0; b -= 2) {
            const unsigned l1 = T | (1u << b), l2 = T | (2u << b), l3 = T | (3u << b);
            int pk = 0;
#pragma unroll
            for (int k = 0; k < 8; ++k) pk += (key[k] >= l1 ? 1 : 0) + (key[k] >= l2 ? (1 << 10) : 0) + (key[k] >= l3 ? (1 << 20) : 0);
            pk = __float_as_int(row16_sum_i(pk)); pk += __shfl_xor(pk, 16); pk += __shfl_xor(pk, 32);
            LAS unsigned* bank = sh + ((b & 2) << 2);
            if (lane == 0) bank[wave] = (unsigned)pk;
            __syncthreads();
            unsigned t1 = 0, t2 = 0, t3 = 0;
#pragma unroll
            for (int w = 0; w < 8; ++w) { const unsigned q = bank[w]; t1 += q & 1023u; t2 += (q >> 10) & 1023u; t3 += q >> 20; }
            T = (int)t3 >= cap ? l3 : (int)t2 >= cap ? l2 : (int)t1 >= cap ? l1 : T;
        }
        int tg = 0, te = 0;
#pragma unroll
        for (int k = 0; k < 8; ++k) { tg += key[k] > T ? 1 : 0; te += key[k] == T ? 1 : 0; }
        int ig = tg, ie = te;
#pragma unroll
        for (int o = 1; o < 64; o <<= 1) { const int a = __shfl_up(ig, o), b = __shfl_up(ie, o); if (lane >= o) { ig += a; ie += b; } }
        __syncthreads();
        if (lane == 63) { sh[16 + wave] = (unsigned)ig; sh[32 + wave] = (unsigned)ie; }
        __syncthreads();
        int pg = ig - tg, pe = ie - te, totg = 0;
#pragma unroll
        for (int w = 0; w < 8; ++w) { const int a = (int)sh[16 + w], b = (int)sh[32 + w]; if (w < wave) { pg += a; pe += b; } totg += a; }
        const int need = cap - totg;
#pragma unroll
        for (int k = 0; k < 8; ++k) { const int i = tid * 8 + k;
            if (i < n) { const bool gt = key[k] > T, eq = key[k] == T; int xr = -1;
                if (gt || (eq && pe < need)) { xr = (set ? BC * CAP_L + bl * CAP_C : bl * CAP_L) + pg + (pe < need ? pe : need); ROWSRC[e * XROWS + xr] = r0 + i; GATEV[e * XROWS + xr] = __uint_as_float(key[k]); XSCL[e * XROWS + xr] = SU[r0 + i]; }
                INV[(size_t)(r0 + i) * NE + e] = xr;
                pg += gt ? 1 : 0; pe += eq ? 1 : 0; } }
    }
    __syncthreads();
}
__device__ __forceinline__ void p_combine(const Frame& F, int l, int chunk, unsigned char* ch) {
    const int* INV = (const int*)(ch + CH_INV); const bf16_t* YS = (const bf16_t*)(ch + CH_YS);
    const int gw = F.bid * 8 + F.wave, NGW = F.G * 8;
    for (int r = gw; r < RC; r += NGW) {
        float acc[16];
#pragma unroll
        for (int j = 0; j < 16; ++j) acc[j] = 0.f;
        int any = 0;
        for (int e = 0; e < NE; ++e) { const int xr = INV[(size_t)r * NE + e];
            if (xr >= 0) { any = 1; const u32x4* yp = (const u32x4*)(YS + ((size_t)e * XROWS + xr) * 1024) + F.lane;
#pragma unroll
                for (int j = 0; j < 2; ++j) { const u32x4 y = yp[64 * j];
                    acc[8 * j + 0] += bflo(y.x); acc[8 * j + 1] += bfhi(y.x); acc[8 * j + 2] += bflo(y.y); acc[8 * j + 3] += bfhi(y.y);
                    acc[8 * j + 4] += bflo(y.z); acc[8 * j + 5] += bfhi(y.z); acc[8 * j + 6] += bflo(y.w); acc[8 * j + 7] += bfhi(y.w); } } }
        if (any) {
            float* hp = hrow_ptr(F, chunk, r); const float* g2 = mod_ptr(F, l, mod_row(chunk, r), 5);
#pragma unroll
            for (int j = 0; j < 2; ++j)
#pragma unroll
                for (int q = 0; q < 2; ++q) { const int col = 512 * j + 8 * F.lane + 4 * q; f32x4* p4 = (f32x4*)(hp + col); const f32x4 g = *(const f32x4*)(g2 + col);
                    f32x4 a; a.x = acc[8 * j + 4 * q]; a.y = acc[8 * j + 4 * q + 1]; a.z = acc[8 * j + 4 * q + 2]; a.w = acc[8 * j + 4 * q + 3];
                    *p4 = *p4 + g * a; }
        }
    }
}
__device__ __forceinline__ void p_final(const Frame& F, unsigned char* ch) {
    const int* INV = (const int*)(ch + CH_INV); const bf16_t* YS = (const bf16_t*)(ch + CH_YS);
    const int gw = F.bid * 8 + F.wave, NGW = F.G * 8; const f32x4* gp = (const f32x4*)FIN(I_FNG) + F.lane;
    for (int r = gw; r < NB * SEQ; r += NGW) {
        const int b = r >> 12, t = r & (SEQ - 1), rr = b * TOK + CTX + t;
        f32x4* hp = (f32x4*)(F.out + ((size_t)r << 10)) + F.lane; f32x4 v[4], acc[4]; float ss = 0.f;
        { const u32x2* hb = (const u32x2*)((const bf16_t*)(ch + CH_HRES) + (size_t)rr * DM) + F.lane;
#pragma unroll
          for (int j = 0; j < 4; ++j) { const u32x2 t = hb[64 * j]; v[j] = (f32x4){bflo(t.x), bfhi(t.x), bflo(t.y), bfhi(t.y)}; acc[j] = (f32x4){0.f, 0.f, 0.f, 0.f}; } }
        { const int xl = INV[(size_t)rr * NE + (F.lane & 15)]; unsigned mk = (unsigned)__ballot(xl >= 0) & 0xffffu;
          while (mk) { const int e0 = __builtin_ctz(mk); mk &= mk - 1u; const bool two = mk != 0u; const int e1 = two ? __builtin_ctz(mk) : e0; if (two) mk &= mk - 1u;
              const int x0 = __builtin_amdgcn_readlane(xl, e0), x1 = __builtin_amdgcn_readlane(xl, e1); const float w1 = two ? 1.f : 0.f;
              const u32x2* y0 = (const u32x2*)(YS + ((size_t)e0 * XROWS + x0) * 1024) + F.lane; const u32x2* y1 = (const u32x2*)(YS + ((size_t)e1 * XROWS + x1) * 1024) + F.lane;
              u32x2 a[4], bb[4];
#pragma unroll
              for (int j = 0; j < 4; ++j) { a[j] = y0[64 * j]; bb[j] = y1[64 * j]; }
#pragma unroll
              for (int j = 0; j < 4; ++j) { acc[j].x += bflo(a[j].x) + w1 * bflo(bb[j].x); acc[j].y += bfhi(a[j].x) + w1 * bfhi(bb[j].x); acc[j].z += bflo(a[j].y) + w1 * bflo(bb[j].y); acc[j].w += bfhi(a[j].y) + w1 * bfhi(bb[j].y); } } }
        const f32x4* g2 = (const f32x4*)mod_ptr(F, DEPTH - 1, b, 5) + F.lane; f32x4 g2q[4], gfq[4];
#pragma unroll
        for (int j = 0; j < 4; ++j) { g2q[j] = g2[64 * j]; gfq[j] = gp[64 * j]; }
        asm volatile("" ::: "memory");
#pragma unroll
        for (int j = 0; j < 4; ++j) { v[j] = v[j] + g2q[j] * acc[j]; ss += (v[j].x * v[j].x + v[j].y * v[j].y) + (v[j].z * v[j].z + v[j].w * v[j].w); }
        const float rstd = rsqrtf(wave_sum(ss) * (1.f / DM) + NORM_EPS);
#pragma unroll
        for (int j = 0; j < 4; ++j) hp[64 * j] = v[j] * rstd * gfq[j];
    }
}
constexpr int STEPS_PER_LAYER = 12, NSTEPS = 1 + DEPTH * STEPS_PER_LAYER + 1;
constexpr unsigned ALL_PHASES = 0xFFFFFFFFu;
#ifndef PROBE_REPMASK
#define PROBE_REPMASK 0u
#endif

template <unsigned PHMASK>
__global__ void __launch_bounds__(512, 2) fwd_kernel(Args args) {
    extern __shared__ __attribute__((aligned(16))) unsigned char lds_raw[];
    Frame F0;
    F0.lds = (LAS unsigned char*)lds_raw; F0.lds_gen = lds_raw;
    F0.tid = 0; F0.lane = 0; F0.wave = __builtin_amdgcn_readfirstlane((int)threadIdx.x >> 6); F0.G = gridDim.x; F0.bid = blockIdx.x;
    F0.in = nullptr; F0.out = args.out; F0.ws = args.ws;
    for (int u = threadIdx.x; u < (LDS_BYTES - LDSCTL_OFF) / 4; u += 512) ((LAS unsigned*)(F0.lds + LDSCTL_OFF))[u] = 0u;
    __syncthreads();
    XcdBarrier bar = xcd_barrier_post((unsigned*)(F0.ws + WS_CTL) + CW_BAR, (volatile LAS unsigned*)(F0.lds + LDSCTL_OFF + 64));
    const int lo = args.lo, hi = args.hi; const unsigned repmask = PROBE_REPMASK;
    int step = 0, l0_ = 0;
#define PH_BEGIN_(k) if (step >= lo && step < hi && ((PHMASK >> (k)) & 1u)) for (int rep_ = 0; rep_ <= (int)((repmask >> (k)) & 1u); ++rep_) { Frame F = F0; \
        { GAS unsigned char* w_ = (GAS unsigned char*)F.ws; GAS float* o_ = (GAS float*)F.out; asm volatile("" : "+s"(w_), "+s"(o_)); \
          F.ws = (unsigned char*)w_; F.out = (float*)o_; F.in = (const float* const*)(F.ws + WS_TAB); } \
        asm volatile("" : "+s"(F.wave), "+s"(F.bid), "+s"(F.G)); \
        { int ln_; asm volatile("v_mbcnt_lo_u32_b32 %0, -1, 0\n\tv_mbcnt_hi_u32_b32 %0, -1, %0" : "=v"(ln_));     \
          F.lane = ln_; F.tid = F.wave * 64 + ln_; } \
        unsigned char* ch = F.ws + WS_CH; (void)ch; int l = l0_; asm volatile("" : "+s"(l)); (void)l;
#define SUBF(name) Frame name = F; { int ln2_; asm volatile("v_mbcnt_lo_u32_b32 %0, -1, 0\n\tv_mbcnt_hi_u32_b32 %0, -1, %0" : "=v"(ln2_)); name.lane = ln2_; name.tid = name.wave * 64 + ln2_; }
#define PH_END } if (step >= lo && step + 1 < hi) { XcdBarrier bb_ = bar; { GAS unsigned* p_ = (GAS unsigned*)bb_.bar; unsigned x_ = bb_.x; asm volatile("" : "+s"(p_), "+s"(x_)); bb_.bar = (unsigned*)p_; bb_.x = x_; } \
        xcd_barrier(bb_); } ++step;

    PH_BEGIN_(0) p_prologue(F, args); PH_END
    for (l0_ = 0; l0_ < DEPTH; ++l0_) {
        constexpr int chunk = 0;
        PH_BEGIN_(1) if (l == 0) p_weights(F, l);
                     if (l == 0) p_norm<false, false>(F, l, chunk, FIN(I_N1G) + l * DM, 0, 1, nullptr, nullptr, 0, nullptr, nullptr, FIN(I_X), FIN(I_CTX), nullptr, false, (signed char*)(ch + CH_U), (float*)(F.ws + WS_SUN));
                     else p_norm<false, true>(F, l, chunk, FIN(I_N1G) + l * DM, 0, 1, nullptr, nullptr, l - 1, (const int*)(ch + CH_INV), (const bf16_t*)(ch + CH_YS), nullptr, nullptr, nullptr, false, (signed char*)(ch + CH_U), (float*)(F.ws + WS_SUN)); PH_END
        PH_BEGIN_(3) { GemmPlainQ g{(const signed char*)(ch + CH_U), (const signed char*)(F.ws + WS_WIN), DM}; pg8::StaticOrder S; S.init(PANELS, 16, F.G, F.bid); EpiIn E{ch, 0, (const float*)(F.ws + WS_SUN), (const float*)(F.ws + WS_SWIN)};
                   pg8::gemm_phase<GemmPlainQ, EpiIn, pg8::StaticOrder>(F.lds, g, S, E, F.tid); } PH_END
        PH_BEGIN_(4) if (rep_ == 0) p_qknorm(F, l, ch); { SUBF(Fb) p_hyena_pre(Fb, l, ch); } { SUBF(Fc) p_lru_conv(Fc, l, ch); } PH_END
        PH_BEGIN_(5) p_attention(F, l, ch, l != DEPTH - 1, (bf16_t*)(ch + (rep_ ? CH_HY : CH_Q))); if (rep_ == 0) { { SUBF(Fb) p_hyena_conv(Fb, l, ch); } { SUBF(Fc) p_lru_scan(Fc, l, ch); } } PH_END
        PH_BEGIN_(8) p_hyena_post(F, ch); PH_END
        PH_BEGIN_(6) { GemmPlainQ g{(const signed char*)(ch + CH_U), (const signed char*)(F.ws + WS_WIN) + (size_t)4096 * DM, DM}; pg8::MappedOrder S; const bool lastl = (l == DEPTH - 1); S.init(lastl ? BC * 16 : PANELS, 12, F.G, F.bid); S.mode = lastl ? 1 : 0; EpiIn E{ch, 16, (const float*)(F.ws + WS_SUN), (const float*)(F.ws + WS_SWIN)};
                   pg8::gemm_phase<GemmPlainQ, EpiIn, pg8::MappedOrder>(F.lds, g, S, E, F.tid); } PH_END
        PH_BEGIN_(9) { { pg8::MappedOrder S; const bool lastl = (l == DEPTH - 1); S.init(lastl ? BC * 16 : PANELS, 4, F.G, F.bid); S.mode = lastl ? 1 : 0;
                     GemmMerge g{(const bf16_t*)(ch + CH_Q), (const bf16_t*)(F.ws + WS_WA), (const bf16_t*)(ch + CH_HL), (const bf16_t*)(F.ws + WS_WH), 1024}; EpiMergeFused E{(bf16_t*)(ch + CH_Y), (const unsigned char*)(ch + CH_GATE)};
                     pg8::gemm_phase<GemmMerge, EpiMergeFused, pg8::MappedOrder>(F.lds, g, S, E, F.tid); }
                   { SUBF(Fw) p_weights_exp13(Fw, l); if (l + 1 < DEPTH) w_filters(Fw, l + 1, 64); } } PH_END
        PH_BEGIN_(10) { GemmPlain g{(const bf16_t*)(ch + CH_Y), (const bf16_t*)(F.ws + WS_WO), 1024}; pg8::MappedOrder S; const bool lastl = (l == DEPTH - 1); S.init(lastl ? BC * 16 : PANELS, 4, F.G, F.bid); S.mode = lastl ? 1 : 0;
                   EpiDelta E{(bf16_t*)(ch + CH_DLT), (const float*)(F.ws + WS_MOD) + (size_t)l * 17 * 6 * DM, chunk};
                   pg8::gemm_phase<GemmPlain, EpiDelta, pg8::MappedOrder>(F.lds, g, S, E, F.tid); { SUBF(Fw) p_weights_exp2(Fw, l); if (l + 1 < DEPTH) w_quant_in(Fw, l + 1, 64); } } PH_END
        PH_BEGIN_(11) p_norm<true, false>(F, l, chunk, FIN(I_N2G) + l * DM, 3, 4, nullptr, (float*)(ch + CH_AFF), 0, nullptr, nullptr, l == 0 ? FIN(I_X) : nullptr, l == 0 ? FIN(I_CTX) : nullptr,
                                                (rep_ == 0) ? (const bf16_t*)(ch + CH_DLT) : nullptr, l == DEPTH - 1, (signed char*)(ch + CH_U2), (float*)(ch + CH_SU)); PH_END
        PH_BEGIN_(12) p_topk(F, ch); PH_END
        PH_BEGIN_(14) { GemmExpertGatherQ g{(const signed char*)(ch + CH_U2), (const int*)(ch + CH_ROWSRC), (const signed char*)(F.ws + WS_W13), 1024, 2048}; pg8::MappedOrder S; const bool lastl = (l == DEPTH - 1); S.init(lastl ? NE * 32 : NE * XPAN, 8, F.G, F.bid); S.mode = lastl ? 2 : 0; EpiSwigluQ E{(bf16_t*)(ch + CH_HID), (const float*)(ch + CH_XSCL), (const float*)(F.ws + WS_SW13)};
                   pg8::gemm_phase<GemmExpertGatherQ, EpiSwigluQ, pg8::MappedOrder>(F.lds, g, S, E, F.tid); } PH_END
        PH_BEGIN_(15) { GemmExpert g{(const bf16_t*)(ch + CH_HID), (const bf16_t*)(F.ws + WS_W2), 1024, 1024}; pg8::MappedOrder S; const bool lastl = (l == DEPTH - 1); S.init(lastl ? NE * 32 : NE * XPAN, 4, F.G, F.bid); S.mode = lastl ? 2 : 0; EpiDown E{(bf16_t*)(ch + CH_YS), (const float*)(ch + CH_GATEV)};
                   pg8::gemm_phase<GemmExpert, EpiDown, pg8::MappedOrder>(F.lds, g, S, E, F.tid); if (l + 1 < DEPTH) { SUBF(Fw) w_transposes(Fw, l + 1, 128); } } PH_END
    }
    PH_BEGIN_(17) p_final(F, ch); PH_END
#undef PH_BEGIN_
#undef PH_END
}

extern "C" void kernel_launch(void* const* d_in, const int* in_sizes, int n_in, void* d_out, int out_size, void* d_ws, size_t ws_size, hipStream_t stream) {
    static int grid = 0;
    if (grid == 0) {
        if (n_in != N_IN || out_size != NB * SEQ * DM || ws_size < WS_END) { fprintf(stderr, "kernel_launch: unexpected shapes: n_in %d out %d ws %zu (need %zu)\n", n_in, out_size, ws_size, (size_t)WS_END); grid = -1; return; }
        int dev = 0, cus = 0, per_cu = 0;
        if (hipGetDevice(&dev) != hipSuccess || hipDeviceGetAttribute(&cus, hipDeviceAttributeMultiprocessorCount, dev) != hipSuccess) { grid = -1; return; }
#if MK_ONE_LAUNCH
        if (hipFuncSetAttribute((const void*)fwd_kernel<ALL_PHASES>, hipFuncAttributeMaxDynamicSharedMemorySize, LDS_BYTES) != hipSuccess) { fprintf(stderr, "kernel_launch: hipFuncSetAttribute failed\n"); grid = -1; return; }
        if (hipOccupancyMaxActiveBlocksPerMultiprocessor(&per_cu, (const void*)fwd_kernel<ALL_PHASES>, 512, LDS_BYTES) != hipSuccess || per_cu < 1) { fprintf(stderr, "kernel_launch: occupancy query says %d\n", per_cu); }
#else
#define SET_ATTR(k) if (hipFuncSetAttribute((const void*)fwd_kernel<(1u << (k))>, hipFuncAttributeMaxDynamicSharedMemorySize, LDS_BYTES) != hipSuccess) { fprintf(stderr, "kernel_launch: hipFuncSetAttribute failed\n"); grid = -1; return; }
        SET_ATTR(0) SET_ATTR(1) SET_ATTR(2) SET_ATTR(3) SET_ATTR(4) SET_ATTR(5) SET_ATTR(6) SET_ATTR(7) SET_ATTR(8) SET_ATTR(9) SET_ATTR(10) SET_ATTR(11) SET_ATTR(12) SET_ATTR(13) SET_ATTR(14) SET_ATTR(15) SET_ATTR(16) SET_ATTR(17)
#undef SET_ATTR
        (void)per_cu;
#endif
        (void)hipGetLastError();
        grid = cus;
    }
    if (grid < 0) return;
    (void)hipMemsetAsync((char*)d_ws + WS_CTL, 0, CTL_ZERO_BYTES, stream);
    Args a{};
    for (int i = 0; i < N_IN; ++i) a.in[i] = (const float*)d_in[i];
    a.out = (float*)d_out; a.ws = (unsigned char*)d_ws;
#if MK_ONE_LAUNCH
    a.lo = 0; a.hi = NSTEPS;
    hipLaunchKernelGGL(fwd_kernel<ALL_PHASES>, dim3(grid), dim3(512), LDS_BYTES, stream, a);
#else
    {
        int s = 0;
#define LAUNCH_PH(k) do { a.lo = s; a.hi = s + 1; hipLaunchKernelGGL(fwd_kernel<(1u << (k))>, dim3(grid), dim3(512), LDS_BYTES, stream, a); ++s; } while (0)
        LAUNCH_PH(0);
        for (int l = 0; l < DEPTH; ++l) { LAUNCH_PH(1); LAUNCH_PH(3); LAUNCH_PH(4); LAUNCH_PH(5); LAUNCH_PH(8); LAUNCH_PH(6); LAUNCH_PH(9); LAUNCH_PH(10);
            LAUNCH_PH(11); LAUNCH_PH(12); LAUNCH_PH(14); LAUNCH_PH(15); }
        LAUNCH_PH(17);
#undef LAUNCH_PH
    }
#endif
    const hipError_t le = hipPeekAtLastError();
    if (le != hipSuccess) fprintf(stderr, "kernel_launch: launch failed: %s\n", hipGetErrorName(le));
}
```

```cpp
#include <hip/hip_runtime.h>
#include <cstdio>
#include <cstdint>

#define GAS __attribute__((address_space(1)))
#define LAS __attribute__((address_space(3)))
typedef unsigned short bf16_t;
typedef short bf16x8 __attribute__((ext_vector_type(8)));
typedef short s16x4 __attribute__((ext_vector_type(4)));
typedef float f32x16 __attribute__((ext_vector_type(16)));
typedef float f32x4 __attribute__((ext_vector_type(4)));
typedef float f32x2 __attribute__((ext_vector_type(2)));
typedef unsigned u32x4 __attribute__((ext_vector_type(4)));
typedef unsigned u32x2 __attribute__((ext_vector_type(2)));

#ifndef MK_ONE_LAUNCH
#define MK_ONE_LAUNCH 1
#endif

constexpr int NB = 16, SEQ = 4096, DM = 1024, DEPTH = 4, CTX = 256, TOK = SEQ + CTX;
constexpr int NCH = 1, BC = NB / NCH, RC = BC * TOK, PANELS = RC / 256;
constexpr int IN_TOTAL = 7168, GRIDW = 64;
constexpr int NE = 16, CAP_L = 512, CAP_C = 32, XPB = CAP_L + CAP_C, XROWS = BC * XPB;
constexpr float NORM_EPS = 1e-6f;
static_assert(RC % 256 == 0 && XROWS % 256 == 0 && TOK % 256 == 0, "panel alignment");

enum { I_X = 0, I_C, I_CTX, I_CCTX, I_MODW, I_MODB, I_N1G, I_N2G, I_WIN, I_QNG, I_KNG, I_HYCW, I_HYCB, I_FW1, I_FB1, I_FW2, I_FB2, I_FW3, I_FREQ, I_HYBIAS,
       I_LCW, I_LCB, I_LWA, I_LBA, I_LWX, I_LBX, I_LLAM, I_WAO, I_WHO, I_WLO, I_WOUT, I_ROUT, I_EW1, I_EW3, I_EW2, I_FNG, N_IN };
static_assert(N_IN == 36, "36 inputs");

constexpr size_t MiB = (size_t)1 << 20;
constexpr size_t WS_CTL = 0, CTL_ZERO_BYTES = 1 * MiB;
constexpr size_t WS_HC = 1 * MiB;
constexpr size_t WS_MOD = 17 * MiB;
constexpr size_t WS_FRL = 19 * MiB;
constexpr size_t WS_FRC = 35 * MiB;
constexpr size_t WS_ROPE = 30 * MiB;
constexpr size_t WS_WIN = 36 * MiB;
constexpr size_t WS_SWIN = 44 * MiB;
constexpr size_t WS_WINB = 88 * MiB;
constexpr size_t CH_HRES = 952 * MiB;
constexpr size_t CH_UB = 952 * MiB;
constexpr size_t WS_SUN = 35 * MiB + 640 * 1024;
constexpr size_t WS_WA = 50 * MiB, WS_WH = 52 * MiB, WS_WL = 53 * MiB, WS_WO = 54 * MiB;
constexpr size_t WS_W13 = 56 * MiB;
constexpr size_t WS_SW13 = 96 * MiB;
constexpr size_t WS_W2 = 120 * MiB;
constexpr size_t WS_CH = 152 * MiB;
constexpr size_t CH_U = 0, CH_Q = 136 * MiB, CH_K = 272 * MiB, CH_V = 306 * MiB, CH_HY = 340 * MiB, CH_RG = 544 * MiB, CH_X0 = 612 * MiB, CH_P = 680 * MiB, CH_XC = 748 * MiB,
                 CH_RX = 816 * MiB, CH_HYO = 884 * MiB, CH_END = 952 * MiB, CH_GATE = 272 * MiB;
constexpr size_t CH_YSUM = 680 * MiB;
constexpr size_t CH_DLT = 272 * MiB;
constexpr size_t CH_HL = CH_RX;
constexpr size_t CH_HF = CH_HY, CH_HB = CH_HY + 68 * MiB, CH_YT = CH_HY + 136 * MiB, CH_LRUO = CH_RX, CH_Y = CH_U;
constexpr size_t CH_U2 = 0, CH_AFF = 136 * MiB, CH_SU = 140 * MiB + MiB / 2, CH_ROWSRC = 141 * MiB, CH_GATEV = 141 * MiB + 3 * MiB / 4, CH_XSCL = 142 * MiB + MiB / 2, CH_INV = 143 * MiB + MiB / 4, CH_HID = 148 * MiB, CH_YS = 420 * MiB;
constexpr size_t WS_END = WS_CH + CH_END + 136 * MiB;
static_assert((size_t)RC * 1024 * 2 == 136 * MiB && (size_t)NE * XROWS * 1024 * 2 == 272 * MiB && CH_YS + 272 * MiB <= CH_END && CH_GATE + 408 * MiB <= CH_RG + 136 * MiB, "buffer sizes");
constexpr int CW_BAR = 4096;
constexpr size_t WS_TAB = WS_MOD + 2 * MiB - 4096;

constexpr int RING_BYTES = 131072, LDSCTL_OFF = 146432, LDS_BYTES = 147456;

__device__ __forceinline__ float bf2f(bf16_t v) { return __uint_as_float(((unsigned)v) << 16); }
__device__ __forceinline__ float bflo(unsigned w) { return __uint_as_float(w << 16); }
__device__ __forceinline__ float bfhi(unsigned w) { return __uint_as_float(w & 0xffff0000u); }
__device__ __forceinline__ unsigned cvt_pk_bf16(float lo, float hi) { unsigned r; asm volatile("v_cvt_pk_bf16_f32 %0, %1, %2" : "=v"(r) : "v"(lo), "v"(hi)); return r; }
__device__ __forceinline__ unsigned cvt_pk_bf16_nv(float lo, float hi) { unsigned r; asm("v_cvt_pk_bf16_f32 %0, %1, %2" : "=v"(r) : "v"(lo), "v"(hi)); return r; }
__device__ __forceinline__ bf16_t f2bf(float f) { return (bf16_t)(cvt_pk_bf16_nv(f, 0.f) & 0xffffu); }
__device__ __forceinline__ float sigmoid_f(float x) { return __builtin_amdgcn_rcpf(1.f + __builtin_amdgcn_exp2f(-1.4426950408889634f * x)); }
__device__ __forceinline__ float silu_f(float x) { return x * sigmoid_f(x); }
__device__ __forceinline__ float gelu_tanh_f(float x) { return x * sigmoid_f(1.5957691216057308f * (x + 0.044715f * x * x * x)); }
__device__ __forceinline__ void sincos_rr(float x, float& s, float& c) {
    const float k = rintf(x * 0.15915494309189535f);
    float r = fmaf(-k, 6.2831854820251465f, x); r = fmaf(-k, -1.7484556000744083e-07f, r);
    s = __sinf(r); c = __cosf(r);
}
template <int CTRL> __device__ __forceinline__ float dpp_f(float v) { return __int_as_float(__builtin_amdgcn_update_dpp(0, __float_as_int(v), CTRL, 0xF, 0xF, true)); }
__device__ __forceinline__ float row16_sum(float v) {
    v += dpp_f<0xB1>(v); v += dpp_f<0x4E>(v); v += dpp_f<0x141>(v); v += dpp_f<0x140>(v); return v;
}
template <int CTRL> __device__ __forceinline__ int dpp_i(int v) { return __builtin_amdgcn_update_dpp(0, v, CTRL, 0xF, 0xF, true); }
__device__ __forceinline__ float row16_sum_i(int v) { v += dpp_i<0xB1>(v); v += dpp_i<0x4E>(v); v += dpp_i<0x141>(v); v += dpp_i<0x140>(v); return __int_as_float(v); }
__device__ __forceinline__ float row16_xor8(float v) { return dpp_f<0x128>(v); }
__device__ __forceinline__ float wave_sum(float v) { v = row16_sum(v); v += __shfl_xor(v, 16); v += __shfl_xor(v, 32); return v; }
#define LDS_WAIT() asm volatile("s_waitcnt lgkmcnt(0)" ::: "memory")
#define VM_WAIT() asm volatile("s_waitcnt vmcnt(0)" ::: "memory")
#define XB_TMO      128
#define XB_XCNT(j)  (256  + 64 * (j))
#define XB_XSUB(j)  (1280 + 64 * (j))
#define XB_XGEN(j)  (2304 + 64 * (j))
#define XB_TOP      3328
#define XB_TOPGEN   3392
#define XCD_BAR_WORDS 3456
#define XB_SPIN_CAP (1u << 18)

__device__ __forceinline__ unsigned xb_ld(unsigned* p)              { return __hip_atomic_load(p, __ATOMIC_RELAXED, __HIP_MEMORY_SCOPE_AGENT); }
__device__ __forceinline__ unsigned xb_add(unsigned* p, unsigned v) { return __hip_atomic_fetch_add(p, v, __ATOMIC_RELAXED, __HIP_MEMORY_SCOPE_AGENT); }
__device__ __forceinline__ unsigned xb_xcc_id() { return (unsigned)__builtin_amdgcn_s_getreg((3 << 11) | 20) & 0xFu; }
#define XB_SPIN(cond, bar) do { unsigned _sp = 0; while (cond) { __builtin_amdgcn_s_sleep(1); \
    if ((++_sp & 255u) == 0u) { if (xb_ld(&(bar)[XB_TMO])) break; if (_sp > XB_SPIN_CAP) { atomicAdd(&(bar)[XB_TMO], 1u); break; } } } } while (0)

struct XcdBarrier {
    unsigned* bar; unsigned x;
    volatile LAS unsigned* st;
};

__device__ __forceinline__ XcdBarrier xcd_barrier_post(unsigned* bar, volatile LAS unsigned* st) {
    XcdBarrier b; b.bar = bar; b.x = xb_xcc_id(); b.st = st;
    if (threadIdx.x == 0) (void)xb_add(&bar[XB_XCNT(b.x)], 1u);
    return b;
}
__device__ __forceinline__ void xcd_barrier_complete(unsigned* bar, unsigned x, unsigned& nloc, unsigned& nx) {
    const unsigned G = gridDim.x * gridDim.y * gridDim.z;
    unsigned sum, cnt, mine, sp = 0u;
    for (;;) {
        sum = 0u; cnt = 0u; mine = 0u;
#pragma unroll
        for (unsigned j = 0; j < 16; ++j) { const unsigned c = xb_ld(&bar[XB_XCNT(j)]); sum += c; cnt += (c > 0u) ? 1u : 0u; mine = (j == x) ? c : mine; }
        if (sum == G) break;
        __builtin_amdgcn_s_sleep(1);
        if ((++sp & 255u) == 0u) { if (xb_ld(&bar[XB_TMO])) break; if (sp > XB_SPIN_CAP) { atomicAdd(&bar[XB_TMO], 1u); break; } }
    }
    nloc = mine > 0u ? mine : 1u; nx = cnt > 0u ? cnt : 1u;
}

__device__ __forceinline__ void xcd_barrier(const XcdBarrier& b) {
    asm volatile("s_waitcnt vmcnt(0)" ::: "memory");
    __syncthreads();
    if (threadIdx.x == 0) {
        unsigned* bar = b.bar;
        __builtin_amdgcn_s_waitcnt(0);
        unsigned nloc = b.st[0], nx = b.st[1];
        if (nloc == 0u) { xcd_barrier_complete(bar, b.x, nloc, nx); b.st[0] = nloc; b.st[1] = nx; }
        const unsigned old = xb_add(&bar[XB_XSUB(b.x)], 1u);
        const unsigned gen = old / nloc;
        if (old + 1u == (gen + 1u) * nloc) {
            __builtin_amdgcn_fence(__ATOMIC_RELEASE, "agent");
            asm volatile("s_waitcnt vmcnt(0)" ::: "memory");
            const unsigned og = xb_add(&bar[XB_TOP], 1u);
            const unsigned tg = og / nx;
            if (og + 1u == (tg + 1u) * nx) xb_add(&bar[XB_TOPGEN], 1u);
            else XB_SPIN(xb_ld(&bar[XB_TOPGEN]) == tg, bar);
            __builtin_amdgcn_fence(__ATOMIC_ACQUIRE, "agent");
            xb_add(&bar[XB_XGEN(b.x)], 1u);
            asm volatile("s_waitcnt vmcnt(0)" ::: "memory");
        } else {
            XB_SPIN(xb_ld(&bar[XB_XGEN(b.x)]) == gen, bar);
            __builtin_amdgcn_fence(__ATOMIC_ACQUIRE, "agent");
            asm volatile("s_waitcnt vmcnt(0)" ::: "memory");
        }
    }
    __syncthreads();
}
namespace pg8 {
#define PG8_LAS __attribute__((address_space(3)))
constexpr int BM = 256, BK = 64, HALF = 128, HTB = HALF * BK * 2  , STAGE_BYTES = 8 * HTB, NXCD = 8, WGM = 8;
__host__ __device__ __forceinline__ int lds_byte(int r, int c) { const int st = (r >> 4) * 2 + (c >> 5), rr = r & 15, cc = c & 31, ob = rr * 64 + cc * 2; return st * 1024 + (ob ^ (((ob >> 9) & 1) << 5)); }
__host__ __device__ __forceinline__ void stage_rc(int b, int& R, int& C) { const int st = b / 1024, sb = b % 1024, swz = sb ^ (((sb >> 9) & 1) << 5); R = (st >> 1) * 16 + swz / 64; C = (st & 1) * 32 + (swz % 64) / 2; }
__host__ __device__ __forceinline__ int perm32(int rho) { const int n = rho >> 4, i = rho & 15; return 8 * (i >> 2) + 4 * n + (i & 3); }
struct Unit { int pm, pn; };
struct StaticOrder {
    int nM, nN, nwg, G, c;
    __host__ __device__ void init(int nM_, int nN_, int G_, int c_) { nM = nM_; nN = nN_; nwg = nM * nN; G = G_; c = c_; }
    __host__ __device__ bool next(int i, Unit& u) const {
        const long L = (long)i * G + c; if (L >= nwg) return false;
        int wgid = (int)L; { const int q = nwg / NXCD, r = nwg % NXCD, xcd = wgid % NXCD, off = wgid / NXCD; wgid = (xcd < r ? xcd * (q + 1) : r * (q + 1) + (xcd - r) * q) + off; }
        const int nig = WGM * nN, gid = wgid / nig, fm = gid * WGM, gsz = (nM - fm) < WGM ? (nM - fm) : WGM;
        u.pm = fm + ((wgid % nig) % gsz); u.pn = (wgid % nig) / gsz; return true;
    }
    __device__ __forceinline__ void a_ready(const Unit&) const {}
    __device__ __forceinline__ void done(const Unit&) const {}
};
struct MappedOrder : StaticOrder {
    int mode;
    __host__ __device__ bool next(int i, Unit& u) const {
        if (!StaticOrder::next(i, u)) return false;
        if (mode == 1) u.pm = 17 * (u.pm >> 4) + 1 + (u.pm & 15); else if (mode == 2) u.pm = 34 * (u.pm >> 5) + (u.pm & 31);
        return true; }
};
typedef int i32x4 __attribute__((ext_vector_type(4)));
template <bool I8> struct AccSel { typedef f32x4 type; };
template <> struct AccSel<true> { typedef i32x4 type; };
template <class GemmT, class Epi, class Sched, bool ALIGN_EPI = true, bool SP2 = true>
__device__ __forceinline__ void gemm_phase(PG8_LAS unsigned char* lds, const GemmT g, const Sched& S, const Epi& E, int tid_in) {
    int tid_ = tid_in; asm volatile("" : "+v"(tid_));
    const int tid = tid_, wid = __builtin_amdgcn_readfirstlane(tid >> 6), lane = tid & 63, wr = wid >> 2, wc = wid & 3, fr = lane & 15, fq = lane >> 4;
    constexpr int ESZ = GemmT::ESZ;
    constexpr bool I8 = (ESZ == 1);
    constexpr bool GATHER = GemmT::GATHER;
    constexpr int NSEG = GemmT::NSEG;
    const int K = g.K, nt1 = K * ESZ / (BK * 2), nt = NSEG * nt1;
    static_assert(!GATHER || SP2, "the gathered-A form is written for the SP2 loop only");
    unsigned voffB[2], gA[2][2], gAn[2][2]; int sR[2], sC[2];
#pragma unroll
    for (int i = 0; i < 2; ++i) { int R, C; stage_rc(tid * 16 + i * 8192, R, C); const int Rb = Epi::PERM ? ((R & ~31) + perm32(R & 31)) : R; sR[i] = R; sC[i] = C;
        voffB[i] = (unsigned)(Rb * K * ESZ + C * 2); gA[0][i] = gA[1][i] = gAn[0][i] = gAn[1][i] = (unsigned)(R * K * ESZ + C * 2); }
    const size_t kstep = (size_t)(BK * 2);
    const size_t hstep = (size_t)HALF * K * ESZ;
    const size_t hA = GATHER ? (size_t)0 : hstep;
    const size_t tstep = 2 * hstep;
    long dA = 0, dB = 0; if constexpr (NSEG == 2) { dA = g.seg_delta_a() - (long)nt1 * (long)kstep; dB = g.seg_delta_b() - (long)nt1 * (long)kstep; }
    const unsigned ldsw = (unsigned)wid * 1024u;
    const int aoff = lds_byte(wr * 64 + fr, fq * 8), boff = lds_byte(wc * 32 + fr, fq * 8);
#define PG8_SA(b, h) (((b) * 2 + (h)) * HTB)
#define PG8_SB(b, h) ((4 + (b) * 2 + (h)) * HTB)
#define PG8_STAGE(bufoff, gbase, voff) do { _Pragma("unroll") for (int _i = 0; _i < 2; ++_i) \
        __builtin_amdgcn_global_load_lds((const unsigned*)((const char*)(gbase) + (voff)[_i]), (PG8_LAS unsigned*)(lds + (bufoff) + ldsw + _i * 8192), 16, 0, 0); } while (0)
#define PG8_LDA(dst, b, h) do { _Pragma("unroll") for (int m = 0; m < 4; ++m) _Pragma("unroll") for (int k = 0; k < 2; ++k) dst[m][k] = *(const PG8_LAS bf16x8*)(lds + PG8_SA(b, h) + aoff + m * 2048 + k * 1024); } while (0)
#define PG8_LDB(dst, b, h) do { _Pragma("unroll") for (int n = 0; n < 2; ++n) _Pragma("unroll") for (int k = 0; k < 2; ++k) dst[n][k] = *(const PG8_LAS bf16x8*)(lds + PG8_SB(b, h) + boff + n * 2048 + k * 1024); } while (0)
#define PG8_MMA(ai, bj, At, Bt) do { __builtin_amdgcn_s_setprio(1); _Pragma("unroll") for (int m = 0; m < 4; ++m) _Pragma("unroll") for (int n = 0; n < 2; ++n) _Pragma("unroll") for (int k = 0; k < 2; ++k) { \
        if constexpr (I8) acc[ai][bj][m][n] = __builtin_amdgcn_mfma_i32_16x16x64_i8(__builtin_bit_cast(i32x4, Bt[n][k]), __builtin_bit_cast(i32x4, At[m][k]), acc[ai][bj][m][n], 0, 0, 0); \
        else acc[ai][bj][m][n] = __builtin_amdgcn_mfma_f32_16x16x32_bf16(Bt[n][k], At[m][k], acc[ai][bj][m][n], 0, 0, 0); } __builtin_amdgcn_s_setprio(0); } while (0)
#define PG8_WAIT_V(n) asm volatile("s_waitcnt vmcnt(" #n ")" ::: "memory")
#define PG8_WAIT_L(n) asm volatile("s_waitcnt lgkmcnt(" #n ")" ::: "memory")
#define PG8_BAR __builtin_amdgcn_s_barrier()
#define PG8_SCHED __builtin_amdgcn_sched_barrier(0)
    Unit cur, nxt; int ui = 0;
    if (!S.next(0, cur)) return;
    typedef typename AccSel<I8>::type acc_t;
    acc_t acc[2][2][4][2];
#pragma unroll
    for (int a = 0; a < 2; ++a)
#pragma unroll
        for (int b = 0; b < 2; ++b)
#pragma unroll
            for (int m = 0; m < 4; ++m)
#pragma unroll
                for (int n = 0; n < 2; ++n) acc[a][b][m][n] = (acc_t){0, 0, 0, 0};
    bf16x8 At[4][2], B0[2][2], B1[2][2];
    const char* cA = g.a_tile(cur); const char* cB = g.b_tile(cur);
    S.a_ready(cur);
    if constexpr (GATHER) {
            { int r4[2][2];
#pragma unroll
        for (int h = 0; h < 2; ++h)
#pragma unroll
            for (int i = 0; i < 2; ++i) r4[h][i] = g.a_row(cur, h * HALF + sR[i]);
        asm volatile("" ::: "memory");
#pragma unroll
        for (int h = 0; h < 2; ++h)
#pragma unroll
            for (int i = 0; i < 2; ++i) gA[h][i] = (unsigned)(r4[h][i] * K * ESZ + sC[i] * 2); }
        PG8_WAIT_V(0); }
    if constexpr (SP2) {
        PG8_STAGE(PG8_SB(0, 0), cB, voffB); PG8_STAGE(PG8_SB(0, 1), cB + hstep, voffB); PG8_STAGE(PG8_SA(0, 0), cA, gA[0]); PG8_STAGE(PG8_SA(0, 1), cA + hA, gA[1]);
        if (wr == 1) PG8_BAR;
        PG8_WAIT_V(2); PG8_BAR;
        PG8_STAGE(PG8_SB(1, 0), cB + kstep, voffB); PG8_STAGE(PG8_SA(1, 0), cA + kstep, gA[0]); PG8_STAGE(PG8_SB(1, 1), cB + hstep + kstep, voffB);
        PG8_WAIT_V(6); PG8_BAR;
    } else {
        PG8_STAGE(PG8_SB(0, 0), cB, voffB); PG8_STAGE(PG8_SA(0, 0), cA, gA[0]); PG8_STAGE(PG8_SB(0, 1), cB + hstep, voffB); PG8_STAGE(PG8_SA(0, 1), cA + hstep, gA[0]);
        if (wr == 1) PG8_BAR;
        PG8_WAIT_V(4); PG8_BAR;
        PG8_STAGE(PG8_SB(1, 0), cB + kstep, voffB); PG8_STAGE(PG8_SA(1, 0), cA + kstep, gA[0]); PG8_STAGE(PG8_SB(1, 1), cB + hstep + kstep, voffB);
        PG8_WAIT_V(6); PG8_BAR;
    }
    for (;;) {
        const bool has_next = S.next(ui + 1, nxt);
        const char* nA = has_next ? g.a_tile(nxt) : cA; const char* nB = has_next ? g.b_tile(nxt) : cB;
        if constexpr (GATHER) {
                { int r4[2][2];
#pragma unroll
            for (int h = 0; h < 2; ++h)
#pragma unroll
                for (int i = 0; i < 2; ++i) r4[h][i] = has_next ? g.a_row(nxt, h * HALF + sR[i]) : 0;
            asm volatile("" ::: "memory");
#pragma unroll
            for (int h = 0; h < 2; ++h)
#pragma unroll
                for (int i = 0; i < 2; ++i) gAn[h][i] = has_next ? (unsigned)(r4[h][i] * K * ESZ + sC[i] * 2) : gA[h][i]; }
            PG8_WAIT_V(0); }
#pragma unroll 1
        for (int sg = 0; sg < (NSEG == 2 ? 3 : 1); ++sg) {
        const int tb = NSEG == 2 ? (sg == 0 ? 0 : sg == 1 ? nt1 : nt1 + nt1 / 2) : 0, te = NSEG == 2 ? (sg == 0 ? nt1 : sg == 1 ? nt1 + nt1 / 2 : nt) : nt;
#pragma unroll 1
        for (int t = tb; t < te; t += 2) {
            const bool last = (t == nt - 2);
            const long sAc = (NSEG == 2 && t >= nt1) ? dA : 0, sAn = (NSEG == 2 && t + 2 >= nt1) ? dA : 0, sBn = (NSEG == 2 && t + 2 >= nt1) ? dB : 0;
            const char* a1 = cA + sAc + (size_t)(t + 1) * kstep;
            const char* a2 = last ? nA : cA + sAn + (size_t)(t + 2) * kstep; const char* b2 = last ? nB : cB + sBn + (size_t)(t + 2) * kstep;
            const char* a3 = a2 + kstep; const char* b3 = b2 + kstep;
            if (last && has_next) S.a_ready(nxt);
            unsigned g2[2][2];
#pragma unroll
            for (int h = 0; h < 2; ++h)
#pragma unroll
                for (int i = 0; i < 2; ++i) g2[h][i] = (GATHER && last) ? gAn[h][i] : gA[h][i];
            if constexpr (SP2) {
            PG8_LDB(B0, 0, 0); PG8_LDB(B1, 0, 1); PG8_SCHED; PG8_LDA(At, 0, 0); PG8_STAGE(PG8_SA(1, 1), a1 + hA, gA[1]);
            PG8_WAIT_V(8); PG8_WAIT_L(0); PG8_BAR; PG8_MMA(0, 0, At, B0); PG8_MMA(0, 1, At, B1); PG8_BAR; PG8_SCHED;
            PG8_LDA(At, 0, 1); PG8_STAGE(PG8_SB(0, 0), b2, voffB); PG8_STAGE(PG8_SB(0, 1), b2 + hstep, voffB); PG8_STAGE(PG8_SA(0, 0), a2, g2[0]);
            PG8_WAIT_V(8); PG8_WAIT_L(0); PG8_BAR; PG8_MMA(1, 0, At, B0); PG8_MMA(1, 1, At, B1); PG8_BAR; PG8_SCHED;
            PG8_LDB(B0, 1, 0); PG8_LDB(B1, 1, 1); PG8_SCHED; PG8_LDA(At, 1, 0); PG8_STAGE(PG8_SA(0, 1), a2 + hA, g2[1]);
            PG8_WAIT_V(8); PG8_WAIT_L(0); PG8_BAR; PG8_MMA(0, 0, At, B0); PG8_MMA(0, 1, At, B1); PG8_BAR; PG8_SCHED;
            PG8_LDA(At, 1, 1); PG8_STAGE(PG8_SB(1, 0), b3, voffB); PG8_STAGE(PG8_SB(1, 1), b3 + hstep, voffB); PG8_STAGE(PG8_SA(1, 0), a3, g2[0]);
            PG8_WAIT_V(8); PG8_WAIT_L(0); PG8_BAR; PG8_MMA(1, 0, At, B0); PG8_MMA(1, 1, At, B1); PG8_BAR; PG8_SCHED;
            } else {
            PG8_LDB(B0, 0, 0); PG8_SCHED; PG8_LDA(At, 0, 0); PG8_STAGE(PG8_SA(1, 1), a1 + hstep, gA[0]);
            PG8_WAIT_L(8); PG8_BAR; PG8_WAIT_L(0); PG8_MMA(0, 0, At, B0); PG8_BAR; PG8_SCHED;
            PG8_LDB(B1, 0, 1); PG8_STAGE(PG8_SB(0, 0), b2, voffB);
            PG8_BAR; PG8_WAIT_L(0); PG8_MMA(0, 1, At, B1); PG8_BAR;
            PG8_LDA(At, 0, 1); PG8_STAGE(PG8_SA(0, 0), a2, gA[0]);
            PG8_BAR; PG8_WAIT_L(0); PG8_MMA(1, 0, At, B0); PG8_BAR; PG8_SCHED;
            PG8_STAGE(PG8_SB(0, 1), b2 + hstep, voffB);
            PG8_WAIT_V(6); PG8_BAR; PG8_MMA(1, 1, At, B1); PG8_BAR;
            PG8_LDB(B0, 1, 0); PG8_SCHED; PG8_LDA(At, 1, 0); PG8_STAGE(PG8_SA(0, 1), a2 + hstep, gA[0]);
            PG8_WAIT_L(8); PG8_BAR; PG8_WAIT_L(0); PG8_MMA(0, 0, At, B0); PG8_BAR; PG8_SCHED;
            PG8_LDB(B1, 1, 1); PG8_STAGE(PG8_SB(1, 0), b3, voffB);
            PG8_BAR; PG8_WAIT_L(0); PG8_MMA(0, 1, At, B1); PG8_BAR;
            PG8_LDA(At, 1, 1); PG8_STAGE(PG8_SA(1, 0), a3, gA[0]);
            PG8_BAR; PG8_WAIT_L(0); PG8_MMA(1, 0, At, B0); PG8_BAR; PG8_SCHED;
            PG8_STAGE(PG8_SB(1, 1), b3 + hstep, voffB);
            PG8_WAIT_V(6); PG8_BAR; PG8_MMA(1, 1, At, B1); PG8_BAR;
            }
        }
        if constexpr (NSEG == 2) { if (sg < 2) { PG8_SCHED; E.mid(acc, cur, sg, wr, wc, fr, fq); PG8_SCHED; } }
        }
        if constexpr (ALIGN_EPI) { if (wr == 0) PG8_BAR; }
        if constexpr (!Epi::AFTER_DRAIN) {
            if constexpr (I8) { f32x4 accf[2][2][4][2];
#pragma unroll
                for (int a = 0; a < 2; ++a)
#pragma unroll
                    for (int b = 0; b < 2; ++b)
#pragma unroll
                        for (int m = 0; m < 4; ++m)
#pragma unroll
                            for (int n = 0; n < 2; ++n) accf[a][b][m][n] = (f32x4){(float)acc[a][b][m][n][0], (float)acc[a][b][m][n][1], (float)acc[a][b][m][n][2], (float)acc[a][b][m][n][3]};
                E(accf, cur, wr, wc, fr, fq); }
            else E(acc, cur, wr, wc, fr, fq);
            S.done(cur); }
        if (!has_next) break;
#pragma unroll
        for (int a = 0; a < 2; ++a)
#pragma unroll
            for (int b = 0; b < 2; ++b)
#pragma unroll
                for (int m = 0; m < 4; ++m)
#pragma unroll
                    for (int n = 0; n < 2; ++n) acc[a][b][m][n] = (acc_t){0, 0, 0, 0};
        cur = nxt; cA = nA; cB = nB; ++ui;
        if constexpr (GATHER) {
#pragma unroll
            for (int h = 0; h < 2; ++h)
#pragma unroll
                for (int i = 0; i < 2; ++i) gA[h][i] = gAn[h][i]; }
        if constexpr (ALIGN_EPI) { if (wr == 1) PG8_BAR; }
    }
    PG8_WAIT_V(0);
    if constexpr (!ALIGN_EPI) { if (wr == 0) PG8_BAR; }
    PG8_BAR;
    if constexpr (Epi::AFTER_DRAIN) { static_assert(!Epi::AFTER_DRAIN || !I8, "no int8 after-drain epilogues"); }
#undef PG8_SA
#undef PG8_SB
#undef PG8_STAGE
#undef PG8_LDA
#undef PG8_LDB
#undef PG8_MMA
#undef PG8_WAIT_V
#undef PG8_WAIT_L
#undef PG8_BAR
#undef PG8_SCHED
}
}
namespace att {
constexpr int D = 128, NW = 8, QBLK = 32, KVBLK = 64;
constexpr float SCALE = 0.088388347648318440f;
constexpr float THR = 8.f;
constexpr int SDEPTH = 2;
constexpr int LDQ = 1024, LDK = 256, LDO = 1024;
constexpr size_t SHM_V = KVBLK * D * 2, SHM_K = KVBLK * D * 2, SHM_ATTN = 2 * SHM_V + 2 * SHM_K + NW * 64 * 4;
typedef bf16_t bf16;
__device__ __forceinline__ unsigned cvtpk(float lo, float hi) { return cvt_pk_bf16(lo, hi); }
struct St { using T = bf16x8;
  __device__ static __forceinline__ T ld8(const bf16* p) { return *reinterpret_cast<const bf16x8*>(p); }
  __device__ static __forceinline__ bf16x8 tobf(T x) { return x; } };
#define KSWZ(row, colB) ((row) * 256 + ((colB) ^ (((row) & 7) << 4)))
#define SBAR() __builtin_amdgcn_sched_barrier(0)
__device__ __forceinline__ int crow(int r, int hi) { return (r & 3) + 8 * (r >> 2) + 4 * hi; }
__device__ __forceinline__ void partialSM(f32x16& p0, f32x16& p1, float& m_reg, float& mn, float& alpha) {
  constexpr float C = SCALE * 1.4426950408889634f;
  float pmax = p0[0]; for (int r = 1; r < 16; ++r) pmax = fmaxf(pmax, p0[r]); for (int r = 0; r < 16; ++r) pmax = fmaxf(pmax, p1[r]);
  { auto rr = __builtin_amdgcn_permlane32_swap(__float_as_uint(pmax), __float_as_uint(pmax), false, false);
    pmax = fmaxf(__uint_as_float(rr[0]), __uint_as_float(rr[1])); }
  if (__builtin_expect(__all(pmax - m_reg <= THR / SCALE), 1)) { mn = m_reg; alpha = 1.f; }
  else { mn = fmaxf(m_reg, pmax); alpha = __builtin_amdgcn_exp2f((m_reg - mn) * C); m_reg = mn; }
  float mnC = -mn * C;
  for (int r = 0; r < 16; ++r) p0[r] = fmaf(p0[r], C, mnC); for (int r = 0; r < 16; ++r) p1[r] = fmaf(p1[r], C, mnC);
  for (int r = 0; r < 16; ++r) p0[r] = __builtin_amdgcn_exp2f(p0[r]);
}
__device__ __forceinline__ void finishSM(f32x16& p0, f32x16& p1, float alpha, float& l_reg, bf16x8& pa0, bf16x8& pa1, bf16x8& pa2, bf16x8& pa3) {
  for (int r = 0; r < 16; ++r) p1[r] = __builtin_amdgcn_exp2f(p1[r]);
  float ps = 0; for (int r = 0; r < 16; ++r) ps += p0[r]; for (int r = 0; r < 16; ++r) ps += p1[r];
  { auto rr = __builtin_amdgcn_permlane32_swap(__float_as_uint(ps), __float_as_uint(ps), false, false);
    ps = __uint_as_float(rr[0]) + __uint_as_float(rr[1]); }
  l_reg = l_reg * alpha + ps;
#define PK4(P, BASE, OUT) do { unsigned a0 = cvtpk(P[BASE + 0], P[BASE + 1]), a1 = cvtpk(P[BASE + 2], P[BASE + 3]);   \
    unsigned b0 = cvtpk(P[BASE + 4], P[BASE + 5]), b1 = cvtpk(P[BASE + 6], P[BASE + 7]);                              \
    auto r0 = __builtin_amdgcn_permlane32_swap(a0, b0, false, false); auto r1 = __builtin_amdgcn_permlane32_swap(a1, b1, false, false); \
    u32x4 w = {r0[0], r1[0], r0[1], r1[1]}; OUT = *reinterpret_cast<bf16x8*>(&w); } while (0)
  PK4(p0, 0, pa0); PK4(p0, 8, pa1); PK4(p1, 0, pa2); PK4(p1, 8, pa3);
#undef PK4
}
__device__ __forceinline__ void qkt(f32x16& p0, f32x16& p1, const bf16* Ks, const bf16x8* qr, int r32, int hi) {
  p0 = f32x16{}; p1 = f32x16{};
  for (int d0 = 0; d0 < 8; ++d0) { int cb = (d0 * 16 + hi * 8) * 2;
    bf16x8 b0 = *reinterpret_cast<const bf16x8*>((const char*)Ks + KSWZ(r32, cb));
    bf16x8 b1 = *reinterpret_cast<const bf16x8*>((const char*)Ks + KSWZ(32 + r32, cb));
    p0 = __builtin_amdgcn_mfma_f32_32x32x16_bf16(b0, qr[d0], p0, 0, 0, 0);
    p1 = __builtin_amdgcn_mfma_f32_32x32x16_bf16(b1, qr[d0], p1, 0, 0, 0); }
}
__device__ __forceinline__ int v_st(int k, int c) { const int kk = (k & ~0xC) | ((k & 4) << 1) | ((k & 8) >> 1); return ((kk >> 3) * 4 + (c >> 5)) * 512 + ((kk & 7) * 32 + (c & 31)) * 2; }
__device__ __forceinline__ int v_rd_base(int lane) { return ((lane & 3) << 3) | (((lane >> 2) & 3) << 6) | (((lane >> 4) & 1) << 5) | (((lane >> 5) & 1) << 8); }
constexpr int v_rd_off(int d0, int ks, int half) { return d0 * 512 + ks * 4096 + half * 2048; }
template <int OFF> __device__ __forceinline__ s16x4 tr_read(int vb) {
  s16x4 r; asm volatile("ds_read_b64_tr_b16 %0, %1 offset:%2" : "=&v"(r) : "v"(vb), "i"(OFF) : "memory"); return r;
}
template <int D0> __device__ __forceinline__ void pv_one(f32x16& od, int vb, bf16x8 pa0, bf16x8 pa1, bf16x8 pa2, bf16x8 pa3) {
  const s16x4 l0 = tr_read<v_rd_off(D0, 0, 0)>(vb), h0 = tr_read<v_rd_off(D0, 0, 1)>(vb), l1 = tr_read<v_rd_off(D0, 1, 0)>(vb), h1 = tr_read<v_rd_off(D0, 1, 1)>(vb);
  const s16x4 l2 = tr_read<v_rd_off(D0, 2, 0)>(vb), h2 = tr_read<v_rd_off(D0, 2, 1)>(vb), l3 = tr_read<v_rd_off(D0, 3, 0)>(vb), h3 = tr_read<v_rd_off(D0, 3, 1)>(vb);
  asm volatile("s_waitcnt lgkmcnt(0)" ::: "memory"); SBAR();
#define PK(L, H) (bf16x8){L[0], L[1], L[2], L[3], H[0], H[1], H[2], H[3]}
  od = __builtin_amdgcn_mfma_f32_32x32x16_bf16(pa0, PK(l0, h0), od, 0, 0, 0);
  od = __builtin_amdgcn_mfma_f32_32x32x16_bf16(pa1, PK(l1, h1), od, 0, 0, 0);
  od = __builtin_amdgcn_mfma_f32_32x32x16_bf16(pa2, PK(l2, h2), od, 0, 0, 0);
  od = __builtin_amdgcn_mfma_f32_32x32x16_bf16(pa3, PK(l3, h3), od, 0, 0, 0);
#undef PK
}
__device__ __forceinline__ void pv_d0(f32x16* o, int vb, bf16x8 pa0, bf16x8 pa1, bf16x8 pa2, bf16x8 pa3) {
  pv_one<0>(o[0], vb, pa0, pa1, pa2, pa3); pv_one<1>(o[1], vb, pa0, pa1, pa2, pa3); pv_one<2>(o[2], vb, pa0, pa1, pa2, pa3); pv_one<3>(o[3], vb, pa0, pa1, pa2, pa3);
}

__device__ __forceinline__ void attn_dense_body(const bf16* Qb, const bf16* __restrict__ Kh, const bf16* __restrict__ Vh,
                                                bf16* Ob, int seq, char* lds, int tid_in, const float* qgain, const float* ropc, const float* rops, int t0) {
  using SQ = St;
  int tid_ = tid_in; asm volatile("" : "+v"(tid_));
  const int tid = tid_, wid = tid >> 6, lane = tid & 63, r32 = lane & 31, hi = lane >> 5;
  bf16* V_lds = (bf16*)lds; bf16* K_lds = (bf16*)(lds + 2 * SHM_V);
  float* ws = (float*)(lds + 2 * SHM_V + 2 * SHM_K) + wid * 64; float* li_l = ws; float* al_l = ws + 32;
  float m_reg = -1e30f, l_reg = 0; f32x16 o[4] = {}; bf16x8 qr[8];
  const bf16* Qw = Qb + (long)(wid * QBLK + r32) * LDQ + hi * 8;
#pragma unroll
  for (int d0 = 0; d0 < 8; ++d0) qr[d0] = SQ::tobf(SQ::ld8(Qw + d0 * 16));
  { float qf[8][8]; float ss = 0.f;
#pragma unroll
    for (int d0 = 0; d0 < 8; ++d0) { const u32x4 w = __builtin_bit_cast(u32x4, qr[d0]);
      qf[d0][0] = bflo(w.x); qf[d0][1] = bfhi(w.x); qf[d0][2] = bflo(w.y); qf[d0][3] = bfhi(w.y); qf[d0][4] = bflo(w.z); qf[d0][5] = bfhi(w.z); qf[d0][6] = bflo(w.w); qf[d0][7] = bfhi(w.w);
#pragma unroll
      for (int j = 0; j < 8; ++j) ss = fmaf(qf[d0][j], qf[d0][j], ss); }
    { auto rr = __builtin_amdgcn_permlane32_swap(__float_as_uint(ss), __float_as_uint(ss), false, false); ss = __uint_as_float(rr[0]) + __uint_as_float(rr[1]); }
    const float rms = rsqrtf(ss * (1.f / 128.f) + 1e-6f);
#pragma unroll
    for (int d0 = 0; d0 < 8; ++d0) { const f32x4 g0 = *(const f32x4*)(qgain + d0 * 16 + hi * 8), g1 = *(const f32x4*)(qgain + d0 * 16 + hi * 8 + 4);
      qf[d0][0] *= rms * g0.x; qf[d0][1] *= rms * g0.y; qf[d0][2] *= rms * g0.z; qf[d0][3] *= rms * g0.w; qf[d0][4] *= rms * g1.x; qf[d0][5] *= rms * g1.y; qf[d0][6] *= rms * g1.z; qf[d0][7] *= rms * g1.w; }
    if (t0 >= 0) { const int t = t0 + wid * QBLK + r32;
#pragma unroll
      for (int d0 = 0; d0 < 4; ++d0) { const float* cp = ropc + (long)t * 64 + d0 * 16 + hi * 8; const float* sp = rops + (long)t * 64 + d0 * 16 + hi * 8;
        const f32x4 c0 = *(const f32x4*)cp, c1 = *(const f32x4*)(cp + 4), s0 = *(const f32x4*)sp, s1 = *(const f32x4*)(sp + 4);
        const float cs[8] = {c0.x, c0.y, c0.z, c0.w, c1.x, c1.y, c1.z, c1.w}, sn[8] = {s0.x, s0.y, s0.z, s0.w, s1.x, s1.y, s1.z, s1.w};
#pragma unroll
        for (int j = 0; j < 8; ++j) { const float x1 = qf[d0][j], x2 = qf[d0 + 4][j]; qf[d0][j] = x1 * cs[j] - x2 * sn[j]; qf[d0 + 4][j] = x2 * cs[j] + x1 * sn[j]; } } }
#pragma unroll
    for (int d0 = 0; d0 < 8; ++d0) { u32x4 w = {cvtpk(qf[d0][0], qf[d0][1]), cvtpk(qf[d0][2], qf[d0][3]), cvtpk(qf[d0][4], qf[d0][5]), cvtpk(qf[d0][6], qf[d0][7])}; qr[d0] = __builtin_bit_cast(bf16x8, w); } }
  const int sr = tid >> 4, sc = (tid & 15) * 8, vst0 = v_st(sr, sc), vst1 = v_st(32 + sr, sc);
  const int vb0 = (int)(uintptr_t)V_lds + v_rd_base(lane);
  struct { typename St::T vs0, vs1, ks0, ks1; } sr_[SDEPTH];
#define SLOAD(i, k0) do { sr_[i].vs0 = St::ld8(&Vh[(long)((k0) + sr) * LDK + sc]); sr_[i].vs1 = St::ld8(&Vh[(long)((k0) + 32 + sr) * LDK + sc]); \
    sr_[i].ks0 = St::ld8(&Kh[(long)((k0) + sr) * LDK + sc]); sr_[i].ks1 = St::ld8(&Kh[(long)((k0) + 32 + sr) * LDK + sc]); } while (0)
#define SWRITE(b, i) do { *(bf16x8*)((char*)V_lds + (b) * SHM_V + vst0) = St::tobf(sr_[i].vs0);          \
    *(bf16x8*)((char*)V_lds + (b) * SHM_V + vst1) = St::tobf(sr_[i].vs1); int kc = sc * 2;               \
    *(bf16x8*)((char*)K_lds + (b) * SHM_K + KSWZ(sr, kc)) = St::tobf(sr_[i].ks0);                       \
    *(bf16x8*)((char*)K_lds + (b) * SHM_K + KSWZ(32 + sr, kc)) = St::tobf(sr_[i].ks1); } while (0)
#define SWAIT() do { if constexpr (SDEPTH == 2) asm volatile("s_waitcnt vmcnt(4)" ::: "memory"); else asm volatile("s_waitcnt vmcnt(0)" ::: "memory"); } while (0)
#define RESC(a) do { if (__any((a) < 1.f)) { if (hi == 0) al_l[r32] = (a); asm volatile("s_waitcnt lgkmcnt(0)" ::: "memory"); \
    for (int d = 0; d < 4; ++d) for (int r = 0; r < 16; ++r) o[d][r] *= al_l[crow(r, hi)]; } } while (0)
  f32x16 pA0, pA1, pB0, pB1; float mnA, mnB, alA, alB; bf16x8 pa0, pa1, pa2, pa3; const int NT = seq / KVBLK;
  constexpr int SE = 0, SO = SDEPTH - 1;
  SLOAD(SE, 0); asm volatile("s_waitcnt vmcnt(0)" ::: "memory"); SWRITE(0, SE); __syncthreads();
  qkt(pA0, pA1, K_lds, qr, r32, hi); partialSM(pA0, pA1, m_reg, mnA, alA);
  SLOAD(SO, KVBLK); if constexpr (SDEPTH == 2) { if (2 < NT) SLOAD(SE, 2 * KVBLK); }
  SWAIT(); SWRITE(1, SO); __syncthreads();
  for (int j = 1; j + 1 < NT; j += 2) {
    SBAR(); qkt(pB0, pB1, (bf16*)((char*)K_lds + SHM_K), qr, r32, hi);
    finishSM(pA0, pA1, alA, l_reg, pa0, pa1, pa2, pa3); SBAR();
    SLOAD(SO, (j + SDEPTH) * KVBLK); SBAR();
    pv_d0(o, vb0, pa0, pa1, pa2, pa3); partialSM(pB0, pB1, m_reg, mnB, alB);
    __syncthreads(); SWAIT(); SWRITE(0, SE);
    RESC(alB); __syncthreads();
    SBAR(); qkt(pA0, pA1, K_lds, qr, r32, hi);
    finishSM(pB0, pB1, alB, l_reg, pa0, pa1, pa2, pa3); SBAR();
    if (SDEPTH == 1 || j + 3 < NT) SLOAD(SE, (j + 1 + SDEPTH) * KVBLK); SBAR();
    pv_d0(o, vb0 + (int)SHM_V, pa0, pa1, pa2, pa3); partialSM(pA0, pA1, m_reg, mnA, alA);
    __syncthreads(); SWAIT(); SWRITE(1, SO);
    RESC(alA); __syncthreads();
  }
  SBAR(); qkt(pB0, pB1, (bf16*)((char*)K_lds + SHM_K), qr, r32, hi);
  finishSM(pA0, pA1, alA, l_reg, pa0, pa1, pa2, pa3); SBAR();
  pv_d0(o, vb0, pa0, pa1, pa2, pa3); partialSM(pB0, pB1, m_reg, mnB, alB);
  __syncthreads(); RESC(alB);
  finishSM(pB0, pB1, alB, l_reg, pa0, pa1, pa2, pa3); SBAR();
  pv_d0(o, vb0 + (int)SHM_V, pa0, pa1, pa2, pa3);
  if (hi == 0) li_l[r32] = l_reg; asm volatile("s_waitcnt lgkmcnt(0)" ::: "memory");
  float rli[16];
#pragma unroll
  for (int r = 0; r < 16; ++r) rli[r] = __builtin_amdgcn_rcpf(li_l[crow(r, hi)]);
  bf16* Ow = Ob + (long)(wid * QBLK) * LDO;
#pragma unroll
  for (int r = 0; r < 16; ++r) { int orow = crow(r, hi);
#pragma unroll
    for (int d0 = 0; d0 < 4; ++d0) Ow[(long)orow * LDO + d0 * 32 + r32] = f2bf(o[d0][r] * rli[r]); }
  __syncthreads();
#undef SLOAD
#undef SWRITE
#undef SWAIT
#undef RESC
}
}
struct Args { const float* in[N_IN]; float* out; unsigned char* ws; int lo, hi; };
struct Frame {
    LAS unsigned char* lds; unsigned char* lds_gen;
    int tid, lane, wave, G, bid;
    const float* const* in; float* out; unsigned char* ws;
};
__device__ __forceinline__ const float* fin_ptr(const float* const* tab, int i) {
    const unsigned long long p = (unsigned long long)tab[i];
    const unsigned lo = __builtin_amdgcn_readfirstlane((unsigned)p), hi = __builtin_amdgcn_readfirstlane((unsigned)(p >> 32));
    return (const float*)(const GAS float*)(((unsigned long long)hi << 32) | lo);
}
#define FIN(i) fin_ptr(F.in, (i))
__device__ __forceinline__ float* hrow_ptr(const Frame& F, int chunk, int r) {
    const int bl = r / TOK, pos = r - bl * TOK, b = chunk * BC + bl;
    return pos < CTX ? (float*)(F.ws + WS_HC) + ((size_t)(b * CTX + pos) << 10) : F.out + ((size_t)(b * SEQ + pos - CTX) << 10);
}
__device__ __forceinline__ const float* hrow_src(const float* lat, const float* ctxb, int chunk, int r) {
    const int bl = r / TOK, pos = r - bl * TOK, b = chunk * BC + bl;
    return pos < CTX ? ctxb + ((size_t)(b * CTX + pos) << 10) : lat + ((size_t)(b * SEQ + pos - CTX) << 10);
}
__device__ __forceinline__ int mod_row(int chunk, int r) { const int bl = r / TOK, pos = r - bl * TOK; return pos < CTX ? 16 : chunk * BC + bl; }
__device__ __forceinline__ const float* mod_ptr(const Frame& F, int l, int mrow, int part) { return (const float*)(F.ws + WS_MOD) + ((size_t)(l * 17 + mrow) * 6 + part) * DM; }

__device__ __forceinline__ void p_prologue(const Frame& F, const Args& args) {
#undef FIN
#define FIN(i) (args.in[i])
    if (F.bid == 0 && F.tid < N_IN) { const float* v = nullptr;
#pragma unroll
        for (int i = 0; i < N_IN; ++i) v = (F.tid == i) ? args.in[i] : v;
        ((const float**)(F.ws + WS_TAB))[F.tid] = v; }
    {
        float* ropc = (float*)(F.ws + WS_ROPE); float* rops = ropc + SEQ * 64;
        for (int i = F.bid * 512 + F.tid; i < SEQ * 64; i += F.G * 512) { const int t = i >> 6, pp = i & 63;
            const float inv = exp2f(-(float)(pp & 31) * (13.287712379549449f / 32.0f)), ang = (float)(pp < 32 ? t / GRIDW : t % GRIDW) * inv; float s, c; sincos_rr(ang, s, c);
            ropc[i] = c; rops[i] = s; }
    }
    LAS float* sl = (LAS float*)F.lds; LAS float* red = sl + 17 * DM;
    for (int cbk = F.bid; cbk < (DEPTH * 6 * DM) / 128; cbk += F.G) {
        __syncthreads();
        for (int i = F.tid; i < 17 * DM; i += 512) { const float v = i < 16 * DM ? FIN(I_C)[i] : FIN(I_CCTX)[i - 16 * DM]; sl[i] = silu_f(v); }
        __syncthreads();
        const int kq = F.tid >> 7, cn = F.tid & 127, col = cbk * 128 + cn, l = col / (6 * DM), n = col - l * 6 * DM;
        const float* w = FIN(I_MODW) + (size_t)l * DM * 6 * DM + (size_t)(256 * kq) * 6 * DM + n;
        float acc[17];
#pragma unroll
        for (int j = 0; j < 17; ++j) acc[j] = 0.f;
        for (int k0 = 0; k0 < 256; k0 += 8) { float wv[8];
#pragma unroll
            for (int q = 0; q < 8; ++q) wv[q] = w[(size_t)(k0 + q) * 6 * DM];
#pragma unroll
            for (int q = 0; q < 8; ++q)
#pragma unroll
                for (int j = 0; j < 17; ++j) acc[j] = fmaf(sl[j * DM + 256 * kq + k0 + q], wv[q], acc[j]); }
        if (kq > 0) {
#pragma unroll
            for (int j = 0; j < 17; ++j) red[((kq - 1) * 17 + j) * 128 + cn] = acc[j]; }
        __syncthreads();
        if (kq == 0) { const float bv = FIN(I_MODB)[l * 6 * DM + n]; float* mo = (float*)(F.ws + WS_MOD) + (size_t)l * 17 * 6 * DM + n;
#pragma unroll
            for (int j = 0; j < 17; ++j) mo[(size_t)j * 6 * DM] = acc[j] + red[(0 * 17 + j) * 128 + cn] + red[(1 * 17 + j) * 128 + cn] + red[(2 * 17 + j) * 128 + cn] + bv; }
    }
    __syncthreads();
#undef FIN
#define FIN(i) fin_ptr(F.in, (i))
}

__device__ __forceinline__ void transpose_item(const float* __restrict__ W, int N, int k0, int n0, bf16_t* dst  , int Kd, LAS float* scr, int lane, float wscale = 1.0f) {
    {
        int step = 2 * N; asm volatile("" : "+v"(step));
        const float* wp = W + (size_t)(k0 + (lane >> 5)) * N + n0 + (lane & 31);
        float v[32];
#pragma unroll
        for (int i = 0; i < 32; ++i) { v[i] = __builtin_nontemporal_load(wp); wp += step; }
#pragma unroll
        for (int i = 0; i < 32; ++i) scr[(2 * i + (lane >> 5)) * 33 + (lane & 31)] = v[i] * wscale;
    }
    LDS_WAIT(); asm volatile("" ::: "memory");
    const int c = lane & 7;
#pragma unroll
    for (int j = 0; j < 4; ++j) { const int n = (lane >> 3) + 8 * j; const LAS float* s = scr + (8 * c) * 33 + n;
        u32x4 o; o.x = cvt_pk_bf16_nv(s[0 * 33], s[1 * 33]); o.y = cvt_pk_bf16_nv(s[2 * 33], s[3 * 33]); o.z = cvt_pk_bf16_nv(s[4 * 33], s[5 * 33]); o.w = cvt_pk_bf16_nv(s[6 * 33], s[7 * 33]);
        *(u32x4*)(dst + (size_t)n * Kd + k0 + 8 * c) = o; }
    LDS_WAIT(); asm volatile("" ::: "memory");
}
__device__ __forceinline__ void quant_item(const float* __restrict__ W, int ldw, int n0, signed char* dst, float* sdst, LAS int* scr, int lane) {
    const int cn = lane & 31, hi = lane >> 5;
    const float* wp0 = W + (size_t)hi * ldw + n0 + cn;
    float mx = 0.f;
    for (int kb = 0; kb < 32; ++kb) { float v[16];
#pragma unroll
        for (int i = 0; i < 16; ++i) v[i] = wp0[(size_t)(32 * kb + 2 * i) * ldw];
#pragma unroll
        for (int i = 0; i < 16; ++i) mx = fmaxf(mx, fabsf(v[i])); }
    mx = fmaxf(mx, __shfl_xor(mx, 32));
    const float inv = mx > 0.f ? 127.0f / mx : 0.f;
    if (lane < 32) sdst[lane] = mx * (1.0f / 127.0f);
    for (int kc = 0; kc < 8; ++kc) {
#pragma unroll
        for (int hb = 0; hb < 4; ++hb) { float v[16];
#pragma unroll
            for (int i = 0; i < 16; ++i) v[i] = wp0[(size_t)(128 * kc + 32 * hb + 2 * i) * ldw];
#pragma unroll
            for (int i = 0; i < 16; ++i) scr[(32 * hb + 2 * i + hi) * 33 + cn] = (int)rintf(v[i] * inv); }
        LDS_WAIT(); asm volatile("" ::: "memory");
#pragma unroll
        for (int t = 0; t < 4; ++t) { const int chunk = lane + 64 * t, n = chunk >> 3, c16 = chunk & 7; const LAS int* s = scr + (16 * c16) * 33 + n; unsigned w[4];
#pragma unroll
            for (int q = 0; q < 4; ++q) w[q] = (unsigned)(s[(4 * q) * 33] & 255) | ((unsigned)(s[(4 * q + 1) * 33] & 255) << 8) | ((unsigned)(s[(4 * q + 2) * 33] & 255) << 16) | ((unsigned)(s[(4 * q + 3) * 33] & 255) << 24);
            u32x4 o; o.x = w[0]; o.y = w[1]; o.z = w[2]; o.w = w[3]; *(u32x4*)(dst + (size_t)n * DM + 128 * kc + 16 * c16) = o; }
        LDS_WAIT(); asm volatile("" ::: "memory");
    }
}
__device__ __forceinline__ void quant_item_wg(const Frame& F, const float* __restrict__ W, int ldw, int n0, signed char* dst, float* sdst, int par) {
    LAS int* scr = (LAS int*)(F.lds + F.wave * 16896); LAS float* cmx = (LAS float*)(F.lds + 8 * 16896) + par * 256;
    const int lane = F.lane, cn = lane & 31, hi = lane >> 5;
    int step = 2 * ldw; asm volatile("" : "+v"(step));
    const float* wp = W + (size_t)(128 * F.wave + hi) * ldw + n0 + cn;
    float v[64];
#pragma unroll
    for (int i = 0; i < 64; ++i) { v[i] = __builtin_nontemporal_load(wp); wp += step; }
    float mx = 0.f;
#pragma unroll
    for (int i = 0; i < 64; ++i) mx = fmaxf(mx, fabsf(v[i]));
    mx = fmaxf(mx, __shfl_xor(mx, 32));
    if (lane < 32) cmx[F.wave * 32 + lane] = mx;
    __syncthreads();
    float m = 0.f;
#pragma unroll
    for (int w = 0; w < 8; ++w) m = fmaxf(m, cmx[w * 32 + cn]);
    const float inv = m > 0.f ? 127.0f / m : 0.f;
    if (F.wave == 0 && lane < 32) sdst[lane] = m * (1.0f / 127.0f);
#pragma unroll
    for (int i = 0; i < 64; ++i) scr[(2 * i + hi) * 33 + cn] = (int)rintf(v[i] * inv);
    LDS_WAIT(); asm volatile("" ::: "memory");
#pragma unroll
    for (int t = 0; t < 4; ++t) { const int chunk = lane + 64 * t, n = chunk >> 3, c16 = chunk & 7; const LAS int* s = scr + (16 * c16) * 33 + n; unsigned w[4];
#pragma unroll
        for (int q = 0; q < 4; ++q) w[q] = (unsigned)(s[(4 * q) * 33] & 255) | ((unsigned)(s[(4 * q + 1) * 33] & 255) << 8) | ((unsigned)(s[(4 * q + 2) * 33] & 255) << 16) | ((unsigned)(s[(4 * q + 3) * 33] & 255) << 24);
        u32x4 o; o.x = w[0]; o.y = w[1]; o.z = w[2]; o.w = w[3]; *(u32x4*)(dst + (size_t)n * DM + 128 * F.wave + 16 * c16) = o; }
    LDS_WAIT(); asm volatile("" ::: "memory");
}
__device__ __forceinline__ void filt_unit(const Frame& F, int l, int n, int i0, bf16_t* FR) {
    const int lane = F.lane;
    const float* fw1 = FIN(I_FW1) + (size_t)l * 33 * 64; const float* fb1 = FIN(I_FB1) + l * 64;
    const float* fw2 = FIN(I_FW2) + (size_t)l * 64 * 64; const float* fb2 = FIN(I_FB2) + l * 64;
    const float* fw3 = FIN(I_FW3) + (size_t)l * 64 * 1024; const float* fq = FIN(I_FREQ) + l * 128;
    LAS bf16_t* T = (LAS bf16_t*)F.lds;
    float h2[4], tt[4], w1v[33];
#pragma unroll
    for (int q = 0; q < 33; ++q) w1v[q] = fw1[q * 64 + lane];
    const float b1v = fb1[lane], b2v = fb2[lane], f0v = fq[lane], f1v = fq[64 + lane];
    float w2v[64];
#pragma unroll
    for (int q = 0; q < 64; ++q) w2v[q] = fw2[q * 64 + lane];
    asm volatile("" ::: "memory");
#pragma unroll
    for (int p = 0; p < 4; ++p) { const int i = i0 + 4 * F.wave + p;
        const float t = (float)i / (float)(n - 1), w = (6.283185307179586f / (float)n) * (float)i; tt[p] = t;
        float a = b1v + t * w1v[0];
#pragma unroll
        for (int q = 0; q < 16; ++q) { const float f = 1e-4f + (float)q * ((15.0f - 1e-4f) / 15.0f); float s, c; sincos_rr(f * w, s, c);
            a = fmaf(c, w1v[1 + q], a); a = fmaf(-s, w1v[17 + q], a); }
        float sn, cs; sincos_rr(f0v * a, sn, cs); const float h1 = sn;
        float a2 = b2v;
#pragma unroll
        for (int q = 0; q < 64; ++q) a2 = fmaf(__shfl(h1, q), w2v[q], a2);
        sincos_rr(f1v * a2, sn, cs); h2[p] = sn; }
    float o[4][16];
#pragma unroll
    for (int p = 0; p < 4; ++p)
#pragma unroll
        for (int m = 0; m < 16; ++m) o[p][m] = 0.f;
    for (int q = 0; q < 64; q += 4) { float hq[4][4];
#pragma unroll
        for (int qq = 0; qq < 4; ++qq)
#pragma unroll
            for (int p = 0; p < 4; ++p) hq[qq][p] = __shfl(h2[p], q + qq);
        float wv[4][16];
#pragma unroll
        for (int qq = 0; qq < 4; ++qq)
#pragma unroll
            for (int m = 0; m < 16; ++m) wv[qq][m] = fw3[(q + qq) * 1024 + m * 64 + lane];
        asm volatile("" ::: "memory");
#pragma unroll
        for (int qq = 0; qq < 4; ++qq)
#pragma unroll
            for (int m = 0; m < 16; ++m)
#pragma unroll
                for (int p = 0; p < 4; ++p) o[p][m] = fmaf(hq[qq][p], wv[qq][m], o[p][m]); }
    const float mind = -3.0701134573253945f, maxd = -15.350567286626973f;
    __syncthreads();
#pragma unroll
    for (int m = 0; m < 8; ++m) { const int c = m * 64 + lane; const float dl = mind + (float)c * ((maxd - mind) / 511.0f);
#pragma unroll
        for (int p = 0; p < 4; ++p) { const float dec = __expf(tt[p] * dl);
            T[c * 34 + 4 * F.wave + p] = f2bf(o[p][m] * dec); T[(512 + c) * 34 + 4 * F.wave + p] = f2bf(o[p][m + 8] * dec); } }
    __syncthreads();
    const int CL = 2 * n + 16, pp = F.tid & 31, i = i0 + pp;
    for (int row = F.tid >> 5; row < 1024; row += 16) { const int dir = row >> 9, c = row & 511; float v = bf2f(T[row * 34 + pp]);
        if (i == 0) { if (dir) continue; v += bf2f(T[(512 + c) * 34 + pp]); }
        FR[(size_t)c * CL + (dir ? n + i : n - i)] = f2bf(v); }
}
__device__ __forceinline__ void p_weights(const Frame& F, int l) {
    LAS float* scr = (LAS float*)(F.lds + F.wave * 16896);
    const int gw = F.bid * 8 + F.wave, NGW = F.G * 8;
    constexpr int I_B = 16 * 32, I_C2 = 8 * 32, I_E = 16 * 32;
    constexpr int I_A = 0;
    constexpr int NITEMS = I_A + I_B + 2 * I_C2 + I_E;
    for (int u = F.bid; u < (SEQ + CTX) / 32; u += F.G) {
        if (u < SEQ / 32) filt_unit(F, l, SEQ, 32 * u, (bf16_t*)(F.ws + WS_FRL));
        else filt_unit(F, l, CTX, 32 * (u - SEQ / 32), (bf16_t*)(F.ws + WS_FRC));
    }
    __syncthreads();
    constexpr int NFB = (SEQ + CTX) / 32;
    const int nfw = (F.G > NFB ? NFB : F.G) * 8, now = (F.G > NFB ? F.G - NFB : 0) * 8, nslots = nfw + 3 * now;
    for (int sl0 = (F.bid < NFB ? gw : nfw + 3 * (gw - nfw)), rep3 = 0; rep3 < (F.bid < NFB ? 1 : 3); ++rep3)
    for (int it = sl0 + rep3; it < NITEMS; it += nslots) {
        int r = it;
        if (r < I_A) { const int kb = r / 128, nb = r % 128; transpose_item(FIN(I_WIN) + (size_t)l * DM * IN_TOTAL, IN_TOTAL, 64 * kb, 32 * nb, (bf16_t*)(F.ws + WS_WINB) + (size_t)(32 * nb) * DM, DM, scr, F.lane); continue; } r -= I_A;
        if (r < I_B) { const int kb = r / 32, nb = r % 32; transpose_item(FIN(I_WAO) + (size_t)l * DM * DM, DM, 64 * kb, 32 * nb, (bf16_t*)(F.ws + WS_WA) + (size_t)(32 * nb) * DM, DM, scr, F.lane, 1.0f / 255.0f); continue; } r -= I_B;
        if (r < I_C2) { const int kb = r / 32, nb = r % 32; transpose_item(FIN(I_WHO) + (size_t)l * 512 * DM, DM, 64 * kb, 32 * nb, (bf16_t*)(F.ws + WS_WH) + (size_t)(32 * nb) * 1024, 1024, scr, F.lane, 1.0f / 255.0f); continue; } r -= I_C2;
        if (r < I_C2) { const int kb = r / 32, nb = r % 32; transpose_item(FIN(I_WLO) + (size_t)l * 512 * DM, DM, 64 * kb, 32 * nb, (bf16_t*)(F.ws + WS_WH) + (size_t)(32 * nb) * 1024 + 512, 1024, scr, F.lane, 1.0f / 255.0f); continue; } r -= I_C2;
        { const int kb = r / 32, nb = r % 32; transpose_item(FIN(I_WOUT) + (size_t)l * DM * DM, DM, 64 * kb, 32 * nb, (bf16_t*)(F.ws + WS_WO) + (size_t)(32 * nb) * DM, DM, scr, F.lane); }
    }
    __syncthreads();
    { int par = 0;
      for (int nb = F.G - 1 - F.bid; nb < 224; nb += F.G, par ^= 1)
        quant_item_wg(F, FIN(I_WIN) + (size_t)l * DM * IN_TOTAL, IN_TOTAL, 32 * nb, (signed char*)(F.ws + WS_WIN) + (size_t)(32 * nb) * DM, (float*)(F.ws + WS_SWIN) + 32 * nb, par); }
    __syncthreads();
}
__device__ __forceinline__ void w_filters(const Frame& F, int l, int first) {
    if (F.G <= first) first = 0; if (F.bid < first) return;
    for (int u = F.bid - first; u < (SEQ + CTX) / 32; u += F.G - first) {
        if (u < SEQ / 32) filt_unit(F, l, SEQ, 32 * u, (bf16_t*)(F.ws + WS_FRL));
        else filt_unit(F, l, CTX, 32 * (u - SEQ / 32), (bf16_t*)(F.ws + WS_FRC));
    }
    __syncthreads();
}
__device__ __forceinline__ void w_quant_in(const Frame& F, int l, int first) {
    if (F.G <= first) first = 0; if (F.bid < first) return;
    __syncthreads();
    int par = 0;
    for (int nb = F.bid - first; nb < 224; nb += F.G - first, par ^= 1)
        quant_item_wg(F, FIN(I_WIN) + (size_t)l * DM * IN_TOTAL, IN_TOTAL, 32 * nb, (signed char*)(F.ws + WS_WIN) + (size_t)(32 * nb) * DM, (float*)(F.ws + WS_SWIN) + 32 * nb, par);
    __syncthreads();
}
__device__ __forceinline__ void w_transposes(const Frame& F, int l, int first) {
    if (F.G <= first) first = 0; if (F.bid < first) return;
    LAS float* scr = (LAS float*)(F.lds + F.wave * 16896);
    constexpr int I_B = 16 * 32, I_C2 = 8 * 32, I_E = 16 * 32, NITEMS = I_B + 2 * I_C2 + I_E;
    for (int it = (F.bid - first) * 8 + F.wave; it < NITEMS; it += (F.G - first) * 8) {
        int r = it;
        if (r < I_B) { const int kb = r / 32, nb = r % 32; transpose_item(FIN(I_WAO) + (size_t)l * DM * DM, DM, 64 * kb, 32 * nb, (bf16_t*)(F.ws + WS_WA) + (size_t)(32 * nb) * DM, DM, scr, F.lane, 1.0f / 255.0f); continue; } r -= I_B;
        if (r < I_C2) { const int kb = r / 32, nb = r % 32; transpose_item(FIN(I_WHO) + (size_t)l * 512 * DM, DM, 64 * kb, 32 * nb, (bf16_t*)(F.ws + WS_WH) + (size_t)(32 * nb) * 1024, 1024, scr, F.lane, 1.0f / 255.0f); continue; } r -= I_C2;
        if (r < I_C2) { const int kb = r / 32, nb = r % 32; transpose_item(FIN(I_WLO) + (size_t)l * 512 * DM, DM, 64 * kb, 32 * nb, (bf16_t*)(F.ws + WS_WH) + (size_t)(32 * nb) * 1024 + 512, 1024, scr, F.lane, 1.0f / 255.0f); continue; } r -= I_C2;
        { const int kb = r / 32, nb = r % 32; transpose_item(FIN(I_WOUT) + (size_t)l * DM * DM, DM, 64 * kb, 32 * nb, (bf16_t*)(F.ws + WS_WO) + (size_t)(32 * nb) * DM, DM, scr, F.lane); }
    }
}
__device__ __forceinline__ bool exp_wave(const Frame& F, int l, int& j, int& pw) {
    const int first = (l == DEPTH - 1 || F.G <= 64) ? 0 : 64;
    j = (F.bid - first) * 8 + F.wave; pw = (F.G - first) * 8; return F.bid >= first; }
__device__ __forceinline__ void p_weights_exp13(const Frame& F, int l) {
    int j, pw; if (!exp_wave(F, l, j, pw)) return;
    int par = 0;
    for (int it = j >> 3; it < 2 * NE * 32; it += (pw >> 3), par ^= 1) {
        const int which = it / (NE * 32), e = (it / 32) % NE, nb = it % 32, n0 = 32 * nb, drow = 256 * (n0 >> 7) + 128 * which + (n0 & 127);
        quant_item_wg(F, FIN(which ? I_EW3 : I_EW1) + ((size_t)l * NE + e) * DM * DM, DM, n0, (signed char*)(F.ws + WS_W13) + ((size_t)e * 2048 + drow) * DM, (float*)(F.ws + WS_SW13) + (size_t)e * 2048 + drow, par); }
    __syncthreads();
}
__device__ __forceinline__ void p_weights_exp2(const Frame& F, int l) {
    LAS float* scr = (LAS float*)(F.lds + F.wave * 16896); int j, pw; if (!exp_wave(F, l, j, pw)) return;
    for (int r = j; r < NE * 512; r += pw) { const int e = r / 512, q = r % 512, kb = q / 32, nb = q % 32;
        transpose_item(FIN(I_EW2) + ((size_t)l * NE + e) * DM * DM, DM, 64 * kb, 32 * nb, (bf16_t*)(F.ws + WS_W2) + ((size_t)e * DM + 32 * nb) * DM, DM, scr, F.lane); }
}


template <bool ROUTE, bool COMBINE>
__device__ __forceinline__ void p_norm(const Frame& F, int l, int chunk, const float* gain, int part_shift, int part_scale, bf16_t* U, float* AFF, int lc = 0, const int* INV = nullptr, const bf16_t* YS = nullptr, const float* xsrc = nullptr, const float* csrc = nullptr, const bf16_t* DLT = nullptr, bool dlt_skip_ctx = false, signed char* UQ = nullptr, float* SU = nullptr) {
    bf16_t* HB = (bf16_t*)(F.ws + WS_CH + CH_HRES);
    constexpr int R = ROUTE ? 1 : 2;
    LAS float* rw = (LAS float*)F.lds;
    if (ROUTE) { const float* r = FIN(I_ROUT) + (size_t)l * DM * NE;
        for (int i = F.tid; i < DM * NE; i += 512) { const int col = i >> 4, e = i & 15; rw[e * DM + col] = r[i]; }
        __syncthreads(); }
    const int gw = F.bid * 8 + F.wave, NGW = F.G * 8, lane = F.lane;
    f32x4 gq[4];
#pragma unroll
    for (int j = 0; j < 4; ++j) gq[j] = ((const f32x4*)gain)[lane + 64 * j];
    const bool pf = ROUTE && xsrc == nullptr && DLT != nullptr;
    u32x2 pt[4], pd[4]; f32x4 psh[4], psc[4];
#pragma unroll
    for (int j = 0; j < 4; ++j) { pt[j] = (u32x2){0u, 0u}; pd[j] = (u32x2){0u, 0u}; psh[j] = (f32x4){0.f, 0.f, 0.f, 0.f}; psc[j] = (f32x4){0.f, 0.f, 0.f, 0.f}; }
    if (pf && gw * R < RC) { const u32x2* hb = (const u32x2*)(HB + (size_t)(gw * R) * DM) + lane; const u32x2* dp = (const u32x2*)(DLT + (size_t)(gw * R) * DM) + lane;
        const int mrn = mod_row(chunk, gw * R); const f32x4* shp = (const f32x4*)mod_ptr(F, l, mrn, part_shift) + lane; const f32x4* scp = (const f32x4*)mod_ptr(F, l, mrn, part_scale) + lane;
#pragma unroll
        for (int j = 0; j < 4; ++j) { pt[j] = hb[64 * j]; pd[j] = dp[64 * j]; psh[j] = shp[64 * j]; psc[j] = scp[64 * j]; } }
    const bool pf1 = !ROUTE && COMBINE && xsrc == nullptr;
    u32x2 qt[R][4]; int qx[R];
#pragma unroll
    for (int q = 0; q < R; ++q) { qx[q] = -1;
#pragma unroll
        for (int j = 0; j < 4; ++j) qt[q][j] = (u32x2){0u, 0u}; }
    if (pf1) {
#pragma unroll
        for (int q = 0; q < R; ++q) { const int r = gw * R + q < RC ? gw * R + q : RC - 1; const u32x2* hb = (const u32x2*)(HB + (size_t)r * DM) + lane;
#pragma unroll
            for (int j = 0; j < 4; ++j) qt[q][j] = hb[64 * j];
            qx[q] = INV[(size_t)r * NE + (lane & 15)]; } }
    for (int r0 = gw * R; r0 < RC; r0 += NGW * R) {
        f32x4 v[R][4]; int mr[R];
        u32x2 ct[4], cd[4]; u32x2 c1[R][4]; int cx[R]; f32x4 csh[4], csc[4];
        if (pf1) {
#pragma unroll
            for (int q = 0; q < R; ++q) { cx[q] = qx[q];
#pragma unroll
                for (int j = 0; j < 4; ++j) c1[q][j] = qt[q][j]; } }
        if (pf) {
#pragma unroll
            for (int j = 0; j < 4; ++j) { ct[j] = pt[j]; cd[j] = pd[j]; csh[j] = psh[j]; csc[j] = psc[j]; } }
#pragma unroll
        for (int q = 0; q < R; ++q) { const int r = r0 + q < RC ? r0 + q : RC - 1; mr[q] = mod_row(chunk, r);
            if (xsrc) { const f32x4* hp = (const f32x4*)hrow_src(xsrc, csrc, chunk, r) + lane;
#pragma unroll
                for (int j = 0; j < 4; ++j) v[q][j] = hp[64 * j]; }
            else { const u32x2* hb = (const u32x2*)(HB + (size_t)r * DM) + lane; u32x2 t[4];
                if (pf) {
#pragma unroll
                    for (int j = 0; j < 4; ++j) t[j] = ct[j]; }
                else if (pf1) {
#pragma unroll
                    for (int j = 0; j < 4; ++j) t[j] = c1[q][j]; }
                else {
#pragma unroll
                for (int j = 0; j < 4; ++j) t[j] = hb[64 * j]; }
#pragma unroll
                for (int j = 0; j < 4; ++j) v[q][j] = (f32x4){bflo(t[j].x), bfhi(t[j].x), bflo(t[j].y), bfhi(t[j].y)}; } }
        if (DLT) {
#pragma unroll
            for (int q = 0; q < R; ++q) { const int r = r0 + q; if (r >= RC) break; if (dlt_skip_ctx && mr[q] == 16) continue;
                const u32x2* dp = (const u32x2*)(DLT + (size_t)r * DM) + lane; u32x2 dv[4];
                if (pf) {
#pragma unroll
                    for (int j = 0; j < 4; ++j) dv[j] = cd[j]; }
                else {
#pragma unroll
                for (int j = 0; j < 4; ++j) dv[j] = dp[64 * j]; }
                u32x2* hw = (u32x2*)(HB + (size_t)r * DM) + lane;
#pragma unroll
                for (int j = 0; j < 4; ++j) { v[q][j].x += bflo(dv[j].x); v[q][j].y += bfhi(dv[j].x); v[q][j].z += bflo(dv[j].y); v[q][j].w += bfhi(dv[j].y);
                    u32x2 w; w.x = cvt_pk_bf16_nv(v[q][j].x, v[q][j].y); w.y = cvt_pk_bf16_nv(v[q][j].z, v[q][j].w); hw[64 * j] = w; } }
        }
        if (COMBINE) {
#pragma unroll
            for (int q = 0; q < R; ++q) { const int r = r0 + q; if (r >= RC) break;
                f32x4 acc[4];
#pragma unroll
                for (int j = 0; j < 4; ++j) acc[j] = (f32x4){0.f, 0.f, 0.f, 0.f};
                const int xl = pf1 ? cx[q] : INV[(size_t)r * NE + (lane & 15)];
                unsigned mk = (unsigned)__ballot(xl >= 0) & 0xffffu;
                const bool any = mk != 0u;
                while (mk) {
                    const int e0 = __builtin_ctz(mk); mk &= mk - 1u; const bool two = mk != 0u; const int e1 = two ? __builtin_ctz(mk) : e0; if (two) mk &= mk - 1u;
                    const int x0 = __builtin_amdgcn_readlane(xl, e0), x1 = __builtin_amdgcn_readlane(xl, e1); const float w1 = two ? 1.f : 0.f;
                    const u32x2* y0 = (const u32x2*)(YS + ((size_t)e0 * XROWS + x0) * 1024) + lane; const u32x2* y1 = (const u32x2*)(YS + ((size_t)e1 * XROWS + x1) * 1024) + lane;
                    u32x2 a[4], b[4];
#pragma unroll
                    for (int j = 0; j < 4; ++j) { a[j] = y0[64 * j]; b[j] = y1[64 * j]; }
#pragma unroll
                    for (int j = 0; j < 4; ++j) { acc[j].x += bflo(a[j].x) + w1 * bflo(b[j].x); acc[j].y += bfhi(a[j].x) + w1 * bfhi(b[j].x); acc[j].z += bflo(a[j].y) + w1 * bflo(b[j].y); acc[j].w += bfhi(a[j].y) + w1 * bfhi(b[j].y); }
                }
                if (any) { const f32x4* g2 = (const f32x4*)mod_ptr(F, lc, mr[q], 5) + lane; u32x2* hw = (u32x2*)(HB + (size_t)r * DM) + lane;
#pragma unroll
                    for (int j = 0; j < 4; ++j) { v[q][j] = v[q][j] + g2[64 * j] * acc[j]; u32x2 w; w.x = cvt_pk_bf16_nv(v[q][j].x, v[q][j].y); w.y = cvt_pk_bf16_nv(v[q][j].z, v[q][j].w); hw[64 * j] = w; } }
            }
        }
        float rstd[R]; f32x4 shq[R][4], scq[R][4];
#pragma unroll
        for (int q = 0; q < R; ++q) { float ss = 0.f;
#pragma unroll
            for (int j = 0; j < 4; ++j) ss += (v[q][j].x * v[q][j].x + v[q][j].y * v[q][j].y) + (v[q][j].z * v[q][j].z + v[q][j].w * v[q][j].w);
            rstd[q] = rsqrtf(wave_sum(ss) * (1.f / DM) + NORM_EPS);
            const f32x4* shp = (const f32x4*)mod_ptr(F, l, mr[q], part_shift) + lane; const f32x4* scp = (const f32x4*)mod_ptr(F, l, mr[q], part_scale) + lane;
            if (pf) {
#pragma unroll
                for (int j = 0; j < 4; ++j) { shq[q][j] = csh[j]; scq[q][j] = csc[j]; } }
            else {
#pragma unroll
            for (int j = 0; j < 4; ++j) { shq[q][j] = shp[64 * j]; scq[q][j] = scp[64 * j]; } } }
        if (pf1) { const int rn0 = r0 + NGW * R;
            if (rn0 < RC) {
#pragma unroll
                for (int q = 0; q < R; ++q) { const int r = rn0 + q < RC ? rn0 + q : RC - 1; const u32x2* hb = (const u32x2*)(HB + (size_t)r * DM) + lane;
#pragma unroll
                    for (int j = 0; j < 4; ++j) qt[q][j] = hb[64 * j];
                    qx[q] = INV[(size_t)r * NE + (lane & 15)]; } } }
        if (pf) { const int rn = r0 + NGW * R;
            if (rn < RC) { const u32x2* hb = (const u32x2*)(HB + (size_t)rn * DM) + lane; const u32x2* dp = (const u32x2*)(DLT + (size_t)rn * DM) + lane;
                const int mrn = mod_row(chunk, rn); const f32x4* shp = (const f32x4*)mod_ptr(F, l, mrn, part_shift) + lane; const f32x4* scp = (const f32x4*)mod_ptr(F, l, mrn, part_scale) + lane;
#pragma unroll
                for (int j = 0; j < 4; ++j) { pt[j] = hb[64 * j]; pd[j] = dp[64 * j]; psh[j] = shp[64 * j]; psc[j] = scp[64 * j]; } } }
        asm volatile("" ::: "memory");
        float lg[ROUTE ? R : 1][16]; f32x2 lgp[ROUTE ? R : 1][16];
        unsigned rwo = 0u; if (ROUTE) asm volatile("" : "+v"(rwo));
        if (ROUTE) {
#pragma unroll
            for (int q = 0; q < R; ++q)
#pragma unroll
                for (int e = 0; e < 16; ++e) { lg[q][e] = 0.f; lgp[q][e] = (f32x2){0.f, 0.f}; } }
        float qinv[R]; const bool qout = UQ != nullptr;
        if (qout) {
#pragma unroll
            for (int q = 0; q < R; ++q) { float mx = 0.f;
#pragma unroll
                for (int j = 0; j < 4; ++j) { f32x4 y = v[q][j] * rstd[q] * gq[j]; y = y * (scq[q][j] + 1.0f) + shq[q][j]; mx = fmaxf(mx, fmaxf(fmaxf(fabsf(y.x), fabsf(y.y)), fmaxf(fabsf(y.z), fabsf(y.w)))); }
                mx = fmaxf(mx, dpp_f<0xB1>(mx)); mx = fmaxf(mx, dpp_f<0x4E>(mx)); mx = fmaxf(mx, dpp_f<0x141>(mx)); mx = fmaxf(mx, dpp_f<0x140>(mx));
                mx = fmaxf(mx, __shfl_xor(mx, 16)); mx = fmaxf(mx, __shfl_xor(mx, 32));
                qinv[q] = mx > 0.f ? 127.0f / mx : 0.f;
                if (lane == 0 && r0 + q < RC) SU[r0 + q] = mx * (1.0f / 127.0f); } }
#pragma unroll
        for (int j = 0; j < 4; ++j) { f32x4 y[R];
#pragma unroll
            for (int q = 0; q < R; ++q) { y[q] = v[q][j] * rstd[q] * gq[j]; y[q] = y[q] * (scq[q][j] + 1.0f) + shq[q][j];
                if (r0 + q < RC) {
                    if (U) { u32x2 w; w.x = cvt_pk_bf16_nv(y[q].x, y[q].y); w.y = cvt_pk_bf16_nv(y[q].z, y[q].w); ((u32x2*)(U + (size_t)(r0 + q) * DM))[lane + 64 * j] = w; }
                    if (qout) { const int a0 = (int)rintf(y[q].x * qinv[q]), a1 = (int)rintf(y[q].y * qinv[q]), a2 = (int)rintf(y[q].z * qinv[q]), a3 = (int)rintf(y[q].w * qinv[q]);
                        ((unsigned*)(UQ + (size_t)(r0 + q) * DM))[lane + 64 * j] = (unsigned)(a0 & 255) | ((unsigned)(a1 & 255) << 8) | ((unsigned)(a2 & 255) << 16) | ((unsigned)(a3 & 255) << 24); }
                } }
            if (ROUTE) {
#pragma unroll
                for (int e = 0; e < 16; ++e) { const f32x4 wv = *(const LAS f32x4*)(rw + rwo + e * DM + 256 * j + 4 * lane);
#pragma unroll
                    for (int q = 0; q < R; ++q) { lgp[q][e] = __builtin_elementwise_fma((f32x2){y[q].x, y[q].y}, (f32x2){wv.x, wv.y}, lgp[q][e]); lgp[q][e] = __builtin_elementwise_fma((f32x2){y[q].z, y[q].w}, (f32x2){wv.z, wv.w}, lgp[q][e]); }
                    if ((e & 7) == 7) asm volatile("" ::: "memory"); } } }
        if (ROUTE) {
#pragma unroll
            for (int q = 0; q < R; ++q)
#pragma unroll
                for (int e = 0; e < 16; ++e) lg[q][e] = lgp[q][e].x + lgp[q][e].y;
#pragma unroll
            for (int q = 0; q < R; ++q) {
                float t8[8], t4[4], t2[2], t1;
                { const bool up = (lane & 32) != 0;
#pragma unroll
                  for (int k = 0; k < 8; ++k) { const float send = up ? lg[q][k] : lg[q][k + 8], keep = up ? lg[q][k + 8] : lg[q][k]; t8[k] = keep + __shfl_xor(send, 32); } }
                { const bool up = (lane & 16) != 0;
#pragma unroll
                  for (int k = 0; k < 4; ++k) { const float send = up ? t8[k] : t8[k + 4], keep = up ? t8[k + 4] : t8[k]; t4[k] = keep + __shfl_xor(send, 16); } }
                { const bool up = (lane & 8) != 0;
#pragma unroll
                  for (int k = 0; k < 2; ++k) { const float send = up ? t4[k] : t4[k + 2], keep = up ? t4[k + 2] : t4[k]; t2[k] = keep + __shfl_xor(send, 8); } }
                { const bool up = (lane & 4) != 0; const float send = up ? t2[0] : t2[1], keep = up ? t2[1] : t2[0]; t1 = keep + __shfl_xor(send, 4); }
                t1 += __shfl_xor(t1, 2); t1 += __shfl_xor(t1, 1);
                float mx = t1; mx = fmaxf(mx, __shfl_xor(mx, 4)); mx = fmaxf(mx, __shfl_xor(mx, 8)); mx = fmaxf(mx, __shfl_xor(mx, 16)); mx = fmaxf(mx, __shfl_xor(mx, 32));
                const float ex = __expf(t1 - mx); float den = ex; den += __shfl_xor(den, 4); den += __shfl_xor(den, 8); den += __shfl_xor(den, 16); den += __shfl_xor(den, 32);
                const int e = ((lane >> 5) & 1) * 8 + ((lane >> 4) & 1) * 4 + ((lane >> 3) & 1) * 2 + ((lane >> 2) & 1);
                if ((lane & 3) == 0 && r0 + q < RC) AFF[(size_t)(r0 + q) * NE + e] = ex * __builtin_amdgcn_rcpf(den);
            }
        }
    }
    if (ROUTE) __syncthreads();
}

__device__ __forceinline__ int win_tile(int t, int sel) { return sel == 1 ? (t < 6 ? t : t + 6) : sel == 2 ? (t < 6 ? t + 6 : t + 8) : t; }
struct GemmPlain { static constexpr int NSEG = 1; const bf16_t* A; const bf16_t* Bt; int K; int tsel = 0; static constexpr bool GATHER = false; static constexpr int ESZ = 2;
    __device__ __forceinline__ const char* a_tile(const pg8::Unit& u) const { return (const char*)A + (size_t)u.pm * 256 * K * 2; }
    __device__ __forceinline__ const char* b_tile(const pg8::Unit& u) const { return (const char*)Bt + (size_t)win_tile(u.pn, tsel) * 256 * K * 2; } };
constexpr int XPAN = XROWS / 256;
struct GemmExpert { static constexpr int NSEG = 1; const bf16_t* A; const bf16_t* Bt; int K; int nrows_b; static constexpr bool GATHER = false; static constexpr int ESZ = 2;
    __device__ __forceinline__ const char* a_tile(const pg8::Unit& u) const { return (const char*)A + (size_t)u.pm * 256 * K * 2; }
    __device__ __forceinline__ const char* b_tile(const pg8::Unit& u) const { const int e = u.pm / XPAN; return (const char*)Bt + ((size_t)e * nrows_b + (size_t)u.pn * 256) * K * 2; } };
struct GemmExpertGather { static constexpr int NSEG = 1; const bf16_t* A; const int* rowsrc; const bf16_t* Bt; int K; int nrows_b; static constexpr bool GATHER = true; static constexpr int ESZ = 2;
    __device__ __forceinline__ const char* a_tile(const pg8::Unit&) const { return (const char*)A; }
    __device__ __forceinline__ int a_row(const pg8::Unit& u, int r) const { return rowsrc[u.pm * 256 + r]; }
    __device__ __forceinline__ const char* b_tile(const pg8::Unit& u) const { const int e = u.pm / XPAN; return (const char*)Bt + ((size_t)e * nrows_b + (size_t)u.pn * 256) * K * 2; } };

struct GemmPlainQ { static constexpr int NSEG = 1; const signed char* A; const signed char* Bt; int K; int tsel = 0; static constexpr bool GATHER = false; static constexpr int ESZ = 1;
    __device__ __forceinline__ const char* a_tile(const pg8::Unit& u) const { return (const char*)A + (size_t)u.pm * 256 * K; }
    __device__ __forceinline__ const char* b_tile(const pg8::Unit& u) const { return (const char*)Bt + (size_t)win_tile(u.pn, tsel) * 256 * K; } };
struct GemmExpertGatherQ { static constexpr int NSEG = 1; const signed char* A; const int* rowsrc; const signed char* Bt; int K; int nrows_b; static constexpr bool GATHER = true; static constexpr int ESZ = 1;
    __device__ __forceinline__ const char* a_tile(const pg8::Unit&) const { return (const char*)A; }
    __device__ __forceinline__ int a_row(const pg8::Unit& u, int r) const { return rowsrc[u.pm * 256 + r]; }
    __device__ __forceinline__ const char* b_tile(const pg8::Unit& u) const { const int e = u.pm / XPAN; return (const char*)Bt + ((size_t)e * nrows_b + (size_t)u.pn * 256) * K; } };

struct EpiIn {
    static constexpr bool PERM = true, AFTER_DRAIN = false;
    unsigned char* ch; int pn_off; const float* su; const float* sw; int tsel = 0;
    __device__ __forceinline__ void operator()(const f32x4 (&acc)[2][2][4][2], const pg8::Unit& u, int wr, int wc, int fr, int fq) const {
        const int pn = win_tile(u.pn, tsel) + pn_off; bf16_t* base; int ld, ct, act = 0;
        if (pn < 4) { base = (bf16_t*)(ch + CH_Q); ld = 1024; ct = pn; }
        else if (pn == 4) { base = (bf16_t*)(ch + CH_K); ld = 256; ct = 0; }
        else if (pn == 5) { base = (bf16_t*)(ch + CH_V); ld = 256; ct = 0; }
        else if (pn < 12) { base = (bf16_t*)(ch + CH_HY); ld = 1536; ct = pn - 6; }
        else if (pn < 14) { base = (bf16_t*)(ch + CH_RX); ld = 512; ct = pn - 12; }
        else if (pn < 16) { base = (bf16_t*)(ch + CH_RG); ld = 512; ct = pn - 14; act = 1; }
        else { base = (bf16_t*)(ch + CH_GATE); ld = 3072; ct = pn - 16; act = 2; }
        const f32x4 one4 = {1.f, 1.f, 1.f, 1.f}; f32x4 sw0a = one4, sw0b = one4, sw1a = one4, sw1b = one4; float sxr[2][4];
        if (su) { const float* swp = sw + pn * 256 + wc * 32 + 8 * fq; sw0a = *(const f32x4*)swp; sw0b = *(const f32x4*)(swp + 4); sw1a = *(const f32x4*)(swp + 128); sw1b = *(const f32x4*)(swp + 132); }
#pragma unroll
        for (int ai = 0; ai < 2; ++ai)
#pragma unroll
            for (int m = 0; m < 4; ++m) sxr[ai][m] = su ? su[u.pm * 256 + wr * 64 + fr + ai * 128 + m * 16] : 1.f;
        const bool tiled = pn >= 16;
        const int etid = ((wr * 4 + wc) * 64) + fq * 16 + fr;
        int rl = wr * 64 + fr, cl = wc * 32 + 8 * fq; asm volatile("" : "+v"(rl), "+v"(cl));
        const int row0 = u.pm * 256 + rl, col0 = ct * 256 + cl;
#pragma unroll
        for (int ai = 0; ai < 2; ++ai)
#pragma unroll
            for (int m = 0; m < 4; ++m) { bf16_t* rowp = base + (size_t)(row0 + ai * 128 + m * 16) * ld + col0; u32x4 gpk = {0u, 0u, 0u, 0u};
#pragma unroll
                for (int bj = 0; bj < 2; ++bj) { f32x4 v0 = acc[ai][bj][m][0] * (bj ? sw1a : sw0a) * sxr[ai][m], v1 = acc[ai][bj][m][1] * (bj ? sw1b : sw0b) * sxr[ai][m];
                    if (act == 1) {
#pragma unroll
                        for (int j = 0; j < 4; ++j) { v0[j] = gelu_tanh_f(v0[j]); v1[j] = gelu_tanh_f(v1[j]); } }
                    else if (act == 2) {
#pragma unroll
                        for (int j = 0; j < 4; ++j) { v0[j] = sigmoid_f(v0[j]); v1[j] = sigmoid_f(v1[j]); } }
                    if (tiled) { unsigned lo = 0u, hi = 0u;
#pragma unroll
                        for (int j = 0; j < 4; ++j) { lo |= (unsigned)fmaxf(fmaf(255.0f, v0[j], 0.5f), 1.0f) << (8 * j); hi |= (unsigned)fmaxf(fmaf(255.0f, v1[j], 0.5f), 1.0f) << (8 * j); }
                        if (bj == 0) { gpk.x = lo; gpk.y = hi; } else { gpk.z = lo; gpk.w = hi; } }
                    else { u32x4 w; w.x = cvt_pk_bf16_nv(v0[0], v0[1]); w.y = cvt_pk_bf16_nv(v0[2], v0[3]); w.z = cvt_pk_bf16_nv(v1[0], v1[1]); w.w = cvt_pk_bf16_nv(v1[2], v1[3]);
                        *(u32x4*)(rowp + bj * 128) = w; } }
                if (tiled) *(u32x4*)((unsigned char*)base + ((((size_t)(u.pm * 12 + ct) * 8 + (ai * 4 + m)) * 512 + etid) << 4)) = gpk; }
    }
};
struct EpiPlain {
    static constexpr bool PERM = true, AFTER_DRAIN = false;
    bf16_t* O;
    __device__ __forceinline__ void operator()(const f32x4 (&acc)[2][2][4][2], const pg8::Unit& u, int wr, int wc, int fr, int fq) const {
        int rl = wr * 64 + fr, cl = wc * 32 + 8 * fq; asm volatile("" : "+v"(rl), "+v"(cl));
        const int row0 = u.pm * 256 + rl, col0 = u.pn * 256 + cl;
#pragma unroll
        for (int ai = 0; ai < 2; ++ai)
#pragma unroll
            for (int m = 0; m < 4; ++m)
#pragma unroll
                for (int bj = 0; bj < 2; ++bj) { const f32x4 v0 = acc[ai][bj][m][0], v1 = acc[ai][bj][m][1];
                    u32x4 w; w.x = cvt_pk_bf16_nv(v0[0], v0[1]); w.y = cvt_pk_bf16_nv(v0[2], v0[3]); w.z = cvt_pk_bf16_nv(v1[0], v1[1]); w.w = cvt_pk_bf16_nv(v1[2], v1[3]);
                    *(u32x4*)(O + (size_t)(row0 + ai * 128 + m * 16) * 1024 + col0 + bj * 128) = w; }
    }
};
template <bool ACCUM, bool FINAL> struct EpiMerge {
    static constexpr bool PERM = true, AFTER_DRAIN = false;
    bf16_t* Y; bf16_t* Yt; const unsigned char* gate; int sub;
    __device__ __forceinline__ void operator()(const f32x4 (&acc)[2][2][4][2], const pg8::Unit& u, int wr, int wc, int fr, int fq) const {
        int rl = wr * 64 + fr, cl = wc * 32 + 8 * fq, et = ((wr * 4 + wc) * 64) + fq * 16 + fr; asm volatile("" : "+v"(rl), "+v"(cl), "+v"(et));
        const int row0 = u.pm * 256 + rl, col0 = u.pn * 256 + cl;
        const unsigned char* gt = gate + (((size_t)(u.pm * 12 + 4 * sub + u.pn) * 8 * 512 + et) << 4); bf16_t* yt = Yt + (((size_t)(u.pm * 4 + u.pn) * 16 * 512 + et) << 3);
#pragma unroll
        for (int ai = 0; ai < 2; ++ai) {
            u32x4 gv[4], yv[4][2];
#pragma unroll
            for (int m = 0; m < 4; ++m) { gv[m] = *(const u32x4*)(gt + ((size_t)(ai * 4 + m) * 512 << 4));
#pragma unroll
                for (int bj = 0; bj < 2; ++bj) { const int k = ai * 8 + m * 2 + bj; if (ACCUM) yv[m][bj] = *(const u32x4*)(yt + ((size_t)k * 512 << 3)); } }
            asm volatile("" ::: "memory");
#pragma unroll
            for (int m = 0; m < 4; ++m)
#pragma unroll
                for (int bj = 0; bj < 2; ++bj) { const int k = ai * 8 + m * 2 + bj; const unsigned g0 = bj ? gv[m].z : gv[m].x, g1 = bj ? gv[m].w : gv[m].y;
                    f32x4 v0 = acc[ai][bj][m][0], v1 = acc[ai][bj][m][1];
                    v0[0] *= (float)(g0 & 255u); v0[1] *= (float)((g0 >> 8) & 255u); v0[2] *= (float)((g0 >> 16) & 255u); v0[3] *= (float)(g0 >> 24);
                    v1[0] *= (float)(g1 & 255u); v1[1] *= (float)((g1 >> 8) & 255u); v1[2] *= (float)((g1 >> 16) & 255u); v1[3] *= (float)(g1 >> 24);
                    if (ACCUM) { const u32x4 o = yv[m][bj]; v0[0] += bflo(o.x); v0[1] += bfhi(o.x); v0[2] += bflo(o.y); v0[3] += bfhi(o.y); v1[0] += bflo(o.z); v1[1] += bfhi(o.z); v1[2] += bflo(o.w); v1[3] += bfhi(o.w); }
                    u32x4 w; w.x = cvt_pk_bf16_nv(v0[0], v0[1]); w.y = cvt_pk_bf16_nv(v0[2], v0[3]); w.z = cvt_pk_bf16_nv(v1[0], v1[1]); w.w = cvt_pk_bf16_nv(v1[2], v1[3]);
                    if (FINAL) *(u32x4*)(Y + (size_t)(row0 + ai * 128 + m * 16) * 1024 + col0 + bj * 128) = w; else *(u32x4*)(yt + ((size_t)k * 512 << 3)) = w; }
            asm volatile("" ::: "memory");
        }
    }
};
struct GemmMerge { const bf16_t* A; const bf16_t* Bt; const bf16_t* A2; const bf16_t* Bt2; int K; static constexpr bool GATHER = false; static constexpr int ESZ = 2; static constexpr int NSEG = 2;
    __device__ __forceinline__ const char* a_tile(const pg8::Unit& u) const { return (const char*)A + (size_t)u.pm * 256 * K * 2; }
    __device__ __forceinline__ const char* b_tile(const pg8::Unit& u) const { return (const char*)Bt + (size_t)u.pn * 256 * K * 2; }
    __device__ __forceinline__ long seg_delta_a() const { return (long)((const char*)A2 - (const char*)A); }
    __device__ __forceinline__ long seg_delta_b() const { return (long)((const char*)Bt2 - (const char*)Bt); } };
struct EpiMergeFused {
    static constexpr bool PERM = true, AFTER_DRAIN = false;
    bf16_t* Y; const unsigned char* gate;
    __device__ __forceinline__ void mid(f32x4 (&acc)[2][2][4][2], const pg8::Unit& u, int stage, int wr, int wc, int fr, int fq) const {
        int et = ((wr * 4 + wc) * 64) + fq * 16 + fr; asm volatile("" : "+v"(et));
        const unsigned char* gn = gate + (((size_t)(u.pm * 12 + 4 * stage + u.pn) * 8 * 512 + et) << 4); const unsigned char* gd = gn + ((size_t)4 * 8 * 512 << 4);
        u32x4 nv[2][4], dv[2][4];
#pragma unroll
        for (int ai = 0; ai < 2; ++ai)
#pragma unroll
            for (int m = 0; m < 4; ++m) { nv[ai][m] = *(const u32x4*)(gn + ((size_t)(ai * 4 + m) * 512 << 4)); dv[ai][m] = *(const u32x4*)(gd + ((size_t)(ai * 4 + m) * 512 << 4)); }
        asm volatile("" ::: "memory");
#pragma unroll
        for (int ai = 0; ai < 2; ++ai)
#pragma unroll
            for (int m = 0; m < 4; ++m)
#pragma unroll
                for (int bj = 0; bj < 2; ++bj) { const unsigned n0 = bj ? nv[ai][m].z : nv[ai][m].x, n1 = bj ? nv[ai][m].w : nv[ai][m].y, d0 = bj ? dv[ai][m].z : dv[ai][m].x, d1 = bj ? dv[ai][m].w : dv[ai][m].y;
#pragma unroll
                    for (int j = 0; j < 4; ++j) { acc[ai][bj][m][0][j] *= (float)((n0 >> (8 * j)) & 255u) * __builtin_amdgcn_rcpf((float)((d0 >> (8 * j)) & 255u));
                                                  acc[ai][bj][m][1][j] *= (float)((n1 >> (8 * j)) & 255u) * __builtin_amdgcn_rcpf((float)((d1 >> (8 * j)) & 255u)); }
                    __builtin_amdgcn_sched_barrier(0); }
        asm volatile("" ::: "memory");
    }
    __device__ __forceinline__ void operator()(const f32x4 (&acc)[2][2][4][2], const pg8::Unit& u, int wr, int wc, int fr, int fq) const {
        int rl = wr * 64 + fr, cl = wc * 32 + 8 * fq, et = ((wr * 4 + wc) * 64) + fq * 16 + fr; asm volatile("" : "+v"(rl), "+v"(cl), "+v"(et));
        const int row0 = u.pm * 256 + rl, col0 = u.pn * 256 + cl;
        const unsigned char* gt = gate + (((size_t)(u.pm * 12 + 8 + u.pn) * 8 * 512 + et) << 4);
#pragma unroll
        for (int ai = 0; ai < 2; ++ai) { u32x4 gv[4];
#pragma unroll
            for (int m = 0; m < 4; ++m) gv[m] = *(const u32x4*)(gt + ((size_t)(ai * 4 + m) * 512 << 4));
            asm volatile("" ::: "memory");
#pragma unroll
            for (int m = 0; m < 4; ++m)
#pragma unroll
                for (int bj = 0; bj < 2; ++bj) { const unsigned g0 = bj ? gv[m].z : gv[m].x, g1 = bj ? gv[m].w : gv[m].y;
                    f32x4 v0 = acc[ai][bj][m][0], v1 = acc[ai][bj][m][1];
                    v0[0] *= (float)(g0 & 255u); v0[1] *= (float)((g0 >> 8) & 255u); v0[2] *= (float)((g0 >> 16) & 255u); v0[3] *= (float)(g0 >> 24);
                    v1[0] *= (float)(g1 & 255u); v1[1] *= (float)((g1 >> 8) & 255u); v1[2] *= (float)((g1 >> 16) & 255u); v1[3] *= (float)(g1 >> 24);
                    u32x4 w; w.x = cvt_pk_bf16_nv(v0[0], v0[1]); w.y = cvt_pk_bf16_nv(v0[2], v0[3]); w.z = cvt_pk_bf16_nv(v1[0], v1[1]); w.w = cvt_pk_bf16_nv(v1[2], v1[3]);
                    *(u32x4*)(Y + (size_t)(row0 + ai * 128 + m * 16) * 1024 + col0 + bj * 128) = w; }
            asm volatile("" ::: "memory");
        }
    }
};
struct EpiDelta {
    static constexpr bool PERM = true, AFTER_DRAIN = false;
    bf16_t* DLT; const float* modl; int chunk;
    __device__ __forceinline__ void operator()(const f32x4 (&acc)[2][2][4][2], const pg8::Unit& u, int wr, int wc, int fr, int fq) const {
        const int bl = u.pm / 17, p = u.pm - bl * 17, b = chunk * BC + bl;
        const float* g1 = modl + ((size_t)(p == 0 ? 16 : b) * 6 + 2) * DM;
        int rl = wr * 64 + fr, cl = wc * 32 + 8 * fq; asm volatile("" : "+v"(rl), "+v"(cl));
        const int row0 = u.pm * 256 + rl, col0 = u.pn * 256 + cl;
        f32x4 gv[2][2];
#pragma unroll
        for (int bj = 0; bj < 2; ++bj)
#pragma unroll
            for (int n = 0; n < 2; ++n) gv[bj][n] = *(const f32x4*)(g1 + col0 + bj * 128 + 4 * n);
#pragma unroll
        for (int ai = 0; ai < 2; ++ai)
#pragma unroll
            for (int m = 0; m < 4; ++m) { bf16_t* rowp = DLT + (size_t)(row0 + ai * 128 + m * 16) * 1024 + col0;
#pragma unroll
                for (int bj = 0; bj < 2; ++bj) { const f32x4 v0 = acc[ai][bj][m][0] * gv[bj][0], v1 = acc[ai][bj][m][1] * gv[bj][1];
                    u32x4 w; w.x = cvt_pk_bf16_nv(v0[0], v0[1]); w.y = cvt_pk_bf16_nv(v0[2], v0[3]); w.z = cvt_pk_bf16_nv(v1[0], v1[1]); w.w = cvt_pk_bf16_nv(v1[2], v1[3]);
                    *(u32x4*)(rowp + bj * 128) = w; } }
    }
};
struct EpiResid {
    static constexpr bool PERM = false, AFTER_DRAIN = false;
    float* out; float* hc; const float* modl; int chunk; const float* rin; const float* rinc;
    __device__ __forceinline__ void operator()(const f32x4 (&acc)[2][2][4][2], const pg8::Unit& u, int wr, int wc, int fr, int fq) const {
        const int bl = u.pm / 17, p = u.pm - bl * 17, b = chunk * BC + bl;
        float* tb = p == 0 ? hc + ((size_t)(b * CTX) << 10) : out + ((size_t)(b * SEQ + (p - 1) * 256) << 10);
        const float* tr = p == 0 ? rinc + ((size_t)(b * CTX) << 10) : rin + ((size_t)(b * SEQ + (p - 1) * 256) << 10);
        const float* g1 = modl + ((size_t)(p == 0 ? 16 : b) * 6 + 2) * DM;
        int rl = wr * 64 + fr, cl = wc * 32 + 4 * fq; asm volatile("" : "+v"(rl), "+v"(cl));
        const int row0 = rl, col0 = u.pn * 256 + cl;
        f32x4 gv[2][2];
#pragma unroll
        for (int bj = 0; bj < 2; ++bj)
#pragma unroll
            for (int n = 0; n < 2; ++n) gv[bj][n] = *(const f32x4*)(g1 + col0 + bj * 128 + n * 16);
#pragma unroll
        for (int ai = 0; ai < 2; ++ai) {
            f32x4 hv[4][2][2];
#pragma unroll
            for (int m = 0; m < 4; ++m)
#pragma unroll
                for (int bj = 0; bj < 2; ++bj)
#pragma unroll
                    for (int n = 0; n < 2; ++n) hv[m][bj][n] = *(const f32x4*)(tr + (size_t)(row0 + ai * 128 + m * 16) * DM + col0 + bj * 128 + n * 16);
            asm volatile("" ::: "memory");
#pragma unroll
            for (int m = 0; m < 4; ++m)
#pragma unroll
                for (int bj = 0; bj < 2; ++bj)
#pragma unroll
                    for (int n = 0; n < 2; ++n) *(f32x4*)(tb + (size_t)(row0 + ai * 128 + m * 16) * DM + col0 + bj * 128 + n * 16) = hv[m][bj][n] + gv[bj][n] * acc[ai][bj][m][n];
            asm volatile("" ::: "memory");
        }
    }
};
struct EpiSwiglu {
    static constexpr bool PERM = true, AFTER_DRAIN = false;
    bf16_t* HID;
    __device__ __forceinline__ void operator()(const f32x4 (&acc)[2][2][4][2], const pg8::Unit& u, int wr, int wc, int fr, int fq) const {
        int rl = wr * 64 + fr, cl = wc * 32 + 8 * fq; asm volatile("" : "+v"(rl), "+v"(cl));
        const int row0 = u.pm * 256 + rl, col0 = u.pn * 128 + cl;
#pragma unroll
        for (int ai = 0; ai < 2; ++ai)
#pragma unroll
            for (int m = 0; m < 4; ++m) { f32x4 v0, v1;
#pragma unroll
                for (int j = 0; j < 4; ++j) { v0[j] = silu_f(acc[ai][0][m][0][j]) * acc[ai][1][m][0][j]; v1[j] = silu_f(acc[ai][0][m][1][j]) * acc[ai][1][m][1][j]; }
                u32x4 w; w.x = cvt_pk_bf16_nv(v0[0], v0[1]); w.y = cvt_pk_bf16_nv(v0[2], v0[3]); w.z = cvt_pk_bf16_nv(v1[0], v1[1]); w.w = cvt_pk_bf16_nv(v1[2], v1[3]);
                *(u32x4*)(HID + (size_t)(row0 + ai * 128 + m * 16) * 1024 + col0) = w; }
    }
};
struct EpiSwigluQ {
    static constexpr bool PERM = true, AFTER_DRAIN = false;
    bf16_t* HID; const float* xscl; const float* sw13;
    __device__ __forceinline__ void operator()(const f32x4 (&acc)[2][2][4][2], const pg8::Unit& u, int wr, int wc, int fr, int fq) const {
        int rl = wr * 64 + fr, cl = wc * 32 + 8 * fq; asm volatile("" : "+v"(rl), "+v"(cl));
        const int row0 = u.pm * 256 + rl, col0 = u.pn * 128 + cl; const int e = u.pm / XPAN;
        const float* swp = sw13 + (size_t)e * 2048 + u.pn * 256 + cl;
        const f32x4 s1a = *(const f32x4*)swp, s1b = *(const f32x4*)(swp + 4), s3a = *(const f32x4*)(swp + 128), s3b = *(const f32x4*)(swp + 132);
        float sx[2][4];
#pragma unroll
        for (int ai = 0; ai < 2; ++ai)
#pragma unroll
            for (int m = 0; m < 4; ++m) sx[ai][m] = xscl[row0 + ai * 128 + m * 16];
        asm volatile("" ::: "memory");
#pragma unroll
        for (int ai = 0; ai < 2; ++ai)
#pragma unroll
            for (int m = 0; m < 4; ++m) { const float s = sx[ai][m]; f32x4 v0, v1;
#pragma unroll
                for (int j = 0; j < 4; ++j) { v0[j] = silu_f(acc[ai][0][m][0][j] * (s * s1a[j])) * (acc[ai][1][m][0][j] * (s * s3a[j])); v1[j] = silu_f(acc[ai][0][m][1][j] * (s * s1b[j])) * (acc[ai][1][m][1][j] * (s * s3b[j])); }
                u32x4 w; w.x = cvt_pk_bf16_nv(v0[0], v0[1]); w.y = cvt_pk_bf16_nv(v0[2], v0[3]); w.z = cvt_pk_bf16_nv(v1[0], v1[1]); w.w = cvt_pk_bf16_nv(v1[2], v1[3]);
                *(u32x4*)(HID + (size_t)(row0 + ai * 128 + m * 16) * 1024 + col0) = w; }
    }
};
struct EpiDown {
    static constexpr bool PERM = true, AFTER_DRAIN = false;
    bf16_t* YS; const float* gatev;
    __device__ __forceinline__ void operator()(const f32x4 (&acc)[2][2][4][2], const pg8::Unit& u, int wr, int wc, int fr, int fq) const {
        int rl = wr * 64 + fr, cl = wc * 32 + 8 * fq; asm volatile("" : "+v"(rl), "+v"(cl));
        const int row0 = u.pm * 256 + rl, col0 = u.pn * 256 + cl;
        float gq[2][4];
#pragma unroll
        for (int ai = 0; ai < 2; ++ai)
#pragma unroll
            for (int m = 0; m < 4; ++m) gq[ai][m] = gatev[row0 + ai * 128 + m * 16];
        asm volatile("" ::: "memory");
#pragma unroll
        for (int ai = 0; ai < 2; ++ai)
#pragma unroll
            for (int m = 0; m < 4; ++m) { const int row = row0 + ai * 128 + m * 16; const float g = gq[ai][m];
#pragma unroll
                for (int bj = 0; bj < 2; ++bj) { const f32x4 v0 = acc[ai][bj][m][0] * g, v1 = acc[ai][bj][m][1] * g;
                    u32x4 w; w.x = cvt_pk_bf16_nv(v0[0], v0[1]); w.y = cvt_pk_bf16_nv(v0[2], v0[3]); w.z = cvt_pk_bf16_nv(v1[0], v1[1]); w.w = cvt_pk_bf16_nv(v1[2], v1[3]);
                    *(u32x4*)(YS + (size_t)row * 1024 + col0 + bj * 128) = w; } }
    }
};

__device__ __forceinline__ u32x4 qk_head8(u32x4 raw, const float (&g)[8], const float (&cs)[8], const float (&sn)[8], bool second) {
    float x[8] = {bflo(raw.x), bfhi(raw.x), bflo(raw.y), bfhi(raw.y), bflo(raw.z), bfhi(raw.z), bflo(raw.w), bfhi(raw.w)};
    float ss = 0.f;
#pragma unroll
    for (int k = 0; k < 8; ++k) ss = fmaf(x[k], x[k], ss);
    ss = row16_sum(ss);
    const float rms = rsqrtf(ss * (1.f / 128.f) + NORM_EPS);
    float o[8];
#pragma unroll
    for (int k = 0; k < 8; ++k) { const float y = x[k] * rms * g[k], pr = row16_xor8(y); o[k] = second ? fmaf(pr, sn[k], y * cs[k]) : fmaf(-pr, sn[k], y * cs[k]); }
    u32x4 w; w.x = cvt_pk_bf16_nv(o[0], o[1]); w.y = cvt_pk_bf16_nv(o[2], o[3]); w.z = cvt_pk_bf16_nv(o[4], o[5]); w.w = cvt_pk_bf16_nv(o[6], o[7]); return w;
}
__device__ __forceinline__ void p_qknorm(const Frame& F, int l, unsigned char* ch) {
    const int gw = F.bid * 8 + F.wave, NGW = F.G * 8, lane = F.lane, rsel = lane >> 5, hk = (lane >> 4) & 1, l16 = lane & 15, pi = (l16 & 7) * 8; const bool second = l16 >= 8;
    const float* ropc = (const float*)(F.ws + WS_ROPE); const float* rops = ropc + SEQ * 64;
    float gk[8];
    { const float* kg = FIN(I_KNG) + l * 128 + (second ? 64 : 0) + pi;
#pragma unroll
      for (int k = 0; k < 8; ++k) gk[k] = kg[k]; }
    u32x4 na = {0u, 0u, 0u, 0u}, nb = na;
    if (gw * 2 < RC) { const int r0 = gw * 2, ra = r0 + rsel, rb = (r0 + 2 * NGW < RC) ? r0 + 2 * NGW + rsel : ra;
        na = *(const u32x4*)((const bf16_t*)(ch + CH_K) + (size_t)ra * 256 + hk * 128 + l16 * 8); nb = *(const u32x4*)((const bf16_t*)(ch + CH_K) + (size_t)rb * 256 + hk * 128 + l16 * 8); }
    for (int r0 = gw * 2; r0 < RC; r0 += 4 * NGW) {
        const int ra = r0 + rsel, rbq = r0 + 2 * NGW + rsel; const bool twob = r0 + 2 * NGW < RC; const int rb = twob ? rbq : ra;
        bf16_t* kpa = (bf16_t*)(ch + CH_K) + (size_t)ra * 256 + hk * 128 + l16 * 8; bf16_t* kpb = (bf16_t*)(ch + CH_K) + (size_t)rb * 256 + hk * 128 + l16 * 8;
        const u32x4 a2 = na, b2 = nb;
        if (r0 + 4 * NGW < RC) { const int r1 = r0 + 4 * NGW, ra1 = r1 + rsel, rb1 = (r1 + 2 * NGW < RC) ? r1 + 2 * NGW + rsel : ra1;
            na = *(const u32x4*)((const bf16_t*)(ch + CH_K) + (size_t)ra1 * 256 + hk * 128 + l16 * 8); nb = *(const u32x4*)((const bf16_t*)(ch + CH_K) + (size_t)rb1 * 256 + hk * 128 + l16 * 8); }
        const int posa = ra % TOK, posb = rb % TOK; float csa[8], sna[8], csb[8], snb[8];
#pragma unroll
        for (int k = 0; k < 8; ++k) { csa[k] = 1.f; sna[k] = 0.f; csb[k] = 1.f; snb[k] = 0.f; }
        if (posa >= CTX) { const f32x4* cp = (const f32x4*)(ropc + (size_t)(posa - CTX) * 64 + pi); const f32x4* sp = (const f32x4*)(rops + (size_t)(posa - CTX) * 64 + pi);
            const f32x4 c0 = cp[0], c1 = cp[1], s0 = sp[0], s1 = sp[1];
            csa[0] = c0.x; csa[1] = c0.y; csa[2] = c0.z; csa[3] = c0.w; csa[4] = c1.x; csa[5] = c1.y; csa[6] = c1.z; csa[7] = c1.w;
            sna[0] = s0.x; sna[1] = s0.y; sna[2] = s0.z; sna[3] = s0.w; sna[4] = s1.x; sna[5] = s1.y; sna[6] = s1.z; sna[7] = s1.w; }
        if (posb >= CTX) { const f32x4* cp = (const f32x4*)(ropc + (size_t)(posb - CTX) * 64 + pi); const f32x4* sp = (const f32x4*)(rops + (size_t)(posb - CTX) * 64 + pi);
            const f32x4 c0 = cp[0], c1 = cp[1], s0 = sp[0], s1 = sp[1];
            csb[0] = c0.x; csb[1] = c0.y; csb[2] = c0.z; csb[3] = c0.w; csb[4] = c1.x; csb[5] = c1.y; csb[6] = c1.z; csb[7] = c1.w;
            snb[0] = s0.x; snb[1] = s0.y; snb[2] = s0.z; snb[3] = s0.w; snb[4] = s1.x; snb[5] = s1.y; snb[6] = s1.z; snb[7] = s1.w; }
        asm volatile("" ::: "memory");
        const u32x4 wa2 = qk_head8(a2, gk, csa, sna, second), wb2 = qk_head8(b2, gk, csb, snb, second);
        *(u32x4*)kpa = wa2; if (twob) *(u32x4*)kpb = wb2;
    }
}
struct Rows3 { u32x4 a, b, c; };
__device__ __forceinline__ Rows3 conv3_load(const bf16_t* hy, size_t rowoff, int ch0, bool hasl, bool hasr) {
    const u32x4 z = {0u, 0u, 0u, 0u}; Rows3 r;
    r.a = hasl ? *(const u32x4*)(hy + rowoff - 1536 + ch0) : z; r.b = *(const u32x4*)(hy + rowoff + ch0); r.c = hasr ? *(const u32x4*)(hy + rowoff + 1536 + ch0) : z; return r;
}
__device__ __forceinline__ void conv3_calc(const Rows3& r, const LAS float* WT, int cl, float (&o)[8]) {
    const unsigned aw[4] = {r.a.x, r.a.y, r.a.z, r.a.w}, bw[4] = {r.b.x, r.b.y, r.b.z, r.b.w}, cw[4] = {r.c.x, r.c.y, r.c.z, r.c.w};
    const LAS f32x4* w0 = (const LAS f32x4*)(WT + cl); const LAS f32x4* w1 = (const LAS f32x4*)(WT + 128 + cl); const LAS f32x4* w2 = (const LAS f32x4*)(WT + 256 + cl); const LAS f32x4* b4 = (const LAS f32x4*)(WT + 384 + cl);
#pragma unroll
    for (int h = 0; h < 2; ++h) { const f32x4 wa = w0[h], wb = w1[h], wc = w2[h], bv = b4[h];
#pragma unroll
        for (int q = 0; q < 2; ++q) { const int j = 2 * h + q;
            o[2 * j] = bv[2 * q] + wa[2 * q] * bflo(aw[j]) + wb[2 * q] * bflo(bw[j]) + wc[2 * q] * bflo(cw[j]);
            o[2 * j + 1] = bv[2 * q + 1] + wa[2 * q + 1] * bfhi(aw[j]) + wb[2 * q + 1] * bfhi(bw[j]) + wc[2 * q + 1] * bfhi(cw[j]); } }
}
__device__ __forceinline__ void p_hyena_pre(const Frame& F, int l, unsigned char* ch) {
    const bf16_t* hy = (const bf16_t*)(ch + CH_HY); bf16_t* X0 = (bf16_t*)(ch + CH_X0); bf16_t* PT = (bf16_t*)(ch + CH_P);
    const float* w = FIN(I_HYCW) + (size_t)l * 3 * 1536; const float* bb = FIN(I_HYCB) + l * 1536;
    LAS bf16_t* T = (LAS bf16_t*)F.lds;
    LAS float* WT = (LAS float*)(F.lds + 32768);
    const int rr = F.tid >> 3, cs = F.tid & 7, cc = F.tid >> 2, pc = F.tid & 3;
    int cb_loaded = -1;
    for (int u = F.bid; u < (RC / 64) * 4; u += F.G) {
        const int rb = u >> 2, cb = u & 3, r = rb * 64 + rr, pos = r % TOK, c0 = cb * 128 + cs * 16;
        if (cb != cb_loaded) { __syncthreads();
            for (int i = F.tid; i < 3 * 4 * 128; i += 512) { const int gq = i / 512, j = (i >> 7) & 3, c = i & 127, chn = gq * 512 + cb * 128 + c; WT[i] = j < 3 ? w[j * 1536 + chn] : bb[chn]; }
            cb_loaded = cb; }
        const bool hasl = pos != 0 && pos != CTX, hasr = pos != CTX - 1 && pos != TOK - 1;
        __syncthreads();
        Rows3 ld[2][3];
#pragma unroll
        for (int h = 0; h < 2; ++h)
#pragma unroll
            for (int gq = 0; gq < 3; ++gq) ld[h][gq] = conv3_load(hy, (size_t)r * 1536, gq * 512 + c0 + 8 * h, hasl, hasr);
        asm volatile("" ::: "memory");
#pragma unroll
        for (int h = 0; h < 2; ++h) { const int c8 = c0 + 8 * h, cl = cs * 16 + 8 * h; float x0[8], x1[8], v[8];
            conv3_calc(ld[h][0], WT, cl, x0); conv3_calc(ld[h][1], WT + 512, cl, x1); conv3_calc(ld[h][2], WT + 1024, cl, v);
            u32x4 a; a.x = cvt_pk_bf16_nv(x0[0], x0[1]); a.y = cvt_pk_bf16_nv(x0[2], x0[3]); a.z = cvt_pk_bf16_nv(x0[4], x0[5]); a.w = cvt_pk_bf16_nv(x0[6], x0[7]);
            *(u32x4*)(X0 + (size_t)r * 512 + c8) = a;
#pragma unroll
            for (int k = 0; k < 8; ++k) T[(cs * 16 + 8 * h + k) * 72 + (rr ^ (8 * cs))] = f2bf(v[k] * x1[k]);
            asm volatile("" ::: "memory"); }
        __syncthreads();
        const int r0 = rb * 64, bl = r0 / TOK, pos0 = r0 - bl * TOK, c = cb * 128 + cc;
        const int sw = (cc >> 4) & 7; const u32x4 t0 = *(const LAS u32x4*)(T + cc * 72 + 8 * ((2 * pc) ^ sw)), t1 = *(const LAS u32x4*)(T + cc * 72 + 8 * ((2 * pc + 1) ^ sw));
        u32x4* dst = (u32x4*)(PT + ((size_t)c * BC + bl) * TOK + pos0 + 16 * pc); dst[0] = t0; dst[1] = t1;
    }
    __syncthreads();
}
__device__ __forceinline__ void p_hyena_post(const Frame& F, unsigned char* ch) {
    const bf16_t* X0 = (const bf16_t*)(ch + CH_X0); const bf16_t* YT = (const bf16_t*)(ch + CH_YT); bf16_t* HYO = (bf16_t*)(ch + CH_HL);
    LAS bf16_t* T = (LAS bf16_t*)F.lds;
    const int rr = F.tid >> 3, cs = F.tid & 7, cc = F.tid >> 2, pc = F.tid & 3;
    for (int u = F.bid; u < (RC / 64) * 4; u += F.G) {
        const int rb = u >> 2, cb = u & 3, r0 = rb * 64, bl = r0 / TOK, pos0 = r0 - bl * TOK, c = cb * 128 + cc;
        __syncthreads();
        const u32x4* src = (const u32x4*)(YT + ((size_t)c * BC + bl) * TOK + pos0 + 16 * pc);
        const int r = r0 + rr, c0 = cb * 128 + cs * 16;
        const u32x4 y0 = src[0], y1 = src[1], xa = *(const u32x4*)(X0 + (size_t)r * 512 + c0), xb = *(const u32x4*)(X0 + (size_t)r * 512 + c0 + 8);
        *(LAS u32x4*)(T + cc * 72 + 16 * pc) = y0; *(LAS u32x4*)(T + cc * 72 + 16 * pc + 8) = y1;
        __syncthreads();
#pragma unroll
        for (int h = 0; h < 2; ++h) { const int c8 = c0 + 8 * h; const u32x4 x = h ? xb : xa; const unsigned xw[4] = {x.x, x.y, x.z, x.w}; unsigned ow[4];
#pragma unroll
            for (int k = 0; k < 4; ++k) { const float y0f = bf2f(T[(cs * 16 + 8 * h + 2 * k) * 72 + rr]), y1f = bf2f(T[(cs * 16 + 8 * h + 2 * k + 1) * 72 + rr]); ow[k] = cvt_pk_bf16_nv(bflo(xw[k]) * y0f, bfhi(xw[k]) * y1f); }
            u32x4 o; o.x = ow[0]; o.y = ow[1]; o.z = ow[2]; o.w = ow[3]; *(u32x4*)(HYO + (size_t)r * 1024 + c8) = o; }
    }
    __syncthreads();
}
__device__ __forceinline__ void p_lru_conv(const Frame& F, int l, unsigned char* ch) {
    const bf16_t* rx = (const bf16_t*)(ch + CH_RX); bf16_t* XC = (bf16_t*)(ch + CH_XC);
    const float* w = FIN(I_LCW) + (size_t)l * 4 * 512; const float* bb = FIN(I_LCB) + l * 512;
    const size_t total = (size_t)RC * 64, stride = (size_t)F.G * 512;
    const int cfix = (F.tid & 63) * 8;
    float wq[4][8], bq8[8];
    { const f32x4 b0 = *(const f32x4*)(bb + cfix), b1 = *(const f32x4*)(bb + cfix + 4); bq8[0] = b0.x; bq8[1] = b0.y; bq8[2] = b0.z; bq8[3] = b0.w; bq8[4] = b1.x; bq8[5] = b1.y; bq8[6] = b1.z; bq8[7] = b1.w;
#pragma unroll
      for (int j = 0; j < 4; ++j) { const f32x4 w0 = *(const f32x4*)(w + j * 512 + cfix), w1 = *(const f32x4*)(w + j * 512 + cfix + 4);
          wq[j][0] = w0.x; wq[j][1] = w0.y; wq[j][2] = w0.z; wq[j][3] = w0.w; wq[j][4] = w1.x; wq[j][5] = w1.y; wq[j][6] = w1.z; wq[j][7] = w1.w; } }
    u32x4 nx[2][4];
#pragma unroll
    for (int t = 0; t < 2; ++t)
#pragma unroll
        for (int j = 0; j < 4; ++j) nx[t][j] = (u32x4){0u, 0u, 0u, 0u};
    auto issue = [&](size_t i0n, u32x4 (&dst)[2][4]) {
#pragma unroll
        for (int t = 0; t < 2; ++t) { const size_t i = i0n + t * stride < total ? i0n + t * stride : i0n; const int r = (int)(i >> 6), c0 = (int)(i & 63) * 8, pos = r % TOK;
            const int lo = pos < CTX ? 0 : CTX, hi = pos < CTX ? CTX : TOK;
#pragma unroll
            for (int j = 0; j < 4; ++j) { const int pp = pos - 2 + j; const bool v = pp >= lo && pp < hi; dst[t][j] = v ? *(const u32x4*)(rx + (size_t)(r - 2 + j) * 512 + c0) : (u32x4){0u, 0u, 0u, 0u}; } } };
    if ((size_t)F.bid * 512 + F.tid < total) issue((size_t)F.bid * 512 + F.tid, nx);
    for (size_t i0 = (size_t)F.bid * 512 + F.tid; i0 < total; i0 += 2 * stride) {
        u32x4 xv[2][4]; int rr[2], cc[2];
#pragma unroll
        for (int t = 0; t < 2; ++t) { const size_t i = i0 + t * stride < total ? i0 + t * stride : i0; rr[t] = (int)(i >> 6); cc[t] = (int)(i & 63) * 8;
#pragma unroll
            for (int j = 0; j < 4; ++j) xv[t][j] = nx[t][j]; }
        if (i0 + 2 * stride < total) issue(i0 + 2 * stride, nx);
        asm volatile("" ::: "memory");
#pragma unroll
        for (int t = 0; t < 2; ++t) { if (t == 1 && i0 + stride >= total) break; const int r = rr[t], c0 = cc[t];
            float o[8];
#pragma unroll
            for (int q = 0; q < 8; ++q) o[q] = bq8[q];
#pragma unroll
            for (int j = 0; j < 4; ++j) { const u32x4 x = xv[t][j]; const unsigned xw[4] = {x.x, x.y, x.z, x.w};
#pragma unroll
                for (int q = 0; q < 4; ++q) { o[2 * q] += wq[j][2 * q] * bflo(xw[q]); o[2 * q + 1] += wq[j][2 * q + 1] * bfhi(xw[q]); } }
            u32x4 a; a.x = cvt_pk_bf16_nv(o[0], o[1]); a.y = cvt_pk_bf16_nv(o[2], o[3]); a.z = cvt_pk_bf16_nv(o[4], o[5]); a.w = cvt_pk_bf16_nv(o[6], o[7]);
            *(u32x4*)(XC + (size_t)r * 512 + c0) = a; }
    }
}

__device__ __forceinline__ void p_attention(const Frame& F, int l, unsigned char* ch, bool with_ctx, bf16_t* O) {
    bf16_t* Q = (bf16_t*)(ch + CH_Q); const bf16_t* K = (const bf16_t*)(ch + CH_K); const bf16_t* V = (const bf16_t*)(ch + CH_V);
    const float* qgain = FIN(I_QNG) + l * 128; const float* ropc = (const float*)(F.ws + WS_ROPE); const float* rops = ropc + SEQ * 64;
    const int nunits = BC * 8 * 16 + (with_ctx ? BC * 8 : 0);
    const bool xmap = false;
    for (int u = F.bid; u < nunits; u += F.G) {
        int bl, h, qrow0, seq;
        if (u < BC * 8 * 16) { int qb;
            if (xmap) { const int i = u >> 8, x = F.bid & 7, j = F.bid >> 3, grp = i * 4 + (x >> 1), w = (x & 1) * 32 + j; bl = grp >> 1; h = (grp & 1) * 4 + (w >> 4); qb = w & 15; }
            else { qb = u & 15; h = (u >> 4) & 7; bl = u >> 7; }
            qrow0 = bl * TOK + CTX + qb * 256; seq = TOK; }
        else { const int uu = u - BC * 8 * 16; h = uu & 7; bl = uu >> 3; qrow0 = bl * TOK; seq = CTX; }
        const size_t q0 = (size_t)qrow0 * 1024 + h * 128, k0 = (size_t)(bl * TOK) * 256 + (h >> 2) * 128;
        att::attn_dense_body(Q + q0, K + k0, V + k0, O + q0, seq, (char*)F.lds_gen, F.tid, qgain, ropc, rops, seq == TOK ? qrow0 - bl * TOK - CTX : -1);
    }
}
template <int J, int NSEG>
__device__ __forceinline__ void conv_task(const LAS unsigned char* cop, const bf16_t* PTc, bf16_t* YTc, float bias, int q, int par, int lane) {
    constexpr int CL = 2 * NSEG + 16, NSTEP = NSEG / 32;
    const int i = lane & 15, g = lane >> 4, il = i & 7, ih = i >> 3, A0 = J * q;
    const int abase = (il * CL + NSEG - 16 * par + 8 * g - 8 * ih) * 2;
    bf16x8 fw[J]; f32x4 acc[J];
#pragma unroll
    for (int j = 0; j < J; ++j) { acc[j] = (f32x4){0.f, 0.f, 0.f, 0.f}; fw[j] = (bf16x8){0, 0, 0, 0, 0, 0, 0, 0}; }
#pragma unroll
    for (int j = 1; j < J; ++j) fw[j] = *(const LAS bf16x8*)(cop + abase - 64 * (A0 + j));
    const bool bval = i < BC;
    const bf16_t* bp = PTc + (size_t)(i % BC) * TOK + 8 * g;
    const bf16x8 zero8 = (bf16x8){0, 0, 0, 0, 0, 0, 0, 0};
    bf16x8 bq[4];
#pragma unroll
    for (int s = 0; s < 4; ++s) bq[s] = (bval && s < NSTEP) ? *(const bf16x8*)(bp + 32 * s) : zero8;
    for (int bb0 = 0; bb0 < NSTEP; bb0 += J) {
#pragma unroll
        for (int bb = 0; bb < J; ++bb) {
            const int b = bb0 + bb;
            fw[(J - bb) % J] = *(const LAS bf16x8*)(cop + abase - 64 * (A0 - b));
            const bf16x8 bcur = bq[bb & 3];
            bq[bb & 3] = (bval && b + 4 < NSTEP) ? *(const bf16x8*)(bp + 32 * (b + 4)) : zero8;
            asm volatile("" ::: "memory");
#pragma unroll
            for (int j = 1; j < J; ++j) acc[j] = __builtin_amdgcn_mfma_f32_16x16x32_bf16(fw[(j - bb + J) % J], bcur, acc[j], 0, 0, 0);
            acc[0] = __builtin_amdgcn_mfma_f32_16x16x32_bf16(fw[(J - bb) % J], bcur, acc[0], 0, 0, 0);
        }
    }
    if (bval) {
        u32x2 pvv[J];
#pragma unroll
        for (int j = 0; j < J; ++j) pvv[j] = *(const u32x2*)(PTc + (size_t)i * TOK + 16 * (2 * J * q + par + 2 * j) + 4 * g);
        asm volatile("" ::: "memory");
#pragma unroll
        for (int j = 0; j < J; ++j) { const size_t idx = (size_t)i * TOK + 16 * (2 * J * q + par + 2 * j) + 4 * g; const u32x2 pv = pvv[j]; u32x2 o;
            o.x = cvt_pk_bf16_nv(acc[j][0] + bias * bflo(pv.x), acc[j][1] + bias * bfhi(pv.x)); o.y = cvt_pk_bf16_nv(acc[j][2] + bias * bflo(pv.y), acc[j][3] + bias * bfhi(pv.y));
            *(u32x2*)(YTc + idx) = o; }
    }
}
template <int NSEG>
__device__ __forceinline__ void conv_build_copies(const Frame& F, const bf16_t* FRc) {
    constexpr int CL = 2 * NSEG + 16, NCK = CL / 8;
    LAS bf16_t* C = (LAS bf16_t*)F.lds;
    for (int k = F.tid; k < NCK; k += 512) *(LAS u32x4*)(C + 8 * k) = *(const u32x4*)(FRc + 8 * k);
    __syncthreads();
    for (int id = F.tid; id < 7 * NCK; id += 512) { const int a = 1 + id / NCK, k = id - (a - 1) * NCK; unsigned w[4];
#pragma unroll
        for (int e = 0; e < 4; ++e) { const int x0 = 8 * k + 2 * e - a, x1 = x0 + 1; const unsigned lo = x0 >= 0 ? C[x0] : 0u, hi = x1 >= 0 ? C[x1] : 0u; w[e] = lo | (hi << 16); }
        u32x4 o; o.x = w[0]; o.y = w[1]; o.z = w[2]; o.w = w[3]; *(LAS u32x4*)(C + a * CL + 8 * k) = o; }
    __syncthreads();
}
__device__ __forceinline__ void p_hyena_conv(const Frame& F, int l, unsigned char* ch) {
    const bf16_t* PT = (const bf16_t*)(ch + CH_P); bf16_t* YT = (bf16_t*)(ch + CH_YT);
    const float* bias = FIN(I_HYBIAS) + l * 512;
    for (int u = F.bid; u < 1024; u += F.G) {
        const int c = u & 511, seg = u >> 9;
        __syncthreads();
        if (seg == 0) { conv_build_copies<SEQ>(F, (const bf16_t*)(F.ws + WS_FRL) + (size_t)c * (2 * SEQ + 16));
            const float bc = bias[c];
#pragma unroll 1
            for (int task = F.wave; task < 16; task += 8)
                conv_task<16, SEQ>((const LAS unsigned char*)F.lds, PT + (size_t)c * BC * TOK + CTX, YT + (size_t)c * BC * TOK + CTX, bc, task & 7, task >> 3, F.lane); }
        else { conv_build_copies<CTX>(F, (const bf16_t*)(F.ws + WS_FRC) + (size_t)c * (2 * CTX + 16));
            if (F.wave < 2) conv_task<8, CTX>((const LAS unsigned char*)F.lds, PT + (size_t)c * BC * TOK, YT + (size_t)c * BC * TOK, bias[c], 0, F.wave, F.lane); }
    }
    __syncthreads();
}
__device__ __forceinline__ int lru_pos(int d, int tau) { return d == 0 ? tau : (tau < CTX ? CTX - 1 - tau : TOK + CTX - 1 - tau); }
__device__ __forceinline__ void p_lru_scan(const Frame& F, int l, unsigned char* ch) {
    LAS float* ab = (LAS float*)(F.lds + F.wave * 16384);
    LAS float* agg = (LAS float*)(F.lds + 131072);
    const int lane = F.lane, n = lane & 15, g = lane >> 4, wave = F.wave;
    for (int u = F.bid; u < BC * 8 * 2; u += F.G)
    for (int d = 0; d < 2; ++d) {
        const int half = u & 1, nb = (u >> 1) & 7, bl = u >> 4;
        const float* wa = FIN(I_LWA) + ((size_t)(l * 2 + d) * 8 + nb) * 4096; const float* wx = FIN(I_LWX) + ((size_t)(l * 2 + d) * 8 + nb) * 4096;
        bf16x8 Bwa[2][2], Bwx[2][2]; float ba[2], bx[2], sp8[2];
#pragma unroll
        for (int kh = 0; kh < 2; ++kh)
#pragma unroll
            for (int nh = 0; nh < 2; ++nh) { const int col = half * 32 + nh * 16 + n, k0 = 32 * kh + 8 * g; float wf[8], xf[8];
#pragma unroll
                for (int e = 0; e < 8; ++e) { wf[e] = wa[(k0 + e) * 64 + col]; xf[e] = wx[(k0 + e) * 64 + col]; }
                asm volatile("" ::: "memory");
                u32x4 t; t.x = cvt_pk_bf16_nv(wf[0], wf[1]); t.y = cvt_pk_bf16_nv(wf[2], wf[3]); t.z = cvt_pk_bf16_nv(wf[4], wf[5]); t.w = cvt_pk_bf16_nv(wf[6], wf[7]); Bwa[kh][nh] = __builtin_bit_cast(bf16x8, t);
                t.x = cvt_pk_bf16_nv(xf[0], xf[1]); t.y = cvt_pk_bf16_nv(xf[2], xf[3]); t.z = cvt_pk_bf16_nv(xf[4], xf[5]); t.w = cvt_pk_bf16_nv(xf[6], xf[7]); Bwx[kh][nh] = __builtin_bit_cast(bf16x8, t); }
#pragma unroll
        for (int nh = 0; nh < 2; ++nh) { const int chj = nb * 64 + half * 32 + nh * 16 + n, o = (l * 2 + d) * 512 + chj;
            ba[nh] = FIN(I_LBA)[o]; bx[nh] = FIN(I_LBX)[o]; sp8[nh] = -8.0f * log1pf(__expf(-FIN(I_LLAM)[o])); }
        const bf16_t* XCb = (const bf16_t*)(ch + CH_XC) + (size_t)bl * TOK * 512; const int ldo = d ? 1024 : 512; bf16_t* HOb = d ? (bf16_t*)(ch + CH_HL) + (size_t)bl * TOK * 1024 + 512 : (bf16_t*)(ch + CH_HF) + (size_t)bl * TOK * 512;
        const bf16_t* HFb = (const bf16_t*)(ch + CH_HF) + (size_t)bl * TOK * 512; const bf16_t* RGb = (const bf16_t*)(ch + CH_RG) + (size_t)bl * TOK * 512;
        const int chj0 = nb * 64 + half * 32 + n;
        float H[2] = {0.f, 0.f};
        __syncthreads();
        for (int sc = 0; sc < 9; ++sc) {
            float As[2] = {1.f, 1.f}, Bs[2] = {0.f, 0.f};
            bf16x8 A0q[4], A1q[4]; bf16_t xrq[4][2][4];
#pragma unroll
            for (int tt = 0; tt < 4; ++tt) { const int tau0 = sc * 512 + wave * 64 + tt * 16; const bool live = tau0 < TOK;
                const bf16_t* ap = XCb + (size_t)lru_pos(d, live ? tau0 + n : 0) * 512 + nb * 64 + 8 * g; A0q[tt] = *(const bf16x8*)ap; A1q[tt] = *(const bf16x8*)(ap + 32);
#pragma unroll
                for (int r = 0; r < 4; ++r) { const int pr = lru_pos(d, live ? tau0 + 4 * g + r : 0); xrq[tt][0][r] = XCb[(size_t)pr * 512 + chj0]; xrq[tt][1][r] = XCb[(size_t)pr * 512 + chj0 + 16]; } }
            asm volatile("" ::: "memory");
#pragma unroll
            for (int tt = 0; tt < 4; ++tt) {
                const int tau0 = sc * 512 + wave * 64 + tt * 16; const bool live = tau0 < TOK;
                const bf16x8 A0 = A0q[tt], A1 = A1q[tt];
                bf16_t xr[2][4];
#pragma unroll
                for (int r = 0; r < 4; ++r) { xr[0][r] = xrq[tt][0][r]; xr[1][r] = xrq[tt][1][r]; }
#pragma unroll
                for (int nh = 0; nh < 2; ++nh) {
                    f32x4 ra = (f32x4){0.f, 0.f, 0.f, 0.f}, ri = ra;
                    ra = __builtin_amdgcn_mfma_f32_16x16x32_bf16(A0, Bwa[0][nh], ra, 0, 0, 0); ra = __builtin_amdgcn_mfma_f32_16x16x32_bf16(A1, Bwa[1][nh], ra, 0, 0, 0);
                    ri = __builtin_amdgcn_mfma_f32_16x16x32_bf16(A0, Bwx[0][nh], ri, 0, 0, 0); ri = __builtin_amdgcn_mfma_f32_16x16x32_bf16(A1, Bwx[1][nh], ri, 0, 0, 0);
                    float a[4], b[4];
#pragma unroll
                    for (int r = 0; r < 4; ++r) { const float xj = bf2f(xr[nh][r]);
                        const float ea = __builtin_amdgcn_exp2f(fminf(-1.4426950408889634f * (ra[r] + ba[nh]), 60.f)), ei = __builtin_amdgcn_exp2f(fminf(-1.4426950408889634f * (ri[r] + bx[nh]), 60.f));
                        const float da = 1.f + ea, di = 1.f + ei, rc = __builtin_amdgcn_rcpf(da * di), sga = di * rc, sgi = da * rc;
                        const float la = sp8[nh] * sga, x2 = 2.0f * la, aexp = __expf(la);
                        float em1 = x2 * (1.0f + x2 * (0.5f + x2 * (0.16666667f + x2 * (0.041666668f + x2 * 0.0083333338f))));
                        if (x2 < -0.25f) em1 = aexp * aexp - 1.0f;
                        a[r] = live ? aexp : 1.f; b[r] = live ? __builtin_amdgcn_sqrtf(fmaxf(-em1, 0.f)) * sgi * xj : 0.f;
                        *(LAS f32x2*)(ab + ((((tt * 2 + nh) * 4 + r) * 64 + lane) << 1)) = (f32x2){a[r], b[r]}; }
                    float A = a[0], B = b[0];
#pragma unroll
                    for (int r = 1; r < 4; ++r) { B = fmaf(B, a[r], b[r]); A *= a[r]; }
                    float Ai = A, Bi = B;
                    { const float Ap = __shfl_up(Ai, 16), Bp = __shfl_up(Bi, 16); if (g >= 1) { Bi = fmaf(Bp, Ai, Bi); Ai *= Ap; } }
                    { const float Ap = __shfl_up(Ai, 32), Bp = __shfl_up(Bi, 32); if (g >= 2) { Bi = fmaf(Bp, Ai, Bi); Ai *= Ap; } }
                    Bs[nh] = fmaf(Bs[nh], Ai, Bi); As[nh] *= Ai;
                }
            }
            LAS float* ag = agg + (sc & 1) * (8 * 2 * 16 * 2);
            if (g == 3) {
#pragma unroll
                for (int nh = 0; nh < 2; ++nh) { ag[((wave * 2 + nh) * 16 + n) * 2] = As[nh]; ag[((wave * 2 + nh) * 16 + n) * 2 + 1] = Bs[nh]; } }
            __syncthreads();
            float hst[2];
#pragma unroll
            for (int nh = 0; nh < 2; ++nh) { float h = H[nh], hin = H[nh];
#pragma unroll
                for (int w = 0; w < 8; ++w) { if (w == wave) hin = h; h = fmaf(ag[((w * 2 + nh) * 16 + n) * 2], h, ag[((w * 2 + nh) * 16 + n) * 2 + 1]); }
                hst[nh] = hin; H[nh] = h; }
#pragma unroll 1
            for (int tt = 0; tt < 4; ++tt) {
                const int tau0 = sc * 512 + wave * 64 + tt * 16; if (tau0 >= TOK) break;
                int posr[4];
#pragma unroll
                for (int r = 0; r < 4; ++r) posr[r] = lru_pos(d, tau0 + 4 * g + r);
                bf16_t hfq[2][4], rgq[2][4];
                if (d) {
#pragma unroll
                    for (int nh = 0; nh < 2; ++nh)
#pragma unroll
                        for (int r = 0; r < 4; ++r) { const size_t ix = (size_t)posr[r] * 512 + chj0 + 16 * nh; hfq[nh][r] = HFb[ix]; rgq[nh][r] = RGb[ix]; } }
#pragma unroll
                for (int nh = 0; nh < 2; ++nh) { float a[4], b[4];
#pragma unroll
                    for (int r = 0; r < 4; ++r) { const f32x2 t2 = *(const LAS f32x2*)(ab + ((((tt * 2 + nh) * 4 + r) * 64 + lane) << 1)); a[r] = t2.x; b[r] = t2.y; }
                    float A = a[0], B = b[0];
#pragma unroll
                    for (int r = 1; r < 4; ++r) { B = fmaf(B, a[r], b[r]); A *= a[r]; }
                    float Ai = A, Bi = B;
                    { const float Ap = __shfl_up(Ai, 16), Bp = __shfl_up(Bi, 16); if (g >= 1) { Bi = fmaf(Bp, Ai, Bi); Ai *= Ap; } }
                    { const float Ap = __shfl_up(Ai, 32), Bp = __shfl_up(Bi, 32); if (g >= 2) { Bi = fmaf(Bp, Ai, Bi); Ai *= Ap; } }
                    float Ae = __shfl_up(Ai, 16), Be = __shfl_up(Bi, 16); if (g == 0) { Ae = 1.f; Be = 0.f; }
                    float h = fmaf(Ae, hst[nh], Be);
                    bf16_t* hop = HOb + chj0 + 16 * nh;
#pragma unroll
                    for (int r = 0; r < 4; ++r) { h = fmaf(a[r], h, b[r]); hop[(size_t)posr[r] * ldo] = f2bf(d ? (bf2f(hfq[nh][r]) + h) * bf2f(rgq[nh][r]) : h); }
                    hst[nh] = __shfl(h, 48 + n);
                }
            }
        }
    }
    __syncthreads();
}
__device__ __forceinline__ void p_lru_post(const Frame& F, unsigned char* ch) {
    const u32x4* hf = (const u32x4*)(ch + CH_HF); const u32x4* hb = (const u32x4*)(ch + CH_HB); const u32x4* rg = (const u32x4*)(ch + CH_RG); u32x4* o = (u32x4*)(ch + CH_LRUO);
    const size_t total = (size_t)RC * 64, stride = (size_t)F.G * 512;
    for (size_t i = (size_t)F.bid * 512 + F.tid; i < total; i += 2 * stride) {
        const size_t i2 = i + stride; const bool two = i2 < total;
        const u32x4 a = hf[i], b = hb[i], g = rg[i]; u32x4 a2 = a, b2 = b, g2 = g; if (two) { a2 = hf[i2]; b2 = hb[i2]; g2 = rg[i2]; }
        u32x4 w, w2;
        w.x = cvt_pk_bf16_nv((bflo(a.x) + bflo(b.x)) * bflo(g.x), (bfhi(a.x) + bfhi(b.x)) * bfhi(g.x));
        w.y = cvt_pk_bf16_nv((bflo(a.y) + bflo(b.y)) * bflo(g.y), (bfhi(a.y) + bfhi(b.y)) * bfhi(g.y));
        w.z = cvt_pk_bf16_nv((bflo(a.z) + bflo(b.z)) * bflo(g.z), (bfhi(a.z) + bfhi(b.z)) * bfhi(g.z));
        w.w = cvt_pk_bf16_nv((bflo(a.w) + bflo(b.w)) * bflo(g.w), (bfhi(a.w) + bfhi(b.w)) * bfhi(g.w));
        w2.x = cvt_pk_bf16_nv((bflo(a2.x) + bflo(b2.x)) * bflo(g2.x), (bfhi(a2.x) + bfhi(b2.x)) * bfhi(g2.x));
        w2.y = cvt_pk_bf16_nv((bflo(a2.y) + bflo(b2.y)) * bflo(g2.y), (bfhi(a2.y) + bfhi(b2.y)) * bfhi(g2.y));
        w2.z = cvt_pk_bf16_nv((bflo(a2.z) + bflo(b2.z)) * bflo(g2.z), (bfhi(a2.z) + bfhi(b2.z)) * bfhi(g2.z));
        w2.w = cvt_pk_bf16_nv((bflo(a2.w) + bflo(b2.w)) * bflo(g2.w), (bfhi(a2.w) + bfhi(b2.w)) * bfhi(g2.w));
        o[i] = w; if (two) o[i2] = w2;
    }
}

__device__ __forceinline__ void p_topk(const Frame& F, unsigned char* ch) {
    const float* AFF = (const float*)(ch + CH_AFF); int* ROWSRC = (int*)(ch + CH_ROWSRC); float* GATEV = (float*)(ch + CH_GATEV); int* INV = (int*)(ch + CH_INV);
    const float* SU = (const float*)(ch + CH_SU); float* XSCL = (float*)(ch + CH_XSCL);
    LAS unsigned* sh = (LAS unsigned*)F.lds;
    const int tid = F.tid, lane = F.lane, wave = F.wave;
    for (int u = F.bid; u < BC * NE * 2; u += F.G) {
        const int set = u / (BC * NE), e = u % NE, bl = (u / NE) % BC;
        const int n = set ? CTX : SEQ, cap = set ? CAP_C : CAP_L, r0 = bl * TOK + (set ? 0 : CTX);
        unsigned key[8];
#pragma unroll
        for (int k = 0; k < 8; ++k) { const int i = tid * 8 + k; key[k] = i < n ? __float_as_uint(AFF[(size_t)(r0 + i) * NE + e]) : 0u; }
        __syncthreads();
        unsigned T = 0u;
#pragma unroll 1
        for (int b = 30; b >= 0; b -= 2) {
            const unsigned l1 = T | (1u << b), l2 = T | (2u << b), l3 = T | (3u << b);
            int pk = 0;
#pragma unroll
            for (int k = 0; k < 8; ++k) pk += (key[k] >= l1 ? 1 : 0) + (key[k] >= l2 ? (1 << 10) : 0) + (key[k] >= l3 ? (1 << 20) : 0);
            pk = __float_as_int(row16_sum_i(pk)); pk += __shfl_xor(pk, 16); pk += __shfl_xor(pk, 32);
            LAS unsigned* bank = sh + ((b & 2) << 2);
            if (lane == 0) bank[wave] = (unsigned)pk;
            __syncthreads();
            unsigned t1 = 0, t2 = 0, t3 = 0;
#pragma unroll
            for (int w = 0; w < 8; ++w) { const unsigned q = bank[w]; t1 += q & 1023u; t2 += (q >> 10) & 1023u; t3 += q >> 20; }
            T = (int)t3 >= cap ? l3 : (int)t2 >= cap ? l2 : (int)t1 >= cap ? l1 : T;
        }
        int tg = 0, te = 0;
#pragma unroll
        for (int k = 0; k < 8; ++k) { tg += key[k] > T ? 1 : 0; te += key[k] == T ? 1 : 0; }
        int ig = tg, ie = te;
#pragma unroll
        for (int o = 1; o < 64; o <<= 1) { const int a = __shfl_up(ig, o), b = __shfl_up(ie, o); if (lane >= o) { ig += a; ie += b; } }
        __syncthreads();
        if (lane == 63) { sh[16 + wave] = (unsigned)ig; sh[32 + wave] = (unsigned)ie; }
        __syncthreads();
        int pg = ig - tg, pe = ie - te, totg = 0;
#pragma unroll
        for (int w = 0; w < 8; ++w) { const int a = (int)sh[16 + w], b = (int)sh[32 + w]; if (w < wave) { pg += a; pe += b; } totg += a; }
        const int need = cap - totg;
#pragma unroll
        for (int k = 0; k < 8; ++k) { const int i = tid * 8 + k;
            if (i < n) { const bool gt = key[k] > T, eq = key[k] == T; int xr = -1;
                if (gt || (eq && pe < need)) { xr = (set ? BC * CAP_L + bl * CAP_C : bl * CAP_L) + pg + (pe < need ? pe : need); ROWSRC[e * XROWS + xr] = r0 + i; GATEV[e * XROWS + xr] = __uint_as_float(key[k]); XSCL[e * XROWS + xr] = SU[r0 + i]; }
                INV[(size_t)(r0 + i) * NE + e] = xr;
                pg += gt ? 1 : 0; pe += eq ? 1 : 0; } }
    }
    __syncthreads();
}
__device__ __forceinline__ void p_combine(const Frame& F, int l, int chunk, unsigned char* ch) {
    const int* INV = (const int*)(ch + CH_INV); const bf16_t* YS = (const bf16_t*)(ch + CH_YS);
    const int gw = F.bid * 8 + F.wave, NGW = F.G * 8;
    for (int r = gw; r < RC; r += NGW) {
        float acc[16];
#pragma unroll
        for (int j = 0; j < 16; ++j) acc[j] = 0.f;
        int any = 0;
        for (int e = 0; e < NE; ++e) { const int xr = INV[(size_t)r * NE + e];
            if (xr >= 0) { any = 1; const u32x4* yp = (const u32x4*)(YS + ((size_t)e * XROWS + xr) * 1024) + F.lane;
#pragma unroll
                for (int j = 0; j < 2; ++j) { const u32x4 y = yp[64 * j];
                    acc[8 * j + 0] += bflo(y.x); acc[8 * j + 1] += bfhi(y.x); acc[8 * j + 2] += bflo(y.y); acc[8 * j + 3] += bfhi(y.y);
                    acc[8 * j + 4] += bflo(y.z); acc[8 * j + 5] += bfhi(y.z); acc[8 * j + 6] += bflo(y.w); acc[8 * j + 7] += bfhi(y.w); } } }
        if (any) {
            float* hp = hrow_ptr(F, chunk, r); const float* g2 = mod_ptr(F, l, mod_row(chunk, r), 5);
#pragma unroll
            for (int j = 0; j < 2; ++j)
#pragma unroll
                for (int q = 0; q < 2; ++q) { const int col = 512 * j + 8 * F.lane + 4 * q; f32x4* p4 = (f32x4*)(hp + col); const f32x4 g = *(const f32x4*)(g2 + col);
                    f32x4 a; a.x = acc[8 * j + 4 * q]; a.y = acc[8 * j + 4 * q + 1]; a.z = acc[8 * j + 4 * q + 2]; a.w = acc[8 * j + 4 * q + 3];
                    *p4 = *p4 + g * a; }
        }
    }
}
__device__ __forceinline__ void p_final(const Frame& F, unsigned char* ch) {
    const int* INV = (const int*)(ch + CH_INV); const bf16_t* YS = (const bf16_t*)(ch + CH_YS);
    const int gw = F.bid * 8 + F.wave, NGW = F.G * 8; const f32x4* gp = (const f32x4*)FIN(I_FNG) + F.lane;
    for (int r = gw; r < NB * SEQ; r += NGW) {
        const int b = r >> 12, t = r & (SEQ - 1), rr = b * TOK + CTX + t;
        f32x4* hp = (f32x4*)(F.out + ((size_t)r << 10)) + F.lane; f32x4 v[4], acc[4]; float ss = 0.f;
        { const u32x2* hb = (const u32x2*)((const bf16_t*)(ch + CH_HRES) + (size_t)rr * DM) + F.lane;
#pragma unroll
          for (int j = 0; j < 4; ++j) { const u32x2 t = hb[64 * j]; v[j] = (f32x4){bflo(t.x), bfhi(t.x), bflo(t.y), bfhi(t.y)}; acc[j] = (f32x4){0.f, 0.f, 0.f, 0.f}; } }
        { const int xl = INV[(size_t)rr * NE + (F.lane & 15)]; unsigned mk = (unsigned)__ballot(xl >= 0) & 0xffffu;
          while (mk) { const int e0 = __builtin_ctz(mk); mk &= mk - 1u; const bool two = mk != 0u; const int e1 = two ? __builtin_ctz(mk) : e0; if (two) mk &= mk - 1u;
              const int x0 = __builtin_amdgcn_readlane(xl, e0), x1 = __builtin_amdgcn_readlane(xl, e1); const float w1 = two ? 1.f : 0.f;
              const u32x2* y0 = (const u32x2*)(YS + ((size_t)e0 * XROWS + x0) * 1024) + F.lane; const u32x2* y1 = (const u32x2*)(YS + ((size_t)e1 * XROWS + x1) * 1024) + F.lane;
              u32x2 a[4], bb[4];
#pragma unroll
              for (int j = 0; j < 4; ++j) { a[j] = y0[64 * j]; bb[j] = y1[64 * j]; }
#pragma unroll
              for (int j = 0; j < 4; ++j) { acc[j].x += bflo(a[j].x) + w1 * bflo(bb[j].x); acc[j].y += bfhi(a[j].x) + w1 * bfhi(bb[j].x); acc[j].z += bflo(a[j].y) + w1 * bflo(bb[j].y); acc[j].w += bfhi(a[j].y) + w1 * bfhi(bb[j].y); } } }
        const f32x4* g2 = (const f32x4*)mod_ptr(F, DEPTH - 1, b, 5) + F.lane; f32x4 g2q[4], gfq[4];
#pragma unroll
        for (int j = 0; j < 4; ++j) { g2q[j] = g2[64 * j]; gfq[j] = gp[64 * j]; }
        asm volatile("" ::: "memory");
#pragma unroll
        for (int j = 0; j < 4; ++j) { v[j] = v[j] + g2q[j] * acc[j]; ss += (v[j].x * v[j].x + v[j].y * v[j].y) + (v[j].z * v[j].z + v[j].w * v[j].w); }
        const float rstd = rsqrtf(wave_sum(ss) * (1.f / DM) + NORM_EPS);
#pragma unroll
        for (int j = 0; j < 4; ++j) hp[64 * j] = v[j] * rstd * gfq[j];
    }
}
constexpr int STEPS_PER_LAYER = 12, NSTEPS = 1 + DEPTH * STEPS_PER_LAYER + 1;
constexpr unsigned ALL_PHASES = 0xFFFFFFFFu;
#ifndef PROBE_REPMASK
#define PROBE_REPMASK 0u
#endif

template <unsigned PHMASK>
__global__ void __launch_bounds__(512, 2) fwd_kernel(Args args) {
    extern __shared__ __attribute__((aligned(16))) unsigned char lds_raw[];
    Frame F0;
    F0.lds = (LAS unsigned char*)lds_raw; F0.lds_gen = lds_raw;
    F0.tid = 0; F0.lane = 0; F0.wave = __builtin_amdgcn_readfirstlane((int)threadIdx.x >> 6); F0.G = gridDim.x; F0.bid = blockIdx.x;
    F0.in = nullptr; F0.out = args.out; F0.ws = args.ws;
    for (int u = threadIdx.x; u < (LDS_BYTES - LDSCTL_OFF) / 4; u += 512) ((LAS unsigned*)(F0.lds + LDSCTL_OFF))[u] = 0u;
    __syncthreads();
    XcdBarrier bar = xcd_barrier_post((unsigned*)(F0.ws + WS_CTL) + CW_BAR, (volatile LAS unsigned*)(F0.lds + LDSCTL_OFF + 64));
    const int lo = args.lo, hi = args.hi; const unsigned repmask = PROBE_REPMASK;
    int step = 0, l0_ = 0;
#define PH_BEGIN_(k) if (step >= lo && step < hi && ((PHMASK >> (k)) & 1u)) for (int rep_ = 0; rep_ <= (int)((repmask >> (k)) & 1u); ++rep_) { Frame F = F0; \
        { GAS unsigned char* w_ = (GAS unsigned char*)F.ws; GAS float* o_ = (GAS float*)F.out; asm volatile("" : "+s"(w_), "+s"(o_)); \
          F.ws = (unsigned char*)w_; F.out = (float*)o_; F.in = (const float* const*)(F.ws + WS_TAB); } \
        asm volatile("" : "+s"(F.wave), "+s"(F.bid), "+s"(F.G)); \
        { int ln_; asm volatile("v_mbcnt_lo_u32_b32 %0, -1, 0\n\tv_mbcnt_hi_u32_b32 %0, -1, %0" : "=v"(ln_));     \
          F.lane = ln_; F.tid = F.wave * 64 + ln_; } \
        unsigned char* ch = F.ws + WS_CH; (void)ch; int l = l0_; asm volatile("" : "+s"(l)); (void)l;
#define SUBF(name) Frame name = F; { int ln2_; asm volatile("v_mbcnt_lo_u32_b32 %0, -1, 0\n\tv_mbcnt_hi_u32_b32 %0, -1, %0" : "=v"(ln2_)); name.lane = ln2_; name.tid = name.wave * 64 + ln2_; }
#define PH_END } if (step >= lo && step + 1 < hi) { XcdBarrier bb_ = bar; { GAS unsigned* p_ = (GAS unsigned*)bb_.bar; unsigned x_ = bb_.x; asm volatile("" : "+s"(p_), "+s"(x_)); bb_.bar = (unsigned*)p_; bb_.x = x_; } \
        xcd_barrier(bb_); } ++step;

    PH_BEGIN_(0) p_prologue(F, args); PH_END
    for (l0_ = 0; l0_ < DEPTH; ++l0_) {
        constexpr int chunk = 0;
        PH_BEGIN_(1) if (l == 0) p_weights(F, l);
                     if (l == 0) p_norm<false, false>(F, l, chunk, FIN(I_N1G) + l * DM, 0, 1, nullptr, nullptr, 0, nullptr, nullptr, FIN(I_X), FIN(I_CTX), nullptr, false, (signed char*)(ch + CH_U), (float*)(F.ws + WS_SUN));
                     else p_norm<false, true>(F, l, chunk, FIN(I_N1G) + l * DM, 0, 1, nullptr, nullptr, l - 1, (const int*)(ch + CH_INV), (const bf16_t*)(ch + CH_YS), nullptr, nullptr, nullptr, false, (signed char*)(ch + CH_U), (float*)(F.ws + WS_SUN)); PH_END
        PH_BEGIN_(3) { GemmPlainQ g{(const signed char*)(ch + CH_U), (const signed char*)(F.ws + WS_WIN), DM}; pg8::StaticOrder S; S.init(PANELS, 16, F.G, F.bid); EpiIn E{ch, 0, (const float*)(F.ws + WS_SUN), (const float*)(F.ws + WS_SWIN)};
                   pg8::gemm_phase<GemmPlainQ, EpiIn, pg8::StaticOrder>(F.lds, g, S, E, F.tid); } PH_END
        PH_BEGIN_(4) if (rep_ == 0) p_qknorm(F, l, ch); { SUBF(Fb) p_hyena_pre(Fb, l, ch); } { SUBF(Fc) p_lru_conv(Fc, l, ch); } PH_END
        PH_BEGIN_(5) p_attention(F, l, ch, l != DEPTH - 1, (bf16_t*)(ch + (rep_ ? CH_HY : CH_Q))); if (rep_ == 0) { { SUBF(Fb) p_hyena_conv(Fb, l, ch); } { SUBF(Fc) p_lru_scan(Fc, l, ch); } } PH_END
        PH_BEGIN_(8) p_hyena_post(F, ch); PH_END
        PH_BEGIN_(6) { GemmPlainQ g{(const signed char*)(ch + CH_U), (const signed char*)(F.ws + WS_WIN) + (size_t)4096 * DM, DM}; pg8::MappedOrder S; const bool lastl = (l == DEPTH - 1); S.init(lastl ? BC * 16 : PANELS, 12, F.G, F.bid); S.mode = lastl ? 1 : 0; EpiIn E{ch, 16, (const float*)(F.ws + WS_SUN), (const float*)(F.ws + WS_SWIN)};
                   pg8::gemm_phase<GemmPlainQ, EpiIn, pg8::MappedOrder>(F.lds, g, S, E, F.tid); } PH_END
        PH_BEGIN_(9) { { pg8::MappedOrder S; const bool lastl = (l == DEPTH - 1); S.init(lastl ? BC * 16 : PANELS, 4, F.G, F.bid); S.mode = lastl ? 1 : 0;
                     GemmMerge g{(const bf16_t*)(ch + CH_Q), (const bf16_t*)(F.ws + WS_WA), (const bf16_t*)(ch + CH_HL), (const bf16_t*)(F.ws + WS_WH), 1024}; EpiMergeFused E{(bf16_t*)(ch + CH_Y), (const unsigned char*)(ch + CH_GATE)};
                     pg8::gemm_phase<GemmMerge, EpiMergeFused, pg8::MappedOrder>(F.lds, g, S, E, F.tid); }
                   { SUBF(Fw) p_weights_exp13(Fw, l); if (l + 1 < DEPTH) w_filters(Fw, l + 1, 64); } } PH_END
        PH_BEGIN_(10) { GemmPlain g{(const bf16_t*)(ch + CH_Y), (const bf16_t*)(F.ws + WS_WO), 1024}; pg8::MappedOrder S; const bool lastl = (l == DEPTH - 1); S.init(lastl ? BC * 16 : PANELS, 4, F.G, F.bid); S.mode = lastl ? 1 : 0;
                   EpiDelta E{(bf16_t*)(ch + CH_DLT), (const float*)(F.ws + WS_MOD) + (size_t)l * 17 * 6 * DM, chunk};
                   pg8::gemm_phase<GemmPlain, EpiDelta, pg8::MappedOrder>(F.lds, g, S, E, F.tid); { SUBF(Fw) p_weights_exp2(Fw, l); if (l + 1 < DEPTH) w_quant_in(Fw, l + 1, 64); } } PH_END
        PH_BEGIN_(11) p_norm<true, false>(F, l, chunk, FIN(I_N2G) + l * DM, 3, 4, nullptr, (float*)(ch + CH_AFF), 0, nullptr, nullptr, l == 0 ? FIN(I_X) : nullptr, l == 0 ? FIN(I_CTX) : nullptr,
                                                (rep_ == 0) ? (const bf16_t*)(ch + CH_DLT) : nullptr, l == DEPTH - 1, (signed char*)(ch + CH_U2), (float*)(ch + CH_SU)); PH_END
        PH_BEGIN_(12) p_topk(F, ch); PH_END
        PH_BEGIN_(14) { GemmExpertGatherQ g{(const signed char*)(ch + CH_U2), (const int*)(ch + CH_ROWSRC), (const signed char*)(F.ws + WS_W13), 1024, 2048}; pg8::MappedOrder S; const bool lastl = (l == DEPTH - 1); S.init(lastl ? NE * 32 : NE * XPAN, 8, F.G, F.bid); S.mode = lastl ? 2 : 0; EpiSwigluQ E{(bf16_t*)(ch + CH_HID), (const float*)(ch + CH_XSCL), (const float*)(F.ws + WS_SW13)};
                   pg8::gemm_phase<GemmExpertGatherQ, EpiSwigluQ, pg8::MappedOrder>(F.lds, g, S, E, F.tid); } PH_END
        PH_BEGIN_(15) { GemmExpert g{(const bf16_t*)(ch + CH_HID), (const bf16_t*)(F.ws + WS_W2), 1024, 1024}; pg8::MappedOrder S; const bool lastl = (l == DEPTH - 1); S.init(lastl ? NE * 32 : NE * XPAN, 4, F.G, F.bid); S.mode = lastl ? 2 : 0; EpiDown E{(bf16_t*)(ch + CH_YS), (const float*)(ch + CH_GATEV)};
                   pg8::gemm_phase<GemmExpert, EpiDown, pg8::MappedOrder>(F.lds, g, S, E, F.tid); if (l + 1 < DEPTH) { SUBF(Fw) w_transposes(Fw, l + 1, 128); } } PH_END
    }
    PH_BEGIN_(17) p_final(F, ch); PH_END
#undef PH_BEGIN_
#undef PH_END
}

extern "C" void kernel_launch(void* const* d_in, const int* in_sizes, int n_in, void* d_out, int out_size, void* d_ws, size_t ws_size, hipStream_t stream) {
    static int grid = 0;
    if (grid == 0) {
        if (n_in != N_IN || out_size != NB * SEQ * DM || ws_size < WS_END) { fprintf(stderr, "kernel_launch: unexpected shapes: n_in %d out %d ws %zu (need %zu)\n", n_in, out_size, ws_size, (size_t)WS_END); grid = -1; return; }
        int dev = 0, cus = 0, per_cu = 0;
        if (hipGetDevice(&dev) != hipSuccess || hipDeviceGetAttribute(&cus, hipDeviceAttributeMultiprocessorCount, dev) != hipSuccess) { grid = -1; return; }
#if MK_ONE_LAUNCH
        if (hipFuncSetAttribute((const void*)fwd_kernel<ALL_PHASES>, hipFuncAttributeMaxDynamicSharedMemorySize, LDS_BYTES) != hipSuccess) { fprintf(stderr, "kernel_launch: hipFuncSetAttribute failed\n"); grid = -1; return; }
        if (hipOccupancyMaxActiveBlocksPerMultiprocessor(&per_cu, (const void*)fwd_kernel<ALL_PHASES>, 512, LDS_BYTES) != hipSuccess || per_cu < 1) { fprintf(stderr, "kernel_launch: occupancy query says %d\n", per_cu); }
#else
#define SET_ATTR(k) if (hipFuncSetAttribute((const void*)fwd_kernel<(1u << (k))>, hipFuncAttributeMaxDynamicSharedMemorySize, LDS_BYTES) != hipSuccess) { fprintf(stderr, "kernel_launch: hipFuncSetAttribute failed\n"); grid = -1; return; }
        SET_ATTR(0) SET_ATTR(1) SET_ATTR(2) SET_ATTR(3) SET_ATTR(4) SET_ATTR(5) SET_ATTR(6) SET_ATTR(7) SET_ATTR(8) SET_ATTR(9) SET_ATTR(10) SET_ATTR(11) SET_ATTR(12) SET_ATTR(13) SET_ATTR(14) SET_ATTR(15) SET_ATTR(16) SET_ATTR(17)
#undef SET_ATTR
        (void)per_cu;
#endif
        (void)hipGetLastError();
        grid = cus;
    }
    if (grid < 0) return;
    (void)hipMemsetAsync((char*)d_ws + WS_CTL, 0, CTL_ZERO_BYTES, stream);
    Args a{};
    for (int i = 0; i < N_IN; ++i) a.in[i] = (const float*)d_in[i];
    a.out = (float*)d_out; a.ws = (unsigned char*)d_ws;
#if MK_ONE_LAUNCH
    a.lo = 0; a.hi = NSTEPS;
    hipLaunchKernelGGL(fwd_kernel<ALL_PHASES>, dim3(grid), dim3(512), LDS_BYTES, stream, a);
#else
    {
        int s = 0;
#define LAUNCH_PH(k) do { a.lo = s; a.hi = s + 1; hipLaunchKernelGGL(fwd_kernel<(1u << (k))>, dim3(grid), dim3(512), LDS_BYTES, stream, a); ++s; } while (0)
        LAUNCH_PH(0);
        for (int l = 0; l < DEPTH; ++l) { LAUNCH_PH(1); LAUNCH_PH(3); LAUNCH_PH(4); LAUNCH_PH(5); LAUNCH_PH(8); LAUNCH_PH(6); LAUNCH_PH(9); LAUNCH_PH(10);
            LAUNCH_PH(11); LAUNCH_PH(12); LAUNCH_PH(14); LAUNCH_PH(15); }
        LAUNCH_PH(17);
#undef LAUNCH_PH
    }
#endif
    const hipError_t le = hipPeekAtLastError();
    if (le != hipSuccess) fprintf(stderr, "kernel_launch: launch failed: %s\n", hipGetErrorName(le));
}
```
